# Optimizing an MI355X kernel written in HIP

```python
import jax, jax.numpy as jnp
from jax import lax
import numpy as np

D_MODEL = 2048
BATCH = 1
SEQ = 8192
DEPTH = 1

HG_HEADS = 16
HG_KDIM = 128
HG_VDIM = D_MODEL // HG_HEADS
HG_FDIM = HG_HEADS * HG_KDIM
HG_VWIDTH = HG_HEADS * HG_VDIM
HG_CHUNK = 64
MLA_HEADS = 16
Q_LORA = 512
KV_LORA = 512
QK_NOPE = 128
QK_ROPE = 64
V_DIM = 128
QK_DIM = QK_NOPE + QK_ROPE
ROPE_THETA = 10000.0
ATTN_BLOCK = 128
FF_MULT = 256
D_FF = ((8 * D_MODEL + 3 * FF_MULT - 1) // (3 * FF_MULT)) * FF_MULT
N_MOD = 6
EPS = 1e-6
IN_SIZES = (HG_FDIM, HG_FDIM, HG_VWIDTH, HG_VWIDTH,
            Q_LORA, KV_LORA, QK_ROPE,
            D_MODEL, D_MODEL)
IN_WIDTH = sum(IN_SIZES)

kernel_name = "hybrid_hgrn2_mla_swiglu_sandwich_adaln"


def rmsnorm(x, w):
    xf = x.astype(jnp.float32)
    y = xf * lax.rsqrt(jnp.mean(xf * xf, axis=-1, keepdims=True) + EPS)
    return (y * w.astype(jnp.float32)).astype(x.dtype)


def rope_tables(positions):
    inv_freq = ROPE_THETA ** (-jnp.arange(0, QK_ROPE, 2, dtype=jnp.float32) / QK_ROPE)
    ang = positions.astype(jnp.float32)[..., None] * inv_freq
    return jnp.cos(ang), jnp.sin(ang)


def apply_rope(t, cos, sin):
    cos = cos.astype(t.dtype)
    sin = sin.astype(t.dtype)
    t1, t2 = jnp.split(t, 2, axis=-1)
    return jnp.concatenate([t1 * cos - t2 * sin, t2 * cos + t1 * sin], axis=-1)


def hgrn2_chunked(q, k, v, g):
    B, S, H, K = q.shape
    V = v.shape[-1]
    C = HG_CHUNK
    nc = S // C

    def to_chunks(t):
        return t.reshape(B, nc, C, H, t.shape[-1]).transpose(1, 0, 3, 2, 4)

    tri = jnp.tril(jnp.ones((C, C), dtype=bool))[:, :, None]

    def step(state, inp):
        qc, kc, vc, gc = inp
        b = jnp.cumsum(gc, axis=2)
        o_inter = jnp.einsum('bhck,bhkv->bhcv', qc * jnp.exp(b), state)
        diff = b[:, :, :, None, :] - b[:, :, None, :, :]
        decay = jnp.exp(jnp.where(tri, diff, -jnp.inf))
        scores = jnp.einsum('bhtsk,bhsk->bhts', qc[:, :, :, None, :] * decay, kc)
        o_intra = jnp.einsum('bhts,bhsv->bhtv', scores, vc)
        b_last = b[:, :, -1:, :]
        state = (jnp.exp(b_last[:, :, 0, :])[..., None] * state
                 + jnp.einsum('bhck,bhcv->bhkv', kc * jnp.exp(b_last - b), vc))
        return state, o_inter + o_intra

    s0 = jnp.zeros((B, H, K, V), jnp.float32)
    _, o = lax.scan(step, s0, (to_chunks(q), to_chunks(k), to_chunks(v), to_chunks(g)))
    return o.transpose(1, 0, 3, 2, 4).reshape(B, S, H, V)


def causal_block_attention(q, k, v):
    B, S, H, Dq = q.shape
    nb = S // ATTN_BLOCK
    qb = q.reshape(B, nb, ATTN_BLOCK, H, Dq).transpose(1, 0, 2, 3, 4)
    k_pos = jnp.arange(S)
    scale = QK_DIM ** -0.5

    def one_block(args):
        q_blk, blk = args
        s = jnp.einsum('bqhd,bkhd->bhqk', q_blk, k,
                       preferred_element_type=jnp.float32) * scale
        q_pos = blk * ATTN_BLOCK + jnp.arange(ATTN_BLOCK)
        s = jnp.where(k_pos[None, :] <= q_pos[:, None], s, -jnp.inf)
        p = jax.nn.softmax(s, axis=-1).astype(v.dtype)
        return jnp.einsum('bhqk,bkhd->bqhd', p, v)

    out = lax.map(one_block, (qb, jnp.arange(nb)))
    return out.transpose(1, 0, 2, 3, 4).reshape(B, S, H, v.shape[-1])


def token_mixer(h, cos, sin, lb, w_in, g_hg_out, w_o_hg, g_q_lora, w_uq,
                g_kv_lora, w_ukv, w_o_mla, w_out):
    B, S, _ = h.shape
    dt = h.dtype
    f32 = jnp.float32
    split_idx = tuple(int(i) for i in np.cumsum(IN_SIZES)[:-1])
    hq, hf, hi, hg, cq, ckv, kr, gate_a, gate_b = jnp.split(h @ w_in, split_idx, axis=-1)

    q = jax.nn.silu(hq.astype(f32)).reshape(B, S, HG_HEADS, HG_KDIM)
    f = lb + (1.0 - lb) * jax.nn.sigmoid(hf.astype(f32))
    log_f = jnp.log(f).reshape(B, S, HG_HEADS, HG_KDIM)
    k = (1.0 - f).reshape(B, S, HG_HEADS, HG_KDIM)
    v = hi.astype(f32).reshape(B, S, HG_HEADS, HG_VDIM)
    o = hgrn2_chunked(q, k, v, log_f)
    o = rmsnorm(o, g_hg_out) * jax.nn.silu(hg.astype(f32)).reshape(B, S, HG_HEADS, HG_VDIM)
    y_a = o.reshape(B, S, HG_VWIDTH).astype(dt) @ w_o_hg

    q_m = (rmsnorm(cq, g_q_lora) @ w_uq).reshape(B, S, MLA_HEADS, QK_DIM)
    q_nope, q_rope = jnp.split(q_m, [QK_NOPE], axis=-1)
    kv = (rmsnorm(ckv, g_kv_lora) @ w_ukv).reshape(B, S, MLA_HEADS, QK_NOPE + V_DIM)
    k_nope, v_m = jnp.split(kv, [QK_NOPE], axis=-1)
    q_rope = apply_rope(q_rope, cos[:, :, None, :], sin[:, :, None, :])
    k_rope = apply_rope(kr, cos, sin)
    q_full = jnp.concatenate([q_nope, q_rope], axis=-1)
    k_full = jnp.concatenate(
        [k_nope, jnp.broadcast_to(k_rope[:, :, None, :], (B, S, MLA_HEADS, QK_ROPE))], axis=-1)
    att = causal_block_attention(q_full, k_full, v_m)
    y_b = att.reshape(B, S, MLA_HEADS * V_DIM) @ w_o_mla

    merged = jax.nn.sigmoid(gate_a) * y_a + jax.nn.sigmoid(gate_b) * y_b
    return merged @ w_out


def swiglu(h, w_gate_up, w_down):
    gate, up = jnp.split(h @ w_gate_up, 2, axis=-1)
    return (jax.nn.silu(gate) * up) @ w_down


def setup_inputs(seed: int = 0) -> dict:
    key = jax.random.key(seed)
    ks = jax.random.split(key, 24)
    f32 = jnp.float32

    def nrm(k, shape, scale):
        return jax.random.normal(k, shape, f32) * scale

    def gain(k, shape):
        return 1.0 + 0.02 * jax.random.normal(k, shape, f32)

    L = DEPTH
    x = jax.random.normal(ks[0], (BATCH, SEQ, D_MODEL), f32)
    c = jax.random.normal(ks[1], (BATCH, D_MODEL), f32)
    offset = jax.random.randint(ks[2], (BATCH, 1), 0, 4096, dtype=jnp.int32)
    positions = (jnp.arange(SEQ, dtype=jnp.int32)[None, :] + offset).astype(jnp.int32)
    return {
        "x": x,
        "c": c,
        "positions": positions,
        "w_ada": nrm(ks[3], (L, D_MODEL, N_MOD * D_MODEL), 0.5 * D_MODEL ** -0.5),
        "b_ada": nrm(ks[4], (L, N_MOD * D_MODEL), 0.01),
        "g_pre_mix": gain(ks[5], (L, D_MODEL)),
        "w_in": nrm(ks[6], (L, D_MODEL, IN_WIDTH), D_MODEL ** -0.5),
        "lb_logits": nrm(ks[7], (DEPTH + 1, HG_FDIM), 0.1),
        "g_hg_out": gain(ks[8], (L, HG_VDIM)),
        "w_o_hg": nrm(ks[9], (L, HG_VWIDTH, D_MODEL), HG_VWIDTH ** -0.5),
        "g_q_lora": gain(ks[10], (L, Q_LORA)),
        "w_uq": nrm(ks[11], (L, Q_LORA, MLA_HEADS * QK_DIM), Q_LORA ** -0.5),
        "g_kv_lora": gain(ks[12], (L, KV_LORA)),
        "w_ukv": nrm(ks[13], (L, KV_LORA, MLA_HEADS * (QK_NOPE + V_DIM)), KV_LORA ** -0.5),
        "w_o_mla": nrm(ks[14], (L, MLA_HEADS * V_DIM, D_MODEL), (MLA_HEADS * V_DIM) ** -0.5),
        "w_out": nrm(ks[15], (L, D_MODEL, D_MODEL), D_MODEL ** -0.5),
        "g_post_mix": gain(ks[16], (L, D_MODEL)),
        "g_pre_ffn": gain(ks[17], (L, D_MODEL)),
        "w_gate_up": nrm(ks[18], (L, D_MODEL, 2 * D_FF), D_MODEL ** -0.5),
        "w_down": nrm(ks[19], (L, D_FF, D_MODEL), D_FF ** -0.5),
        "g_post_ffn": gain(ks[20], (L, D_MODEL)),
    }


def reference(x, c, positions, w_ada, b_ada, g_pre_mix, w_in, lb_logits, g_hg_out,
              w_o_hg, g_q_lora, w_uq, g_kv_lora, w_ukv, w_o_mla, w_out, g_post_mix,
              g_pre_ffn, w_gate_up, w_down, g_post_ffn):
    lb_all = jnp.cumsum(jax.nn.softmax(lb_logits.astype(jnp.float32), axis=0), axis=0)
    cos, sin = rope_tables(positions)
    for l in range(DEPTH):
        mod = jax.nn.silu(c) @ w_ada[l] + b_ada[l]
        sh_m, sc_m, ga_m, sh_f, sc_f, ga_f = jnp.split(mod[:, None, :], N_MOD, axis=-1)
        h = rmsnorm(x, g_pre_mix[l]) * (1.0 + sc_m) + sh_m
        y = token_mixer(h, cos, sin, lb_all[l], w_in[l], g_hg_out[l], w_o_hg[l],
                        g_q_lora[l], w_uq[l], g_kv_lora[l], w_ukv[l], w_o_mla[l], w_out[l])
        x = x + ga_m * rmsnorm(y, g_post_mix[l])
        h = rmsnorm(x, g_pre_ffn[l]) * (1.0 + sc_f) + sh_f
        y = swiglu(h, w_gate_up[l], w_down[l])
        x = x + ga_f * rmsnorm(y, g_post_ffn[l])
    return x
```

```cpp
#include <hip/hip_runtime.h>
#include <hip/hip_bf16.h>
#include <hip/hip_fp16.h>
#include <cstdio>
#include <cstdint>

typedef unsigned short bf16_t;
typedef unsigned short f16_t;

constexpr int S = 8192, D = 2048, H = 16, HK = 128, HV = 128;
constexpr int QL = 512, KVL = 512, NOPE = 128, ROPE = 64, VD = 128, QKD = 192;
constexpr int DFF = 5632, NMOD = 6;
constexpr int IN_W = 13376, IN_WP = 13568;
constexpr int UQ_W = 3072, UKV_W = 4096, GU_W = 11264;
constexpr float EPS = 1e-6f;
constexpr float QSCALE = 0.07216878364870322f * 1.4426950408889634f;

constexpr size_t MiB = 1u << 20;
constexpr size_t WS_CTL = 0;
constexpr size_t WS_MOD = 1 * MiB;
constexpr size_t WS_LB = 1 * MiB + 64 * 1024;
constexpr size_t WS_DG = 1 * MiB + 128 * 1024;
constexpr size_t WS_ROPE = 2 * MiB;
constexpr size_t WS_SSQ = 4 * MiB;
constexpr size_t WS_SSKV = 5 * MiB;
constexpr size_t WS_SSY = 6 * MiB;
constexpr size_t WS_SSY2 = 7 * MiB;
constexpr size_t WS_WIN = 8 * MiB;
constexpr size_t WS_QN = 8 * MiB;
constexpr size_t WS_QR = 40 * MiB;
constexpr size_t WS_WOHG = 61 * MiB;
constexpr size_t WS_WUQ = 69 * MiB;
constexpr size_t WS_WUKV = 72 * MiB;
constexpr size_t WS_WOMLA = 76 * MiB;
constexpr size_t WS_WOUT = 84 * MiB;
constexpr size_t WS_WGU = 92 * MiB;
constexpr size_t WS_WDN = 136 * MiB;
constexpr size_t WS_QH = 158 * MiB;
constexpr size_t WS_G16 = 190 * MiB;
constexpr size_t WS_V = 222 * MiB;
constexpr size_t WS_OG = 254 * MiB;
constexpr size_t WS_SA = 286 * MiB;
constexpr size_t WS_SB = 318 * MiB;
constexpr size_t WS_CQ = 350 * MiB;
constexpr size_t WS_CKV = 358 * MiB;
constexpr size_t WS_KR = 366 * MiB;
constexpr size_t WS_H = 368 * MiB;
constexpr size_t WS_KN = 368 * MiB;
constexpr size_t WS_U = 400 * MiB;
constexpr size_t WS_YAS = 158 * MiB;
constexpr size_t WS_MERGED = 222 * MiB;
constexpr size_t WS_Y = 254 * MiB;
constexpr size_t WS_ACT = 158 * MiB;
constexpr size_t WS_Y2 = 254 * MiB;
constexpr size_t WS_SCR2 = 318 * MiB;
constexpr size_t WS_END = 416 * MiB;

__device__ __forceinline__ float bf2f(bf16_t v) { return __uint_as_float((unsigned)v << 16); }
__device__ __forceinline__ bf16_t f2bf(float f) { unsigned u = __float_as_uint(f); return (bf16_t)((u + 0x7fffu + ((u >> 16) & 1u)) >> 16); }
__device__ __forceinline__ float h2f(f16_t v) { return __half2float(__ushort_as_half(v)); }
__device__ __forceinline__ f16_t f2h(float f) { return __half_as_ushort(__float2half_rn(f)); }
__device__ __forceinline__ float sigmoidf_(float x) { return 1.f / (1.f + __expf(-x)); }
__device__ __forceinline__ float siluf_(float x) { return x / (1.f + __expf(-x)); }

__host__ __device__ inline int src_in(int n) {
    if (n < 8192) return n;
    if (n < 10240) return n - 8192 + 9280;
    if (n < 12288) return n - 10240 + 11328;
    if (n < 12800) return n - 12288 + 8192;
    if (n < 13312) return n - 12800 + 8704;
    if (n < 13376) { const int i = n - 13312; return 9216 + 32 * (i & 1) + (i >> 1); }
    return -1;
}
__host__ __device__ inline int src_uq(int n) {
    if (n < 2048) return (n >> 7) * 192 + (n & 127);
    const int m = n - 2048, h = m >> 6, i = m & 63; return h * 192 + 128 + 32 * (i & 1) + (i >> 1);
}
__host__ __device__ inline int src_gu(int n) { const int t = n >> 8, r = n & 255; return r < 128 ? 128 * t + r : 5632 + 128 * t + (r - 128); }
__host__ __device__ inline int src_id(int n) { return n; }

namespace pg8 {
#define PG8_LAS __attribute__((address_space(3)))
typedef unsigned short bf16_t;
typedef short bf16x8 __attribute__((ext_vector_type(8)));
typedef float f32x4 __attribute__((ext_vector_type(4)));
typedef unsigned u32x4 __attribute__((ext_vector_type(4)));
constexpr int BM = 256, BK = 64, HALF = 128, HTB = HALF * BK * 2  , STAGE_BYTES = 8 * HTB, NXCD = 8, WGM = 8;

__host__ __device__ __forceinline__ int lds_byte(int r, int c) { const int st = (r >> 4) * 2 + (c >> 5), rr = r & 15, cc = c & 31, ob = rr * 64 + cc * 2; return st * 1024 + (ob ^ (((ob >> 9) & 1) << 5)); }
__host__ __device__ __forceinline__ void stage_rc(int b, int& R, int& C) { const int st = b / 1024, sb = b % 1024, swz = sb ^ (((sb >> 9) & 1) << 5); R = (st >> 1) * 16 + swz / 64; C = (st & 1) * 32 + (swz % 64) / 2; }
__host__ __device__ __forceinline__ int perm32(int rho) { const int n = rho >> 4, i = rho & 15; return 8 * (i >> 2) + 4 * n + (i & 3); }

struct Unit { int pm, pn; };
struct Gemm { const bf16_t* A; const bf16_t* Bt; int M, N, K; };

struct StaticOrder {
    int nM, nN, nwg, G, c;
    __host__ __device__ void init(int M, int N, int G_, int c_) { nM = M / BM; nN = N / BM; nwg = nM * nN; G = G_; c = c_; }
    __host__ __device__ bool next(int i, Unit& u) const {
        const long L = (long)i * G + c; if (L >= nwg) return false;
        int wgid = (int)L; { const int q = nwg / NXCD, r = nwg % NXCD, xcd = wgid % NXCD, off = wgid / NXCD; wgid = (xcd < r ? xcd * (q + 1) : r * (q + 1) + (xcd - r) * q) + off; }
        const int nig = WGM * nN, gid = wgid / nig, fm = gid * WGM, gsz = (nM - fm) < WGM ? (nM - fm) : WGM;
        u.pm = fm + ((wgid % nig) % gsz); u.pn = (wgid % nig) / gsz; return true;
    }
    __device__ __forceinline__ void a_ready(const Unit&) const {}
    __device__ __forceinline__ void done(const Unit&) const {}
};

__device__ __forceinline__ unsigned cvt_pk_bf16(float lo, float hi) { unsigned r; asm volatile("v_cvt_pk_bf16_f32 %0, %1, %2" : "=v"(r) : "v"(lo), "v"(hi)); return r; }
__device__ __forceinline__ float sigm(float x) { return __builtin_amdgcn_rcpf(1.f + __expf(-x)); }
__device__ __forceinline__ unsigned cvt_pk_f16(float lo, float hi) { typedef _Float16 h2v __attribute__((ext_vector_type(2))); h2v v = {(_Float16)lo, (_Float16)hi}; return __builtin_bit_cast(unsigned, v); }
__device__ __forceinline__ u32x4 pack_bf16x8(f32x4 a, f32x4 b) { u32x4 w; w.x = cvt_pk_bf16(a[0], a[1]); w.y = cvt_pk_bf16(a[2], a[3]); w.z = cvt_pk_bf16(b[0], b[1]); w.w = cvt_pk_bf16(b[2], b[3]); return w; }
__device__ __forceinline__ void unpack_bf16x8(u32x4 w, f32x4& a, f32x4& b) {
    a[0] = __uint_as_float(w.x << 16); a[1] = __uint_as_float(w.x & 0xffff0000u); a[2] = __uint_as_float(w.y << 16); a[3] = __uint_as_float(w.y & 0xffff0000u);
    b[0] = __uint_as_float(w.z << 16); b[1] = __uint_as_float(w.z & 0xffff0000u); b[2] = __uint_as_float(w.w << 16); b[3] = __uint_as_float(w.w & 0xffff0000u); }
__device__ __forceinline__ float sumsq8(f32x4 a, f32x4 b) { return ((a[0] * a[0] + a[1] * a[1]) + (a[2] * a[2] + a[3] * a[3])) + ((b[0] * b[0] + b[1] * b[1]) + (b[2] * b[2] + b[3] * b[3])); }

struct EpiIn {
    static constexpr bool PERM = true, AFTER_DRAIN = false;
    unsigned short *qh, *g16, *v, *og, *sa, *sb, *cq, *ckv, *kr; const float *lb, *rope; float *ssq, *sskv;
    template <int MODE> __device__ __forceinline__ void seg(const f32x4 (&acc)[2][2][4][2], unsigned short* base, int row0, int colb) const {
        f32x4 l0[2], l1[2];
        if (MODE == 3) {
#pragma unroll
            for (int bj = 0; bj < 2; ++bj) { l0[bj] = *(const f32x4*)(lb + colb + bj * HALF); l1[bj] = *(const f32x4*)(lb + colb + bj * HALF + 4); } }
#pragma unroll
        for (int ai = 0; ai < 2; ++ai)
#pragma unroll
            for (int m = 0; m < 4; ++m) { unsigned short* rowp = base + (size_t)(row0 + ai * HALF + m * 16) * 2048 + colb;
#pragma unroll
                for (int bj = 0; bj < 2; ++bj) { f32x4 a = acc[ai][bj][m][0], b = acc[ai][bj][m][1]; u32x4 w;
                    if (MODE == 1) {
#pragma unroll
                        for (int e = 0; e < 4; ++e) { a[e] = a[e] * sigm(a[e]); b[e] = b[e] * sigm(b[e]); } }
                    if (MODE == 2) {
#pragma unroll
                        for (int e = 0; e < 4; ++e) { a[e] = sigm(a[e]); b[e] = sigm(b[e]); } }
                    if (MODE == 3) {
#pragma unroll
                        for (int e = 0; e < 4; ++e) { a[e] = __logf(l0[bj][e] + (1.f - l0[bj][e]) * sigm(a[e])); b[e] = __logf(l1[bj][e] + (1.f - l1[bj][e]) * sigm(b[e])); }
                        w.x = cvt_pk_f16(a[0], a[1]); w.y = cvt_pk_f16(a[2], a[3]); w.z = cvt_pk_f16(b[0], b[1]); w.w = cvt_pk_f16(b[2], b[3]); }
                    else w = pack_bf16x8(a, b);
                    *(u32x4*)(rowp + bj * HALF) = w; } }
    }
    __device__ __forceinline__ void operator()(const f32x4 (&acc)[2][2][4][2], const Unit& u, int wr, int wc, int fr, int fq) const {
        const int row0 = u.pm * BM + wr * 64 + fr, pn = u.pn, cw = wc * 32 + 8 * fq;
        if (pn < 48) { const int sg = pn >> 3, colb = (pn & 7) * 256 + cw;
            if (sg == 0) seg<1>(acc, qh, row0, colb); else if (sg == 1) seg<3>(acc, g16, row0, colb); else if (sg == 2) seg<0>(acc, v, row0, colb);
            else if (sg == 3) seg<1>(acc, og, row0, colb); else if (sg == 4) seg<2>(acc, sa, row0, colb); else seg<2>(acc, sb, row0, colb); }
        else if (pn < 52) { unsigned short* base = pn < 50 ? cq : ckv; float* ss = pn < 50 ? ssq : sskv; const int colb = (pn & 1) * 256 + cw, slot = (pn & 1) * 4 + wc;
#pragma unroll
            for (int ai = 0; ai < 2; ++ai)
#pragma unroll
                for (int m = 0; m < 4; ++m) { const int row = row0 + ai * HALF + m * 16; unsigned short* rowp = base + (size_t)row * 512 + colb; float s = 0.f;
#pragma unroll
                    for (int bj = 0; bj < 2; ++bj) { const f32x4 a = acc[ai][bj][m][0], b = acc[ai][bj][m][1]; s += sumsq8(a, b); *(u32x4*)(rowp + bj * HALF) = pack_bf16x8(a, b); }
                    s += __shfl_xor(s, 16); s += __shfl_xor(s, 32);
                    if (fq == 0) ss[(size_t)row * 8 + slot] = s; } }
        else if (wc < 2) {
#pragma unroll
            for (int ai = 0; ai < 2; ++ai)
#pragma unroll
                for (int m = 0; m < 4; ++m) { const int row = row0 + ai * HALF + m * 16; const float* rp = rope + ((size_t)row * 32 + 16 * wc + 4 * fq) * 2;
                    const f32x4 c0 = *(const f32x4*)rp, c1 = *(const f32x4*)(rp + 4); const f32x4 a = acc[ai][0][m][0], b = acc[ai][0][m][1]; f32x4 oa, ob;
                    oa[0] = a[0] * c0[0] - a[1] * c0[1]; oa[1] = a[1] * c0[0] + a[0] * c0[1]; oa[2] = a[2] * c0[2] - a[3] * c0[3]; oa[3] = a[3] * c0[2] + a[2] * c0[3];
                    ob[0] = b[0] * c1[0] - b[1] * c1[1]; ob[1] = b[1] * c1[0] + b[0] * c1[1]; ob[2] = b[2] * c1[2] - b[3] * c1[3]; ob[3] = b[3] * c1[2] + b[2] * c1[3];
                    *(u32x4*)(kr + (size_t)row * 64 + cw) = pack_bf16x8(oa, ob); } }
    }
};
struct EpiUq {
    static constexpr bool PERM = true, AFTER_DRAIN = false;
    unsigned short *qn, *qr; const float *ssq, *rope; float qscale, eps;
    __device__ __forceinline__ void operator()(const f32x4 (&acc)[2][2][4][2], const Unit& u, int wr, int wc, int fr, int fq) const {
        const int row0 = u.pm * BM + wr * 64 + fr, pn = u.pn, cw = wc * 32 + 8 * fq;
#pragma unroll
        for (int ai = 0; ai < 2; ++ai)
#pragma unroll
            for (int m = 0; m < 4; ++m) { const int row = row0 + ai * HALF + m * 16;
                const f32x4 p0 = *(const f32x4*)(ssq + (size_t)row * 8), p1 = *(const f32x4*)(ssq + (size_t)row * 8 + 4);
                const float rs = __builtin_amdgcn_rsqf((((p0[0] + p0[1]) + (p0[2] + p0[3])) + ((p1[0] + p1[1]) + (p1[2] + p1[3]))) * (1.f / 512.f) + eps) * qscale;
                if (pn < 8) { unsigned short* rowp = qn + (size_t)row * 2048 + pn * 256 + cw;
#pragma unroll
                    for (int bj = 0; bj < 2; ++bj) *(u32x4*)(rowp + bj * HALF) = pack_bf16x8(acc[ai][bj][m][0] * rs, acc[ai][bj][m][1] * rs); }
                else { unsigned short* rowp = qr + (size_t)row * 1024 + (pn - 8) * 256 + cw; const float* rp = rope + ((size_t)row * 32 + 16 * (wc & 1) + 4 * fq) * 2;
                    const f32x4 c0 = *(const f32x4*)rp, c1 = *(const f32x4*)(rp + 4);
#pragma unroll
                    for (int bj = 0; bj < 2; ++bj) { const f32x4 a = acc[ai][bj][m][0] * rs, b = acc[ai][bj][m][1] * rs; f32x4 oa, ob;
                        oa[0] = a[0] * c0[0] - a[1] * c0[1]; oa[1] = a[1] * c0[0] + a[0] * c0[1]; oa[2] = a[2] * c0[2] - a[3] * c0[3]; oa[3] = a[3] * c0[2] + a[2] * c0[3];
                        ob[0] = b[0] * c1[0] - b[1] * c1[1]; ob[1] = b[1] * c1[0] + b[0] * c1[1]; ob[2] = b[2] * c1[2] - b[3] * c1[3]; ob[3] = b[3] * c1[2] + b[2] * c1[3];
                        *(u32x4*)(rowp + bj * HALF) = pack_bf16x8(oa, ob); } } }
    }
};
struct EpiUkv {
    static constexpr bool PERM = true, AFTER_DRAIN = false;
    unsigned short *kn, *vm; const float* sskv; float eps;
    __device__ __forceinline__ void operator()(const f32x4 (&acc)[2][2][4][2], const Unit& u, int wr, int wc, int fr, int fq) const {
        const int row0 = u.pm * BM + wr * 64 + fr, colb = u.pn * 128 + wc * 32 + 8 * fq;
#pragma unroll
        for (int ai = 0; ai < 2; ++ai)
#pragma unroll
            for (int m = 0; m < 4; ++m) { const int row = row0 + ai * HALF + m * 16;
                const f32x4 p0 = *(const f32x4*)(sskv + (size_t)row * 8), p1 = *(const f32x4*)(sskv + (size_t)row * 8 + 4);
                const float rs = __builtin_amdgcn_rsqf((((p0[0] + p0[1]) + (p0[2] + p0[3])) + ((p1[0] + p1[1]) + (p1[2] + p1[3]))) * (1.f / 512.f) + eps);
                *(u32x4*)(kn + (size_t)row * 2048 + colb) = pack_bf16x8(acc[ai][0][m][0] * rs, acc[ai][0][m][1] * rs);
                *(u32x4*)(vm + (size_t)row * 2048 + colb) = pack_bf16x8(acc[ai][1][m][0] * rs, acc[ai][1][m][1] * rs); }
    }
};
struct EpiYa {
    static constexpr bool PERM = true, AFTER_DRAIN = false;
    float* yas; const unsigned short* sa;
    __device__ __forceinline__ void operator()(const f32x4 (&acc)[2][2][4][2], const Unit& u, int wr, int wc, int fr, int fq) const {
        const int row0 = u.pm * BM + wr * 64 + fr, colb = u.pn * 256 + wc * 32 + 8 * fq;
#pragma unroll
        for (int ai = 0; ai < 2; ++ai)
#pragma unroll
            for (int m = 0; m < 4; ++m) { const size_t off = (size_t)(row0 + ai * HALF + m * 16) * 2048 + colb;
#pragma unroll
                for (int bj = 0; bj < 2; ++bj) { f32x4 ga, gb; unpack_bf16x8(*(const u32x4*)(sa + off + bj * HALF), ga, gb);
                    *(f32x4*)(yas + off + bj * HALF) = acc[ai][bj][m][0] * ga; *(f32x4*)(yas + off + bj * HALF + 4) = acc[ai][bj][m][1] * gb; } }
    }
};
struct EpiYb {
    static constexpr bool PERM = true, AFTER_DRAIN = false;
    const float* yas; const unsigned short* sb; unsigned short* merged;
    __device__ __forceinline__ void operator()(const f32x4 (&acc)[2][2][4][2], const Unit& u, int wr, int wc, int fr, int fq) const {
        const int row0 = u.pm * BM + wr * 64 + fr, colb = u.pn * 256 + wc * 32 + 8 * fq;
#pragma unroll
        for (int ai = 0; ai < 2; ++ai)
#pragma unroll
            for (int m = 0; m < 4; ++m) { const size_t off = (size_t)(row0 + ai * HALF + m * 16) * 2048 + colb;
#pragma unroll
                for (int bj = 0; bj < 2; ++bj) { f32x4 ga, gb; unpack_bf16x8(*(const u32x4*)(sb + off + bj * HALF), ga, gb);
                    const f32x4 y0 = *(const f32x4*)(yas + off + bj * HALF), y1 = *(const f32x4*)(yas + off + bj * HALF + 4);
                    *(u32x4*)(merged + off + bj * HALF) = pack_bf16x8(y0 + acc[ai][bj][m][0] * ga, y1 + acc[ai][bj][m][1] * gb); } }
    }
};
struct EpiF32SS {
    static constexpr bool PERM = true, AFTER_DRAIN = false;
    float* y; float* ss;
    __device__ __forceinline__ void operator()(const f32x4 (&acc)[2][2][4][2], const Unit& u, int wr, int wc, int fr, int fq) const {
        const int row0 = u.pm * BM + wr * 64 + fr, colb = u.pn * 256 + wc * 32 + 8 * fq, slot = u.pn * 4 + wc;
#pragma unroll
        for (int ai = 0; ai < 2; ++ai)
#pragma unroll
            for (int m = 0; m < 4; ++m) { const int row = row0 + ai * HALF + m * 16; const size_t off = (size_t)row * 2048 + colb; float s = 0.f;
#pragma unroll
                for (int bj = 0; bj < 2; ++bj) { const f32x4 a = acc[ai][bj][m][0], b = acc[ai][bj][m][1]; s += sumsq8(a, b);
                    *(f32x4*)(y + off + bj * HALF) = a; *(f32x4*)(y + off + bj * HALF + 4) = b; }
                s += __shfl_xor(s, 16); s += __shfl_xor(s, 32);
                if (fq == 0) ss[(size_t)row * 32 + slot] = s; }
    }
};
struct EpiGu {
    static constexpr bool PERM = true, AFTER_DRAIN = false;
    unsigned short* act; int ldc;
    __device__ __forceinline__ void operator()(const f32x4 (&acc)[2][2][4][2], const Unit& u, int wr, int wc, int fr, int fq) const {
        const int row0 = u.pm * BM + wr * 64 + fr, colb = u.pn * 128 + wc * 32 + 8 * fq;
#pragma unroll
        for (int ai = 0; ai < 2; ++ai)
#pragma unroll
            for (int m = 0; m < 4; ++m) { f32x4 a = acc[ai][0][m][0], b = acc[ai][0][m][1];
#pragma unroll
                for (int e = 0; e < 4; ++e) { a[e] = a[e] * sigm(a[e]) * acc[ai][1][m][0][e]; b[e] = b[e] * sigm(b[e]) * acc[ai][1][m][1][e]; }
                *(u32x4*)(act + (size_t)(row0 + ai * HALF + m * 16) * ldc + colb) = pack_bf16x8(a, b); }
    }
};
template <class Epi, class Sched, bool ALIGN_EPI = false, bool SP2 = false>
__device__ __forceinline__ void gemm_phase(PG8_LAS unsigned char* lds, const Gemm g, const Sched& S, const Epi& E) {
    const int tid = threadIdx.x, wid = __builtin_amdgcn_readfirstlane(tid >> 6), lane = tid & 63, wr = wid >> 2, wc = wid & 3, fr = lane & 15, fq = lane >> 4;
    const int K = g.K, nt = K / BK;
    unsigned voffA[2], voffB[2];
#pragma unroll
    for (int i = 0; i < 2; ++i) { int R, C; stage_rc(tid * 16 + i * 8192, R, C); const int Rb = Epi::PERM ? ((R & ~31) + perm32(R & 31)) : R;
        voffA[i] = (unsigned)(R * K + C) * 2u; voffB[i] = (unsigned)(Rb * K + C) * 2u; }
    const size_t kstep = (size_t)(BK * 2);
    const size_t hstep = (size_t)HALF * K * 2;
    const size_t tstep = 2 * hstep;
    const unsigned ldsw = (unsigned)wid * 1024u;
    const int aoff = lds_byte(wr * 64 + fr, fq * 8), boff = lds_byte(wc * 32 + fr, fq * 8);
#define PG8_SA(b, h) (((b) * 2 + (h)) * HTB)
#define PG8_SB(b, h) ((4 + (b) * 2 + (h)) * HTB)
#define PG8_STAGE(bufoff, gbase, voff) do { _Pragma("unroll") for (int _i = 0; _i < 2; ++_i) \
        __builtin_amdgcn_global_load_lds((const unsigned*)((const char*)(gbase) + (voff)[_i]), (PG8_LAS unsigned*)(lds + (bufoff) + ldsw + _i * 8192), 16, 0, 0); } while (0)
#define PG8_LDA(dst, b, h) do { _Pragma("unroll") for (int m = 0; m < 4; ++m) _Pragma("unroll") for (int k = 0; k < 2; ++k) dst[m][k] = *(const PG8_LAS bf16x8*)(lds + PG8_SA(b, h) + aoff + m * 2048 + k * 1024); } while (0)
#define PG8_LDB(dst, b, h) do { _Pragma("unroll") for (int n = 0; n < 2; ++n) _Pragma("unroll") for (int k = 0; k < 2; ++k) dst[n][k] = *(const PG8_LAS bf16x8*)(lds + PG8_SB(b, h) + boff + n * 2048 + k * 1024); } while (0)
#define PG8_MMA(ai, bj, At, Bt) do { __builtin_amdgcn_s_setprio(1); _Pragma("unroll") for (int m = 0; m < 4; ++m) _Pragma("unroll") for (int n = 0; n < 2; ++n) _Pragma("unroll") for (int k = 0; k < 2; ++k) \
        acc[ai][bj][m][n] = __builtin_amdgcn_mfma_f32_16x16x32_bf16(Bt[n][k], At[m][k], acc[ai][bj][m][n], 0, 0, 0); __builtin_amdgcn_s_setprio(0); } while (0)
#define PG8_WAIT_V(n) asm volatile("s_waitcnt vmcnt(" #n ")" ::: "memory")
#define PG8_WAIT_L(n) asm volatile("s_waitcnt lgkmcnt(" #n ")" ::: "memory")
#define PG8_BAR __builtin_amdgcn_s_barrier()
#define PG8_SCHED __builtin_amdgcn_sched_barrier(0)
    Unit cur, nxt; int ui = 0;
    if (!S.next(0, cur)) return;
    f32x4 acc[2][2][4][2];
#pragma unroll
    for (int a = 0; a < 2; ++a)
#pragma unroll
        for (int b = 0; b < 2; ++b)
#pragma unroll
            for (int m = 0; m < 4; ++m)
#pragma unroll
                for (int n = 0; n < 2; ++n) acc[a][b][m][n] = (f32x4){0.f, 0.f, 0.f, 0.f};
    bf16x8 At[4][2], B0[2][2], B1[2][2];
    const char* cA = (const char*)g.A + (size_t)cur.pm * tstep; const char* cB = (const char*)g.Bt + (size_t)cur.pn * tstep;
    S.a_ready(cur);
    if constexpr (SP2) {
        PG8_STAGE(PG8_SB(0, 0), cB, voffB); PG8_STAGE(PG8_SB(0, 1), cB + hstep, voffB); PG8_STAGE(PG8_SA(0, 0), cA, voffA); PG8_STAGE(PG8_SA(0, 1), cA + hstep, voffA);
        if (wr == 1) PG8_BAR;
        PG8_WAIT_V(2); PG8_BAR;
        PG8_STAGE(PG8_SB(1, 0), cB + kstep, voffB); PG8_STAGE(PG8_SA(1, 0), cA + kstep, voffA); PG8_STAGE(PG8_SB(1, 1), cB + hstep + kstep, voffB);
        PG8_WAIT_V(6); PG8_BAR;
    } else {
        PG8_STAGE(PG8_SB(0, 0), cB, voffB); PG8_STAGE(PG8_SA(0, 0), cA, voffA); PG8_STAGE(PG8_SB(0, 1), cB + hstep, voffB); PG8_STAGE(PG8_SA(0, 1), cA + hstep, voffA);
        if (wr == 1) PG8_BAR;
        PG8_WAIT_V(4); PG8_BAR;
        PG8_STAGE(PG8_SB(1, 0), cB + kstep, voffB); PG8_STAGE(PG8_SA(1, 0), cA + kstep, voffA); PG8_STAGE(PG8_SB(1, 1), cB + hstep + kstep, voffB);
        PG8_WAIT_V(6); PG8_BAR;
    }
    for (;;) {
        const bool has_next = S.next(ui + 1, nxt);
        const char* nA = has_next ? (const char*)g.A + (size_t)nxt.pm * tstep : cA; const char* nB = has_next ? (const char*)g.Bt + (size_t)nxt.pn * tstep : cB;
        for (int t = 0; t < nt; t += 2) {
            const bool last = (t == nt - 2);
            const char* a1 = cA + (size_t)(t + 1) * kstep;
            const char* a2 = last ? nA : cA + (size_t)(t + 2) * kstep; const char* b2 = last ? nB : cB + (size_t)(t + 2) * kstep;
            const char* a3 = a2 + kstep; const char* b3 = b2 + kstep;
            if (last && has_next) S.a_ready(nxt);
            if constexpr (SP2) {
            PG8_LDB(B0, 0, 0); PG8_LDB(B1, 0, 1); PG8_SCHED; PG8_LDA(At, 0, 0); PG8_STAGE(PG8_SA(1, 1), a1 + hstep, voffA);
            PG8_WAIT_V(8); PG8_WAIT_L(0); PG8_BAR; PG8_MMA(0, 0, At, B0); PG8_MMA(0, 1, At, B1); PG8_BAR; PG8_SCHED;
            PG8_LDA(At, 0, 1); PG8_STAGE(PG8_SB(0, 0), b2, voffB); PG8_STAGE(PG8_SB(0, 1), b2 + hstep, voffB); PG8_STAGE(PG8_SA(0, 0), a2, voffA);
            PG8_WAIT_V(8); PG8_WAIT_L(0); PG8_BAR; PG8_MMA(1, 0, At, B0); PG8_MMA(1, 1, At, B1); PG8_BAR; PG8_SCHED;
            PG8_LDB(B0, 1, 0); PG8_LDB(B1, 1, 1); PG8_SCHED; PG8_LDA(At, 1, 0); PG8_STAGE(PG8_SA(0, 1), a2 + hstep, voffA);
            PG8_WAIT_V(8); PG8_WAIT_L(0); PG8_BAR; PG8_MMA(0, 0, At, B0); PG8_MMA(0, 1, At, B1); PG8_BAR; PG8_SCHED;
            PG8_LDA(At, 1, 1); PG8_STAGE(PG8_SB(1, 0), b3, voffB); PG8_STAGE(PG8_SB(1, 1), b3 + hstep, voffB); PG8_STAGE(PG8_SA(1, 0), a3, voffA);
            PG8_WAIT_V(8); PG8_WAIT_L(0); PG8_BAR; PG8_MMA(1, 0, At, B0); PG8_MMA(1, 1, At, B1); PG8_BAR; PG8_SCHED;
            } else {
            PG8_LDB(B0, 0, 0); PG8_SCHED; PG8_LDA(At, 0, 0); PG8_STAGE(PG8_SA(1, 1), a1 + hstep, voffA);
            PG8_WAIT_L(8); PG8_BAR; PG8_WAIT_L(0); PG8_MMA(0, 0, At, B0); PG8_BAR; PG8_SCHED;
            PG8_LDB(B1, 0, 1); PG8_STAGE(PG8_SB(0, 0), b2, voffB);
            PG8_BAR; PG8_WAIT_L(0); PG8_MMA(0, 1, At, B1); PG8_BAR;
            PG8_LDA(At, 0, 1); PG8_STAGE(PG8_SA(0, 0), a2, voffA);
            PG8_BAR; PG8_WAIT_L(0); PG8_MMA(1, 0, At, B0); PG8_BAR; PG8_SCHED;
            PG8_STAGE(PG8_SB(0, 1), b2 + hstep, voffB);
            PG8_WAIT_V(6); PG8_BAR; PG8_MMA(1, 1, At, B1); PG8_BAR;
            PG8_LDB(B0, 1, 0); PG8_SCHED; PG8_LDA(At, 1, 0); PG8_STAGE(PG8_SA(0, 1), a2 + hstep, voffA);
            PG8_WAIT_L(8); PG8_BAR; PG8_WAIT_L(0); PG8_MMA(0, 0, At, B0); PG8_BAR; PG8_SCHED;
            PG8_LDB(B1, 1, 1); PG8_STAGE(PG8_SB(1, 0), b3, voffB);
            PG8_BAR; PG8_WAIT_L(0); PG8_MMA(0, 1, At, B1); PG8_BAR;
            PG8_LDA(At, 1, 1); PG8_STAGE(PG8_SA(1, 0), a3, voffA);
            PG8_BAR; PG8_WAIT_L(0); PG8_MMA(1, 0, At, B0); PG8_BAR; PG8_SCHED;
            PG8_STAGE(PG8_SB(1, 1), b3 + hstep, voffB);
            PG8_WAIT_V(6); PG8_BAR; PG8_MMA(1, 1, At, B1); PG8_BAR;
            }
        }
        if constexpr (ALIGN_EPI) { if (wr == 0) PG8_BAR; }
        if constexpr (!Epi::AFTER_DRAIN) { E(acc, cur, wr, wc, fr, fq); S.done(cur); }
        if (!has_next) break;
#pragma unroll
        for (int a = 0; a < 2; ++a)
#pragma unroll
            for (int b = 0; b < 2; ++b)
#pragma unroll
                for (int m = 0; m < 4; ++m)
#pragma unroll
                    for (int n = 0; n < 2; ++n) acc[a][b][m][n] = (f32x4){0.f, 0.f, 0.f, 0.f};
        cur = nxt; cA = nA; cB = nB; ++ui;
        if constexpr (ALIGN_EPI) { if (wr == 1) PG8_BAR; }
    }
    PG8_WAIT_V(0);
    if constexpr (!ALIGN_EPI) { if (wr == 0) PG8_BAR; }
    PG8_BAR;
    if constexpr (Epi::AFTER_DRAIN) { E.fused(acc, cur, wr, wc, fr, fq, lds, wid, lane); S.done(cur); }
#undef PG8_SA
#undef PG8_SB
#undef PG8_STAGE
#undef PG8_LDA
#undef PG8_LDB
#undef PG8_MMA
#undef PG8_WAIT_V
#undef PG8_WAIT_L
#undef PG8_BAR
#undef PG8_SCHED
}
}
namespace att {
typedef short bf16x8 __attribute__((ext_vector_type(8)));
typedef short s16x4 __attribute__((ext_vector_type(4)));
typedef float f32x16 __attribute__((ext_vector_type(16)));
typedef unsigned u32x4 __attribute__((ext_vector_type(4)));
constexpr int NW = 8, QBLK = 32, KVBLK = 64, QB = NW * QBLK;
constexpr int SHM_V = KVBLK * 128 * 2, SHM_K = KVBLK * 128 * 2, SHM_R = KVBLK * 64 * 2;
constexpr int OFF_V = 0, OFF_K = 2 * SHM_V, OFF_R = OFF_K + 2 * SHM_K, OFF_WS = OFF_R + 2 * SHM_R, OFF_QR = OFF_WS + NW * 64 * 4, LDS_BYTES = OFF_QR + NW * 4096;
constexpr float THR2 = 11.5f;
constexpr int LDQ = 2048, LDR = 1024, LDK = 2048, LDKR = 64;
#define LAS3 __attribute__((address_space(3)))
#define KSWZ(row, colB) ((row) * 256 + ((colB) ^ (((row) & 7) << 4)))
#define SBAR() __builtin_amdgcn_sched_barrier(0)
__device__ __forceinline__ int v_st(int k, int c) { const int kk = (k & ~0xC) | ((k & 4) << 1) | ((k & 8) >> 1); return ((kk >> 3) * 4 + (c >> 5)) * 512 + ((kk & 7) * 32 + (c & 31)) * 2; }
__device__ __forceinline__ int v_rd_base(int lane) { return ((lane & 3) << 3) | (((lane >> 2) & 3) << 6) | (((lane >> 4) & 1) << 5) | (((lane >> 5) & 1) << 8); }
constexpr int v_rd_off(int d0, int ks, int half) { return d0 * 512 + ks * 4096 + half * 2048; }
__device__ __forceinline__ int crow(int r, int hi) { return (r & 3) + 8 * (r >> 2) + 4 * hi; }
__device__ __forceinline__ unsigned cvtpk(float lo, float hi) { unsigned r; asm volatile("v_cvt_pk_bf16_f32 %0, %1, %2" : "=v"(r) : "v"(lo), "v"(hi)); return r; }
__device__ __forceinline__ bf16x8 ld8(const bf16_t* p) { return *reinterpret_cast<const bf16x8*>(p); }
__device__ __forceinline__ void mask_tile(f32x16& p0, f32x16& p1, int dq) {
    const float NEG = -__builtin_inff();
#pragma unroll
    for (int r = 0; r < 16; ++r) { const int c = (r & 3) + 8 * (r >> 2); if (dq - c < 0) p0[r] = NEG; if (dq - c - 32 < 0) p1[r] = NEG; }
}
__device__ __forceinline__ void partialSM(f32x16& p0, f32x16& p1, float& m_reg, float& mn, float& alpha) {
    float pmax = p0[0]; for (int r = 1; r < 16; ++r) pmax = fmaxf(pmax, p0[r]); for (int r = 0; r < 16; ++r) pmax = fmaxf(pmax, p1[r]);
    { auto rr = __builtin_amdgcn_permlane32_swap(__float_as_uint(pmax), __float_as_uint(pmax), false, false); pmax = fmaxf(__uint_as_float(rr[0]), __uint_as_float(rr[1])); }
    if (__builtin_expect(__all((pmax - m_reg) <= THR2), 1)) { mn = m_reg; alpha = 1.f; }
    else { mn = fmaxf(m_reg, pmax); alpha = __builtin_amdgcn_exp2f(m_reg - mn); m_reg = mn; }
    for (int r = 0; r < 16; ++r) p0[r] = p0[r] - mn; for (int r = 0; r < 16; ++r) p1[r] = p1[r] - mn;
    for (int r = 0; r < 16; ++r) p0[r] = __builtin_amdgcn_exp2f(p0[r]);
}
__device__ __forceinline__ void finishSM(f32x16& p0, f32x16& p1, float alpha, float& l_reg, bf16x8& pa0, bf16x8& pa1, bf16x8& pa2, bf16x8& pa3) {
    for (int r = 0; r < 16; ++r) p1[r] = __builtin_amdgcn_exp2f(p1[r]);
    float ps = 0; for (int r = 0; r < 16; ++r) ps += p0[r]; for (int r = 0; r < 16; ++r) ps += p1[r];
    { auto rr = __builtin_amdgcn_permlane32_swap(__float_as_uint(ps), __float_as_uint(ps), false, false); ps = __uint_as_float(rr[0]) + __uint_as_float(rr[1]); }
    l_reg = l_reg * alpha + ps;
#define PK4(P, B_, OUT) do { unsigned a0 = cvtpk(P[B_+0], P[B_+1]), a1 = cvtpk(P[B_+2], P[B_+3]); unsigned b0 = cvtpk(P[B_+4], P[B_+5]), b1 = cvtpk(P[B_+6], P[B_+7]); \
        auto r0 = __builtin_amdgcn_permlane32_swap(a0, b0, false, false); auto r1 = __builtin_amdgcn_permlane32_swap(a1, b1, false, false); \
        u32x4 w = {r0[0], r1[0], r0[1], r1[1]}; OUT = *reinterpret_cast<bf16x8*>(&w); } while (0)
    PK4(p0, 0, pa0); PK4(p0, 8, pa1); PK4(p1, 0, pa2); PK4(p1, 8, pa3);
#undef PK4
}
template <int KB> __device__ __forceinline__ void qkt(f32x16& p0, f32x16& p1, const char* lds, int r32, int hi, const bf16x8* qr, const char* qrl) {
    p0 = f32x16{}; p1 = f32x16{};
    const char* kb[4];
#pragma unroll
    for (int dd = 0; dd < 4; ++dd) kb[dd] = lds + OFF_K + KB * SHM_K + KSWZ(r32, (dd * 16 + hi * 8) * 2);
#pragma unroll
    for (int d0 = 0; d0 < 8; ++d0) { const char* a = kb[d0 & 3] + (d0 >> 2) * 128;
        bf16x8 b0 = *reinterpret_cast<const bf16x8*>(a); bf16x8 b1 = *reinterpret_cast<const bf16x8*>(a + 32 * 256);
        p0 = __builtin_amdgcn_mfma_f32_32x32x16_bf16(b0, qr[d0], p0, 0, 0, 0); p1 = __builtin_amdgcn_mfma_f32_32x32x16_bf16(b1, qr[d0], p1, 0, 0, 0);
        if (d0 == 3 || d0 == 7) SBAR(); }
#pragma unroll
    for (int d0 = 0; d0 < 4; ++d0) { const char* a = lds + OFF_R + KB * SHM_R + d0 * 2048 + r32 * 32 + hi * 16;
        bf16x8 b0 = *reinterpret_cast<const bf16x8*>(a); bf16x8 b1 = *reinterpret_cast<const bf16x8*>(a + 1024);
        const bf16x8 qf = *reinterpret_cast<const bf16x8*>(qrl + d0 * 1024);
        p0 = __builtin_amdgcn_mfma_f32_32x32x16_bf16(b0, qf, p0, 0, 0, 0); p1 = __builtin_amdgcn_mfma_f32_32x32x16_bf16(b1, qf, p1, 0, 0, 0); }
}
template <int VB> __device__ __forceinline__ void pv_tile(f32x16* o, int vb0, bf16x8 pa0, bf16x8 pa1, bf16x8 pa2, bf16x8 pa3) {
#define TRRD(dst, off) asm volatile("ds_read_b64_tr_b16 %0, %1 offset:%2" : "=&v"(dst) : "v"(vb0), "i"(off) : "memory")
#define PV_D0(d0) do { s16x4 l0, l1, l2, l3, h0, h1, h2, h3; constexpr int b_ = OFF_V + VB * SHM_V + v_rd_off(d0, 0, 0); \
        TRRD(l0, b_); TRRD(h0, b_ + 2048); TRRD(l1, b_ + 4096); TRRD(h1, b_ + 6144); TRRD(l2, b_ + 8192); TRRD(h2, b_ + 10240); TRRD(l3, b_ + 12288); TRRD(h3, b_ + 14336); \
        asm volatile("s_waitcnt lgkmcnt(0)" ::: "memory"); SBAR(); \
        o[d0] = __builtin_amdgcn_mfma_f32_32x32x16_bf16(pa0, (bf16x8){l0[0], l0[1], l0[2], l0[3], h0[0], h0[1], h0[2], h0[3]}, o[d0], 0, 0, 0); \
        o[d0] = __builtin_amdgcn_mfma_f32_32x32x16_bf16(pa1, (bf16x8){l1[0], l1[1], l1[2], l1[3], h1[0], h1[1], h1[2], h1[3]}, o[d0], 0, 0, 0); \
        o[d0] = __builtin_amdgcn_mfma_f32_32x32x16_bf16(pa2, (bf16x8){l2[0], l2[1], l2[2], l2[3], h2[0], h2[1], h2[2], h2[3]}, o[d0], 0, 0, 0); \
        o[d0] = __builtin_amdgcn_mfma_f32_32x32x16_bf16(pa3, (bf16x8){l3[0], l3[1], l3[2], l3[3], h3[0], h3[1], h3[2], h3[3]}, o[d0], 0, 0, 0); } while (0)
    PV_D0(0); PV_D0(1); PV_D0(2); PV_D0(3);
#undef PV_D0
#undef TRRD
}
struct BlockRef { const bf16_t* Qn; const bf16_t* Qr; const bf16_t* K; const bf16_t* V; bf16_t* O; int P0; };
#define DMA16(src, dstoff) __builtin_amdgcn_global_load_lds((const unsigned*)(src), (LAS3 unsigned*)(lds3 + (dstoff)), 16, 0, 0)
#define DMA_K(t, bf) do { const bf16_t* s_ = Kh + (size_t)(t) * (KVBLK * LDK); DMA16(s_ + koff0, OFF_K + (bf) * SHM_K + wid * 2048); DMA16(s_ + koff1, OFF_K + (bf) * SHM_K + wid * 2048 + 1024); } while (0)
#define DMA_V(t, bf) do { const bf16_t* s_ = Vh + (size_t)(t) * (KVBLK * LDK); DMA16(s_ + voff0, OFF_V + (bf) * SHM_V + wid * 2048); DMA16(s_ + voff0 + 64, OFF_V + (bf) * SHM_V + wid * 2048 + 1024); } while (0)
#define DMA_R(t, bf) DMA16(KR + (size_t)(t) * (KVBLK * LDKR) + roff, OFF_R + (bf) * SHM_R + wid * 1024)
#define WAIT_BAR() asm volatile("s_waitcnt vmcnt(0) lgkmcnt(0)\n\ts_barrier" ::: "memory")
__device__ __forceinline__ void block(const BlockRef& cur, const bf16_t* KR, char* lds, LAS3 unsigned char* lds3) {
    const int tid = threadIdx.x, wid = __builtin_amdgcn_readfirstlane(tid >> 6), lane = tid & 63, r32 = lane & 31, hi = lane >> 5;
    const int NT = (cur.P0 + QB) / KVBLK;
    const int qlo = cur.P0 + wid * QBLK, qm = qlo + r32 - 4 * hi;
    float* ws = (float*)(lds + OFF_WS) + wid * 64; float* li_l = ws, * al_l = ws + 32;
    float m_reg = -1e30f, l_reg = 0; f32x16 o[4] = {};
    const int vb0 = (int)(uintptr_t)lds + v_rd_base(lane);
    char* qrl = lds + OFF_QR + wid * 4096 + lane * 16;
    const bf16_t* Kh = cur.K; const bf16_t* Vh = cur.V;
    const int kr0 = lane >> 4, kr1 = 4 + (lane >> 4);
    const int koff0 = (wid * 8 + kr0) * LDK + (((lane & 15) ^ kr0) << 3), koff1 = (wid * 8 + kr1) * LDK + (((lane & 15) ^ kr1) << 3);
    const int vkk = wid * 8 + ((lane & 31) >> 2), vk = (vkk & ~0xC) | ((vkk & 4) << 1) | ((vkk & 8) >> 1);
    const int voff0 = vk * LDK + (lane >> 5) * 32 + (lane & 3) * 8;
    const int roff = ((wid & 1) * 32 + (lane >> 1)) * LDKR + (wid >> 1) * 16 + (lane & 1) * 8;
    bf16x8 qr[8];
#define RESC(a) do { if (__any((a) < 1.f)) { if (hi == 0) al_l[r32] = (a); asm volatile("s_waitcnt lgkmcnt(0)" ::: "memory"); \
                     for (int d_ = 0; d_ < 4; ++d_) for (int r = 0; r < 16; ++r) o[d_][r] *= al_l[crow(r, hi)]; } } while (0)
#define KBASE(t) ((t) * KVBLK)
#define MASKT(P0_, P1_, t) do { const int kb_ = KBASE(t); if (kb_ + KVBLK - 1 > qlo) mask_tile(P0_, P1_, qm - kb_); } while (0)
    f32x16 pA0, pA1, pB0, pB1; float mnA, mnB, alA, alB; bf16x8 pa0, pa1, pa2, pa3;
    DMA_K(0, 0); DMA_R(0, 0);
#pragma unroll
    for (int d0 = 0; d0 < 8; ++d0) qr[d0] = ld8(cur.Qn + (size_t)(wid * QBLK + r32) * LDQ + d0 * 16 + hi * 8);
    { bf16x8 t_[4];
#pragma unroll
      for (int d0 = 0; d0 < 4; ++d0) t_[d0] = ld8(cur.Qr + (size_t)(wid * QBLK + r32) * LDR + d0 * 16 + hi * 8);
#pragma unroll
      for (int d0 = 0; d0 < 4; ++d0) *(bf16x8*)(qrl + d0 * 1024) = t_[d0]; }
    WAIT_BAR();
    DMA_K(1, 1); DMA_R(1, 1); DMA_V(0, 0);
    SBAR(); qkt<0>(pA0, pA1, lds, r32, hi, qr, qrl);
    MASKT(pA0, pA1, 0); partialSM(pA0, pA1, m_reg, mnA, alA);
    WAIT_BAR();
#define STEP(PX0, PX1, mnX, alX, PY0, PY1, alY, t, KB, VB) do { \
        if ((t) + 1 < NT) { DMA_K((t) + 1, VB); DMA_R((t) + 1, VB); } DMA_V((t), KB); \
        SBAR(); qkt<KB>(PX0, PX1, lds, r32, hi, qr, qrl); \
        finishSM(PY0, PY1, alY, l_reg, pa0, pa1, pa2, pa3); SBAR(); \
        pv_tile<VB>(o, vb0, pa0, pa1, pa2, pa3); MASKT(PX0, PX1, (t)); partialSM(PX0, PX1, m_reg, mnX, alX); \
        RESC(alX); WAIT_BAR(); } while (0)
    for (int t = 1; t + 1 < NT; t += 2) {
        STEP(pB0, pB1, mnB, alB, pA0, pA1, alA, t, 1, 0);
        STEP(pA0, pA1, mnA, alA, pB0, pB1, alB, t + 1, 0, 1);
    }
    STEP(pB0, pB1, mnB, alB, pA0, pA1, alA, NT - 1, 1, 0);
    finishSM(pB0, pB1, alB, l_reg, pa0, pa1, pa2, pa3); SBAR(); pv_tile<1>(o, vb0, pa0, pa1, pa2, pa3);
    if (hi == 0) li_l[r32] = l_reg; asm volatile("s_waitcnt lgkmcnt(0)" ::: "memory");
    float rli[16];
#pragma unroll
    for (int r = 0; r < 16; ++r) rli[r] = __builtin_amdgcn_rcpf(li_l[crow(r, hi)]);
    bf16_t* Ow = cur.O + (size_t)(wid * QBLK) * LDQ;
#pragma unroll
    for (int r = 0; r < 16; ++r) { const int orow = crow(r, hi);
#pragma unroll
        for (int d0 = 0; d0 < 4; ++d0) { const float v = o[d0][r] * rli[r]; const float vn = __shfl_xor(v, 1);
            if ((r32 & 1) == 0) *(unsigned*)(Ow + (size_t)orow * LDQ + d0 * 32 + r32) = cvtpk(v, vn); } }
    WAIT_BAR();
#undef RESC
#undef KBASE
#undef MASKT
#undef STEP
}
#undef DMA16
#undef DMA_K
#undef DMA_V
#undef DMA_R
#undef WAIT_BAR
__device__ __forceinline__ BlockRef make_ref(int h, int qb, bf16_t* qn, const bf16_t* qr, const bf16_t* kn, const bf16_t* vm) {
    BlockRef r; r.Qn = qn + (size_t)qb * QB * LDQ + h * 128; r.Qr = qr + (size_t)qb * QB * LDR + h * 64; r.K = kn + h * 128; r.V = vm + h * 128; r.O = qn + (size_t)qb * QB * LDQ + h * 128; r.P0 = qb * QB; return r;
}
__device__ __forceinline__ void phase(char* lds, LAS3 unsigned char* lds3, bf16_t* qn, const bf16_t* qr, const bf16_t* kn, const bf16_t* kr, const bf16_t* vm, int vcu, int G) {
    constexpr int NITEMS = H * 16;
    for (int L = vcu; L < NITEMS; L += G) {
        const int h = L >> 4, x = L & 15;
        block(make_ref(h, x, qn, qr, kn, vm), kr, lds, lds3);
        block(make_ref(h, 31 - x, qn, qr, kn, vm), kr, lds, lds3);
    }
}
#undef KSWZ
#undef LAS3
#undef SBAR
}
namespace hg {
typedef short bf16x8 __attribute__((ext_vector_type(8)));
typedef short s16x4 __attribute__((ext_vector_type(4)));
typedef float f32x16 __attribute__((ext_vector_type(16)));
typedef float f32x4 __attribute__((ext_vector_type(4)));
typedef unsigned u32x4 __attribute__((ext_vector_type(4)));
typedef unsigned u32x2 __attribute__((ext_vector_type(2)));
typedef _Float16 f16x8 __attribute__((ext_vector_type(8)));
#define LAS3 __attribute__((address_space(3)))
#define KSWZ(row, colB) ((row) * 256 + ((colB) ^ (((row) & 7) << 4)))
#define SBAR() __builtin_amdgcn_sched_barrier(0)
constexpr int O_QES = 0, O_KES = 16384, O_KET = 32768, O_V = 49152, O_ST = 65536, O_BL = 98304, O_SEG = 131072, O_DL = 133120, O_END = 133632;
constexpr int LD = 2048;
__device__ __forceinline__ int crow(int r, int hi) { return (r & 3) + 8 * (r >> 2) + 4 * hi; }
__device__ __forceinline__ unsigned cvtpk(float lo, float hi) { unsigned r; asm volatile("v_cvt_pk_bf16_f32 %0, %1, %2" : "=v"(r) : "v"(lo), "v"(hi)); return r; }
__device__ __forceinline__ int v_rd_base(int lane) { return ((lane & 3) << 3) | (((lane >> 2) & 3) << 6) | (((lane >> 4) & 1) << 5) | (((lane >> 5) & 1) << 8); }

struct Ptrs { const bf16_t* qh; const f16_t* g16; const bf16_t* v; bf16_t* og; const float* ghg; float* U; float* Dg; };

template <bool OUT>
__device__ __forceinline__ void unit(char* lds, LAS3 unsigned char* lds3, const Ptrs& P, int h, int grp) {
    const int tid = threadIdx.x, wid = __builtin_amdgcn_readfirstlane(tid >> 6), lane = tid & 63, r32 = lane & 31, hi = lane >> 5;
    const int tb = wid & 1, vq = wid >> 1;
    const size_t colh = (size_t)h * 128;
    const int vkk = wid * 8 + ((lane & 31) >> 2), vk = (vkk & ~0xC) | ((vkk & 4) << 1) | ((vkk & 8) >> 1);
    const int voff0 = vk * LD + (lane >> 5) * 32 + (lane & 3) * 8;
    const int vb = (int)(uintptr_t)lds + O_V + v_rd_base(lane) + vq * 512;
    f32x16 Sf[2];
    float gsum[16];
#pragma unroll
    for (int j = 0; j < 16; ++j) gsum[j] = 0.f;
    if (OUT) {
        const float* Sin = P.U + ((size_t)(grp * 16 + h) * 128) * 128;
#pragma unroll
        for (int i = 0; i < 2; ++i)
#pragma unroll
            for (int r = 0; r < 16; ++r) Sf[i][r] = Sin[(size_t)(32 * (2 * tb + i) + crow(r, hi)) * 128 + 32 * vq + r32];
    } else { Sf[0] = f32x16{}; Sf[1] = f32x16{}; }
#define WRITE_ST() do { _Pragma("unroll") for (int i = 0; i < 2; ++i) _Pragma("unroll") for (int g = 0; g < 4; ++g) { const int row = 32 * vq + r32, ch = 4 * (2 * tb + i) + g; \
        u32x2 w; w.x = cvtpk(Sf[i][4 * g], Sf[i][4 * g + 1]); w.y = cvtpk(Sf[i][4 * g + 2], Sf[i][4 * g + 3]); \
        *(u32x2*)(lds + O_ST + row * 256 + ((ch * 16) ^ ((row & 7) << 4)) + 8 * hi) = w; } } while (0)
    if (OUT) WRITE_ST();
    for (int c = 0; c < 8; ++c) {
        const size_t tok0 = (size_t)grp * 512 + c * 64;
        { const bf16_t* s_ = P.v + tok0 * LD + colh;
          __builtin_amdgcn_global_load_lds((const unsigned*)(s_ + voff0), (LAS3 unsigned*)(lds3 + O_V + wid * 2048), 16, 0, 0);
          __builtin_amdgcn_global_load_lds((const unsigned*)(s_ + voff0 + 64), (LAS3 unsigned*)(lds3 + O_V + wid * 2048 + 1024), 16, 0, 0); }
        { const int k = tid & 127, qd = tid >> 7; const f16_t* gp = P.g16 + (tok0 + 16 * qd) * LD + colh + k; float cs = 0.f; float* bl = (float*)(lds + O_BL) + (16 * qd) * 128 + k;
          float gv[16];
#pragma unroll
          for (int i = 0; i < 16; ++i) gv[i] = h2f(gp[(size_t)i * LD]);
#pragma unroll
          for (int i = 0; i < 16; ++i) { cs += gv[i]; bl[i * 128] = cs; }
          ((float*)(lds + O_SEG))[qd * 128 + k] = cs; }
        __syncthreads();
        { const int t = tid >> 3, kc = (tid & 7) * 16, qd = t >> 4; float b[16];
          const float* bl = (const float*)(lds + O_BL) + t * 128 + kc; const float* sg = (const float*)(lds + O_SEG) + kc;
#pragma unroll
          for (int j4 = 0; j4 < 4; ++j4) { f32x4 x = *(const f32x4*)(bl + 4 * j4);
              if (qd > 0) x += *(const f32x4*)(sg + 4 * j4); if (qd > 1) x += *(const f32x4*)(sg + 128 + 4 * j4); if (qd > 2) x += *(const f32x4*)(sg + 256 + 4 * j4);
              b[4 * j4] = x[0]; b[4 * j4 + 1] = x[1]; b[4 * j4 + 2] = x[2]; b[4 * j4 + 3] = x[3]; }
          const f16x8 g0 = *(const f16x8*)(P.g16 + (tok0 + t) * LD + colh + kc), g1 = *(const f16x8*)(P.g16 + (tok0 + t) * LD + colh + kc + 8);
          float ke[16], qe[16];
#pragma unroll
          for (int j = 0; j < 16; ++j) { const float gl = (float)(j < 8 ? g0[j] : g1[j - 8]); ke[j] = (1.f - __expf(gl)) * __expf(-b[j]); }
          if (OUT) { const bf16x8 q0 = *(const bf16x8*)(P.qh + (tok0 + t) * LD + colh + kc), q1 = *(const bf16x8*)(P.qh + (tok0 + t) * LD + colh + kc + 8);
#pragma unroll
              for (int j = 0; j < 16; ++j) qe[j] = bf2f((bf16_t)(j < 8 ? q0[j] : q1[j - 8])) * __expf(b[j]);
              u32x4 w0 = {cvtpk(qe[0], qe[1]), cvtpk(qe[2], qe[3]), cvtpk(qe[4], qe[5]), cvtpk(qe[6], qe[7])}, w1 = {cvtpk(qe[8], qe[9]), cvtpk(qe[10], qe[11]), cvtpk(qe[12], qe[13]), cvtpk(qe[14], qe[15])};
              *(u32x4*)(lds + O_QES + KSWZ(t, kc * 2)) = w0; *(u32x4*)(lds + O_QES + KSWZ(t, kc * 2 + 16)) = w1;
              u32x4 k0 = {cvtpk(ke[0], ke[1]), cvtpk(ke[2], ke[3]), cvtpk(ke[4], ke[5]), cvtpk(ke[6], ke[7])}, k1 = {cvtpk(ke[8], ke[9]), cvtpk(ke[10], ke[11]), cvtpk(ke[12], ke[13]), cvtpk(ke[14], ke[15])};
              *(u32x4*)(lds + O_KES + KSWZ(t, kc * 2)) = k0; *(u32x4*)(lds + O_KES + KSWZ(t, kc * 2 + 16)) = k1; }
          { char* kt = lds + O_KET + (t >> 4) * 4096 + kc * 32 + ((t >> 3) & 1) * 16 + (t & 7) * 2;
#pragma unroll
            for (int j = 0; j < 16; ++j) *(unsigned short*)(kt + j * 32) = f2bf(ke[j]); }
          if (t == 63) {
#pragma unroll
              for (int j = 0; j < 16; ++j) { ((float*)(lds + O_DL))[kc + j] = __expf(b[j]); gsum[j] += b[j]; } } }
        asm volatile("s_waitcnt vmcnt(0)" ::: "memory");
        __syncthreads();
        bf16x8 vf[4];
        { s16x4 lo[4], hh[4];
#pragma unroll
          for (int ks = 0; ks < 4; ++ks) { asm volatile("ds_read_b64_tr_b16 %0, %1 offset:%2" : "=&v"(lo[ks]) : "v"(vb), "i"(ks * 4096) : "memory"); asm volatile("ds_read_b64_tr_b16 %0, %1 offset:%2" : "=&v"(hh[ks]) : "v"(vb), "i"(ks * 4096 + 2048) : "memory"); }
          asm volatile("s_waitcnt lgkmcnt(0)" ::: "memory"); SBAR();
#pragma unroll
          for (int ks = 0; ks < 4; ++ks) vf[ks] = (bf16x8){lo[ks][0], lo[ks][1], lo[ks][2], lo[ks][3], hh[ks][0], hh[ks][1], hh[ks][2], hh[ks][3]}; }
        f32x16 o = f32x16{};
        if (OUT) {
            bf16x8 qr[8];
#pragma unroll
            for (int ks = 0; ks < 8; ++ks) qr[ks] = *(const bf16x8*)(lds + O_QES + KSWZ(32 * tb + r32, (ks * 16 + hi * 8) * 2));
            f32x16 p0 = f32x16{}, p1 = f32x16{};
#pragma unroll
            for (int ks = 0; ks < 8; ++ks) p0 = __builtin_amdgcn_mfma_f32_32x32x16_bf16(*(const bf16x8*)(lds + O_KES + KSWZ(r32, (ks * 16 + hi * 8) * 2)), qr[ks], p0, 0, 0, 0);
            if (tb == 1) {
#pragma unroll
                for (int ks = 0; ks < 8; ++ks) p1 = __builtin_amdgcn_mfma_f32_32x32x16_bf16(*(const bf16x8*)(lds + O_KES + KSWZ(32 + r32, (ks * 16 + hi * 8) * 2)), qr[ks], p1, 0, 0, 0);
#pragma unroll
                for (int r = 0; r < 16; ++r) if (crow(r, hi) > r32) p1[r] = 0.f;
            } else {
#pragma unroll
                for (int r = 0; r < 16; ++r) if (crow(r, hi) > r32) p0[r] = 0.f;
            }
            bf16x8 pa0, pa1, pa2, pa3;
#define PK4(Pv, B_, OUTF) do { unsigned a0 = cvtpk(Pv[B_+0], Pv[B_+1]), a1 = cvtpk(Pv[B_+2], Pv[B_+3]); unsigned b0 = cvtpk(Pv[B_+4], Pv[B_+5]), b1 = cvtpk(Pv[B_+6], Pv[B_+7]); \
        auto r0 = __builtin_amdgcn_permlane32_swap(a0, b0, false, false); auto r1 = __builtin_amdgcn_permlane32_swap(a1, b1, false, false); \
        u32x4 w = {r0[0], r1[0], r0[1], r1[1]}; OUTF = *reinterpret_cast<bf16x8*>(&w); } while (0)
            PK4(p0, 0, pa0); PK4(p0, 8, pa1); PK4(p1, 0, pa2); PK4(p1, 8, pa3);
#undef PK4
            o = __builtin_amdgcn_mfma_f32_32x32x16_bf16(pa0, vf[0], o, 0, 0, 0); o = __builtin_amdgcn_mfma_f32_32x32x16_bf16(pa1, vf[1], o, 0, 0, 0);
            o = __builtin_amdgcn_mfma_f32_32x32x16_bf16(pa2, vf[2], o, 0, 0, 0); o = __builtin_amdgcn_mfma_f32_32x32x16_bf16(pa3, vf[3], o, 0, 0, 0);
#pragma unroll
            for (int ks = 0; ks < 8; ++ks) o = __builtin_amdgcn_mfma_f32_32x32x16_bf16(qr[ks], *(const bf16x8*)(lds + O_ST + KSWZ(32 * vq + r32, (ks * 16 + hi * 8) * 2)), o, 0, 0, 0);
        }
#pragma unroll
        for (int i = 0; i < 2; ++i) { const int kb = 2 * tb + i; f32x16 acc = f32x16{};
#pragma unroll
            for (int ks = 0; ks < 4; ++ks) acc = __builtin_amdgcn_mfma_f32_32x32x16_bf16(*(const bf16x8*)(lds + O_KET + ks * 4096 + (32 * kb + r32) * 32 + hi * 16), vf[ks], acc, 0, 0, 0);
#pragma unroll
            for (int r = 0; r < 16; ++r) Sf[i][r] = ((const float*)(lds + O_DL))[32 * kb + crow(r, hi)] * (Sf[i][r] + acc[r]); }
        __syncthreads();
        if (OUT) {
            WRITE_ST();
            { float* ot = (float*)(lds + O_BL);
#pragma unroll
              for (int r = 0; r < 16; ++r) ot[(32 * tb + crow(r, hi)) * 128 + 32 * vq + r32] = o[r]; }
            __syncthreads();
            { const int t = tid >> 3, vc = (tid & 7) * 16; const float* ot = (const float*)(lds + O_BL) + t * 128 + vc; float x[16]; float ss = 0.f;
#pragma unroll
              for (int j4 = 0; j4 < 4; ++j4) { const f32x4 y = *(const f32x4*)(ot + 4 * j4); x[4 * j4] = y[0]; x[4 * j4 + 1] = y[1]; x[4 * j4 + 2] = y[2]; x[4 * j4 + 3] = y[3]; ss += (y[0] * y[0] + y[1] * y[1]) + (y[2] * y[2] + y[3] * y[3]); }
              ss += __shfl_xor(ss, 1); ss += __shfl_xor(ss, 2); ss += __shfl_xor(ss, 4);
              const float rstd = rsqrtf(ss * (1.f / 128.f) + EPS);
              bf16_t* op = P.og + (tok0 + t) * LD + colh + vc; const bf16x8 e0 = *(const bf16x8*)op, e1 = *(const bf16x8*)(op + 8);
#pragma unroll
              for (int j = 0; j < 16; ++j) x[j] = x[j] * rstd * P.ghg[vc + j] * bf2f((bf16_t)(j < 8 ? e0[j] : e1[j - 8]));
              u32x4 w0 = {cvtpk(x[0], x[1]), cvtpk(x[2], x[3]), cvtpk(x[4], x[5]), cvtpk(x[6], x[7])}, w1 = {cvtpk(x[8], x[9]), cvtpk(x[10], x[11]), cvtpk(x[12], x[13]), cvtpk(x[14], x[15])};
              *(u32x4*)op = w0; *(u32x4*)(op + 8) = w1; }
            __syncthreads();
        }
    }
    if (!OUT) {
        float* Uo = P.U + ((size_t)(grp * 16 + h) * 128) * 128;
#pragma unroll
        for (int i = 0; i < 2; ++i)
#pragma unroll
            for (int r = 0; r < 16; ++r) Uo[(size_t)(32 * (2 * tb + i) + crow(r, hi)) * 128 + 32 * vq + r32] = Sf[i][r];
        if ((tid >> 3) == 63) { const int kc = (tid & 7) * 16;
#pragma unroll
            for (int j = 0; j < 16; ++j) P.Dg[(size_t)(grp * 16 + h) * 128 + kc + j] = __expf(gsum[j]); }
    }
#undef WRITE_ST
}
template <bool OUT> __device__ __forceinline__ void phase(char* lds, LAS3 unsigned char* lds3, const Ptrs& P, int vcu, int G) {
    for (int u = vcu; u < 256; u += G) unit<OUT>(lds, lds3, P, u >> 4, u & 15);
}
__device__ __forceinline__ void scan_phase(float* U, const float* Dg, int gt, int NGT) {
    for (int e = gt; e < 16 * 128 * 128; e += NGT) { const int hk = e >> 7; float cur = 0.f;
#pragma unroll
        for (int g = 0; g < 16; ++g) { const size_t idx = (size_t)g * (16 * 128 * 128) + e; const float u = U[idx], d = Dg[(size_t)g * (16 * 128) + hk]; U[idx] = cur; cur = d * cur + u; } }
}
#undef LAS3
#undef KSWZ
#undef SBAR
}
#define GAS __attribute__((address_space(1)))
#define LAS __attribute__((address_space(3)))
typedef float f32x4 __attribute__((ext_vector_type(4)));
typedef unsigned v4u __attribute__((ext_vector_type(4)));
typedef unsigned v2u __attribute__((ext_vector_type(2)));
constexpr int NWAVES = 8, NTHREADS = 512;
constexpr int RING_BYTES = 131072, LDS_BYTES = 147456;
constexpr int MISC_OFF = LDS_BYTES - 256, CW_BAR = 4096;
#define LDS_WAIT() asm volatile("s_waitcnt lgkmcnt(0)" ::: "memory")
__device__ __forceinline__ unsigned pk2(float lo, float hi) { return (unsigned)f2bf(lo) | ((unsigned)f2bf(hi) << 16); }
__device__ __forceinline__ float wave_sum(float v) {
#pragma unroll
    for (int o = 1; o < 64; o <<= 1) v += __shfl_xor(v, o);
    return v;
}
#define XB_TMO      128
#define XB_XCNT(j)  (256  + 64 * (j))
#define XB_XSUB(j)  (1280 + 64 * (j))
#define XB_XGEN(j)  (2304 + 64 * (j))
#define XB_TOP      3328
#define XB_TOPGEN   3392
#define XCD_BAR_WORDS 3456
#define XB_SPIN_CAP (1u << 18)

__device__ __forceinline__ unsigned xb_ld(unsigned* p)              { return __hip_atomic_load(p, __ATOMIC_RELAXED, __HIP_MEMORY_SCOPE_AGENT); }
__device__ __forceinline__ unsigned xb_add(unsigned* p, unsigned v) { return __hip_atomic_fetch_add(p, v, __ATOMIC_RELAXED, __HIP_MEMORY_SCOPE_AGENT); }
__device__ __forceinline__ unsigned xb_xcc_id() { return (unsigned)__builtin_amdgcn_s_getreg((3 << 11) | 20) & 0xFu; }
#define XB_SPIN(cond, bar) do { unsigned _sp = 0; while (cond) { __builtin_amdgcn_s_sleep(1); \
    if ((++_sp & 255u) == 0u) { if (xb_ld(&(bar)[XB_TMO])) break; if (_sp > XB_SPIN_CAP) { atomicAdd(&(bar)[XB_TMO], 1u); break; } } } } while (0)

struct XcdBarrier {
    unsigned* bar; unsigned x;
    volatile LAS unsigned* st;
};

__device__ __forceinline__ XcdBarrier xcd_barrier_post(unsigned* bar, volatile LAS unsigned* st) {
    XcdBarrier b; b.bar = bar; b.x = xb_xcc_id(); b.st = st;
    if (threadIdx.x == 0) (void)xb_add(&bar[XB_XCNT(b.x)], 1u);
    return b;
}
__device__ __forceinline__ void xcd_barrier_complete(unsigned* bar, unsigned x, unsigned& nloc, unsigned& nx) {
    const unsigned G = gridDim.x * gridDim.y * gridDim.z;
    unsigned sum, cnt, mine, sp = 0u;
    for (;;) {
        sum = 0u; cnt = 0u; mine = 0u;
#pragma unroll
        for (unsigned j = 0; j < 16; ++j) { const unsigned c = xb_ld(&bar[XB_XCNT(j)]); sum += c; cnt += (c > 0u) ? 1u : 0u; mine = (j == x) ? c : mine; }
        if (sum == G) break;
        __builtin_amdgcn_s_sleep(1);
        if ((++sp & 255u) == 0u) { if (xb_ld(&bar[XB_TMO])) break; if (sp > XB_SPIN_CAP) { atomicAdd(&bar[XB_TMO], 1u); break; } }
    }
    nloc = mine > 0u ? mine : 1u; nx = cnt > 0u ? cnt : 1u;
}

__device__ __forceinline__ void xcd_barrier(const XcdBarrier& b) {
    asm volatile("s_waitcnt vmcnt(0)" ::: "memory");
    __syncthreads();
    if (threadIdx.x == 0) {
        unsigned* bar = b.bar;
        __builtin_amdgcn_s_waitcnt(0);
        unsigned nloc = b.st[0], nx = b.st[1];
        if (nloc == 0u) { xcd_barrier_complete(bar, b.x, nloc, nx); b.st[0] = nloc; b.st[1] = nx; }
        const unsigned old = xb_add(&bar[XB_XSUB(b.x)], 1u);
        const unsigned gen = old / nloc;
        if (old + 1u == (gen + 1u) * nloc) {
            __builtin_amdgcn_fence(__ATOMIC_RELEASE, "agent");
            asm volatile("s_waitcnt vmcnt(0)" ::: "memory");
            const unsigned og = xb_add(&bar[XB_TOP], 1u);
            const unsigned tg = og / nx;
            if (og + 1u == (tg + 1u) * nx) xb_add(&bar[XB_TOPGEN], 1u);
            else XB_SPIN(xb_ld(&bar[XB_TOPGEN]) == tg, bar);
            __builtin_amdgcn_fence(__ATOMIC_ACQUIRE, "agent");
            xb_add(&bar[XB_XGEN(b.x)], 1u);
            asm volatile("s_waitcnt vmcnt(0)" ::: "memory");
        } else {
            XB_SPIN(xb_ld(&bar[XB_XGEN(b.x)]) == gen, bar);
            __builtin_amdgcn_fence(__ATOMIC_ACQUIRE, "agent");
            asm volatile("s_waitcnt vmcnt(0)" ::: "memory");
        }
    }
    __syncthreads();
}

struct Args { const void* in[21]; float* out; unsigned char* ws; int ph_lo, ph_hi; };

template <int MAP> __device__ __forceinline__ void p0_transpose_item(const float* W, int K, int N, int NP, const float* scale, bf16_t* WT, LAS float* scr, int item, int lane) {
    const int nblk = NP / 32, kb = item / nblk, nb = item % nblk, k0 = 64 * kb, n0 = 32 * nb;
    const int nn = n0 + (lane & 31); const int sc = MAP == 0 ? src_in(nn) : MAP == 1 ? src_uq(nn) : MAP == 2 ? src_gu(nn) : nn;
#pragma unroll 8
    for (int i = 0; i < 32; ++i) { const int kk = 2 * i + (lane >> 5); float v = 0.f; if (sc >= 0) v = W[(size_t)(k0 + kk) * N + sc]; if (scale) v *= scale[k0 + kk]; scr[kk * 33 + (lane & 31)] = v; }
    LDS_WAIT(); asm volatile("" ::: "memory");
    const int c = lane & 7;
#pragma unroll
    for (int j = 0; j < 4; ++j) { const int n = (lane >> 3) + 8 * j; const LAS float* s = scr + (8 * c) * 33 + n;
        v4u o; o.x = pk2(s[0 * 33], s[1 * 33]); o.y = pk2(s[2 * 33], s[3 * 33]); o.z = pk2(s[4 * 33], s[5 * 33]); o.w = pk2(s[6 * 33], s[7 * 33]);
        *(GAS v4u*)(WT + (size_t)(n0 + n) * K + k0 + 8 * c) = o; }
    LDS_WAIT(); asm volatile("" ::: "memory");
}
__device__ __forceinline__ void p0_prologue(const Args& a, LAS unsigned char* lds, int vcu, int G, int wave, int lane, int tid) {
    unsigned char* ws = a.ws;
    { LAS float* scr = (LAS float*)(lds + wave * 16384);
      const int gw = vcu * NWAVES + wave, NGW = G * NWAVES;
      constexpr int I_IN = (D / 64) * (IN_WP / 32), I_SQ = (D / 64) * (D / 32), I_UQ = (QL / 64) * (UQ_W / 32), I_UKV = (KVL / 64) * (UKV_W / 32), I_GU = (D / 64) * (GU_W / 32), I_DN = (DFF / 64) * (D / 32);
      constexpr int NITEMS = I_IN + 3 * I_SQ + I_UQ + I_UKV + I_GU + I_DN;
      for (int it = gw; it < NITEMS; it += NGW) { int r = it;
          if (r < I_IN) { p0_transpose_item<0>((const float*)a.in[6], D, IN_W, IN_WP, nullptr, (bf16_t*)(ws + WS_WIN), scr, r, lane); continue; } r -= I_IN;
          if (r < I_GU) { p0_transpose_item<2>((const float*)a.in[18], D, GU_W, GU_W, nullptr, (bf16_t*)(ws + WS_WGU), scr, r, lane); continue; } r -= I_GU;
          if (r < I_DN) { p0_transpose_item<3>((const float*)a.in[19], DFF, D, D, nullptr, (bf16_t*)(ws + WS_WDN), scr, r, lane); continue; } r -= I_DN;
          if (r < I_SQ) { p0_transpose_item<3>((const float*)a.in[9], D, D, D, nullptr, (bf16_t*)(ws + WS_WOHG), scr, r, lane); continue; } r -= I_SQ;
          if (r < I_SQ) { p0_transpose_item<3>((const float*)a.in[14], D, D, D, nullptr, (bf16_t*)(ws + WS_WOMLA), scr, r, lane); continue; } r -= I_SQ;
          if (r < I_SQ) { p0_transpose_item<3>((const float*)a.in[15], D, D, D, nullptr, (bf16_t*)(ws + WS_WOUT), scr, r, lane); continue; } r -= I_SQ;
          if (r < I_UQ) { p0_transpose_item<1>((const float*)a.in[11], QL, UQ_W, UQ_W, (const float*)a.in[10], (bf16_t*)(ws + WS_WUQ), scr, r, lane); continue; } r -= I_UQ;
          p0_transpose_item<3>((const float*)a.in[13], KVL, UKV_W, UKV_W, (const float*)a.in[12], (bf16_t*)(ws + WS_WUKV), scr, r, lane);
      } }
    __syncthreads();
    { const int gt = vcu * NTHREADS + tid, NGT = G * NTHREADS; const int* pos = (const int*)a.in[2]; float* rope = (float*)(ws + WS_ROPE);
      for (int i = gt; i < S * 32; i += NGT) { const int t = i >> 5, j = i & 31; const float inv = (float)pow(10000.0, -(double)(2 * j) / 64.0); const float ang = (float)pos[t] * inv;
          rope[2 * i] = (float)cos((double)ang); rope[2 * i + 1] = (float)sin((double)ang); }
      if (gt < 2048) { const float* ll = (const float*)a.in[7]; const float x0 = ll[gt], x1 = ll[2048 + gt], m = fmaxf(x0, x1); const float e0 = expf(x0 - m), e1 = expf(x1 - m); ((float*)(ws + WS_LB))[gt] = e0 / (e0 + e1); } }
    { LAS float* sc = (LAS float*)lds; LAS float* part = (LAS float*)(lds + 8192);
      const float* c = (const float*)a.in[1]; const float* w_ada = (const float*)a.in[3]; const float* b_ada = (const float*)a.in[4];
      for (int i = tid; i < D; i += NTHREADS) { const float cv = c[i]; sc[i] = cv / (1.f + expf(-cv)); }
      __syncthreads();
      for (int cb = vcu; cb < (NMOD * D) / 48; cb += G) {
          const int rg = tid / 12, cg = tid % 12; f32x4 acc = {0.f, 0.f, 0.f, 0.f};
          if (rg < 42) { const float* wp = w_ada + (size_t)cb * 48 + cg * 4;
              for (int r = rg; r < D; r += 42) { const f32x4 w = *(const f32x4*)(wp + (size_t)r * (NMOD * D)); acc += w * sc[r]; }
              *(LAS f32x4*)(part + rg * 48 + cg * 4) = acc; }
          __syncthreads();
          if (tid < 48) { float s = 0.f; for (int r = 0; r < 42; ++r) s += part[r * 48 + tid]; ((float*)(ws + WS_MOD))[cb * 48 + tid] = s + b_ada[cb * 48 + tid]; }
          __syncthreads();
      } }
}
__device__ __forceinline__ void p1_rows_h(const Args& a, int gw, int NGW, int lane) {
    const float* x = (const float*)a.in[0]; const float* g = (const float*)a.in[5]; const float* mod = (const float*)(a.ws + WS_MOD); bf16_t* h = (bf16_t*)(a.ws + WS_H);
    for (int row = gw; row < S; row += NGW) {
        const f32x4* xr = (const f32x4*)(x + (size_t)row * D) + lane; f32x4 v[8]; float ss = 0.f;
#pragma unroll
        for (int j = 0; j < 8; ++j) { v[j] = xr[64 * j]; ss += (v[j][0] * v[j][0] + v[j][1] * v[j][1]) + (v[j][2] * v[j][2] + v[j][3] * v[j][3]); }
        const float rstd = rsqrtf(wave_sum(ss) * (1.f / D) + EPS);
        v2u* o = (v2u*)(h + (size_t)row * D) + lane;
#pragma unroll
        for (int j = 0; j < 8; ++j) { const int cidx = 64 * j + lane; const f32x4 gg = ((const f32x4*)g)[cidx], sh = ((const f32x4*)mod)[cidx], sc = ((const f32x4*)(mod + 2048))[cidx];
            const f32x4 r = v[j] * rstd * gg * (sc + 1.f) + sh; v2u w; w.x = pk2(r[0], r[1]); w.y = pk2(r[2], r[3]); o[64 * j] = w; }
    }
}
__device__ __forceinline__ void p9_rows_mid(const Args& a, int gw, int NGW, int lane) {
    const float* x = (const float*)a.in[0]; const float* y = (const float*)(a.ws + WS_Y); const float* ssy = (const float*)(a.ws + WS_SSY); const float* mod = (const float*)(a.ws + WS_MOD);
    const float* gpost = (const float*)a.in[16]; const float* gpre = (const float*)a.in[17]; bf16_t* h2 = (bf16_t*)(a.ws + WS_H);
    for (int row = gw; row < S; row += NGW) {
        const float rstd = rsqrtf(wave_sum(lane < 32 ? ssy[(size_t)row * 32 + lane] : 0.f) * (1.f / D) + EPS);
        const f32x4* xr = (const f32x4*)(x + (size_t)row * D) + lane; const f32x4* yr = (const f32x4*)(y + (size_t)row * D) + lane; f32x4* orow = (f32x4*)(a.out + (size_t)row * D) + lane;
        f32x4 v[8]; float ss = 0.f;
#pragma unroll
        for (int j = 0; j < 8; ++j) { const int cidx = 64 * j + lane; const f32x4 ga = ((const f32x4*)(mod + 4096))[cidx], gp = ((const f32x4*)gpost)[cidx];
            v[j] = xr[64 * j] + ga * (yr[64 * j] * rstd * gp); orow[64 * j] = v[j]; ss += (v[j][0] * v[j][0] + v[j][1] * v[j][1]) + (v[j][2] * v[j][2] + v[j][3] * v[j][3]); }
        const float r2 = rsqrtf(wave_sum(ss) * (1.f / D) + EPS);
        v2u* o = (v2u*)(h2 + (size_t)row * D) + lane;
#pragma unroll
        for (int j = 0; j < 8; ++j) { const int cidx = 64 * j + lane; const f32x4 gg = ((const f32x4*)gpre)[cidx], sh = ((const f32x4*)(mod + 6144))[cidx], sc = ((const f32x4*)(mod + 8192))[cidx];
            const f32x4 r = v[j] * r2 * gg * (sc + 1.f) + sh; v2u w; w.x = pk2(r[0], r[1]); w.y = pk2(r[2], r[3]); o[64 * j] = w; }
    }
}
__device__ __forceinline__ void p12_rows_final(const Args& a, int gw, int NGW, int lane) {
    const float* y2 = (const float*)(a.ws + WS_Y2); const float* ss2 = (const float*)(a.ws + WS_SSY2); const float* mod = (const float*)(a.ws + WS_MOD); const float* gpost = (const float*)a.in[20];
    for (int row = gw; row < S; row += NGW) {
        const float rstd = rsqrtf(wave_sum(lane < 32 ? ss2[(size_t)row * 32 + lane] : 0.f) * (1.f / D) + EPS);
        const f32x4* yr = (const f32x4*)(y2 + (size_t)row * D) + lane; f32x4* orow = (f32x4*)(a.out + (size_t)row * D) + lane;
#pragma unroll
        for (int j = 0; j < 8; ++j) { const int cidx = 64 * j + lane; const f32x4 ga = ((const f32x4*)(mod + 10240))[cidx], gp = ((const f32x4*)gpost)[cidx];
            orow[64 * j] = orow[64 * j] + ga * (yr[64 * j] * rstd * gp); }
    }
}

__global__ void __launch_bounds__(NTHREADS, 2) fwd(Args a) {
    extern __shared__ __attribute__((aligned(16))) unsigned char lds_raw[];
    LAS unsigned char* lds = (LAS unsigned char*)lds_raw;
    const int tid = threadIdx.x, lane = tid & 63, wave = __builtin_amdgcn_readfirstlane(tid >> 6);
    const int G = gridDim.x, bx = blockIdx.x, vcu = (G % 8 == 0) ? (bx % 8) * (G / 8) + bx / 8 : bx;
    const int gw = vcu * NWAVES + wave, NGW = G * NWAVES;
    unsigned char* ws = a.ws;
    const int lo = a.ph_lo, hi = a.ph_hi;
    volatile LAS unsigned* MISC = (volatile LAS unsigned*)(lds + MISC_OFF);
    if (tid < 16) MISC[tid] = 0u;
    __syncthreads();
    XcdBarrier bar = xcd_barrier_post((unsigned*)(ws + WS_CTL) + CW_BAR, MISC + 8);
#define IN(k) (lo <= (k) && (k) < hi)
#define BAR_AFTER(k) do { if (IN(k) && IN((k) + 1)) xcd_barrier(bar); } while (0)
    const hg::Ptrs hp{(const bf16_t*)(ws + WS_QH), (const f16_t*)(ws + WS_G16), (const bf16_t*)(ws + WS_V), (bf16_t*)(ws + WS_OG), (const float*)a.in[8], (float*)(ws + WS_U), (float*)(ws + WS_DG)};
    if (IN(0)) p0_prologue(a, lds, vcu, G, wave, lane, tid);
    BAR_AFTER(0);
    if (IN(1)) p1_rows_h(a, gw, NGW, lane);
    BAR_AFTER(1);
    if (IN(2)) {
        pg8::Gemm g{(const bf16_t*)(ws + WS_H), (const bf16_t*)(ws + WS_WIN), S, IN_WP, D}; pg8::StaticOrder So; So.init(S, IN_WP, G, bx);
        pg8::EpiIn E{(bf16_t*)(ws + WS_QH), (bf16_t*)(ws + WS_G16), (bf16_t*)(ws + WS_V), (bf16_t*)(ws + WS_OG), (bf16_t*)(ws + WS_SA), (bf16_t*)(ws + WS_SB), (bf16_t*)(ws + WS_CQ), (bf16_t*)(ws + WS_CKV), (bf16_t*)(ws + WS_KR),
                     (const float*)(ws + WS_LB), (const float*)(ws + WS_ROPE), (float*)(ws + WS_SSQ), (float*)(ws + WS_SSKV)};
        pg8::gemm_phase<pg8::EpiIn, pg8::StaticOrder, true, true>(lds, g, So, E);
    }
    BAR_AFTER(2);
    if (IN(3)) {
        { pg8::Gemm g{(const bf16_t*)(ws + WS_CQ), (const bf16_t*)(ws + WS_WUQ), S, UQ_W, QL}; pg8::StaticOrder So; So.init(S, UQ_W, G, bx);
          pg8::EpiUq E{(bf16_t*)(ws + WS_QN), (bf16_t*)(ws + WS_QR), (const float*)(ws + WS_SSQ), (const float*)(ws + WS_ROPE), QSCALE, EPS};
          pg8::gemm_phase<pg8::EpiUq, pg8::StaticOrder, true, true>(lds, g, So, E); }
        { pg8::Gemm g{(const bf16_t*)(ws + WS_CKV), (const bf16_t*)(ws + WS_WUKV), S, UKV_W, KVL}; pg8::StaticOrder So; So.init(S, UKV_W, G, bx);
          pg8::EpiUkv E{(bf16_t*)(ws + WS_KN), (bf16_t*)a.out, (const float*)(ws + WS_SSKV), EPS};
          pg8::gemm_phase<pg8::EpiUkv, pg8::StaticOrder, true, true>(lds, g, So, E); }
        hg::phase<false>((char*)lds_raw, lds, hp, vcu, G);
    }
    BAR_AFTER(3);
    if (IN(4)) hg::scan_phase((float*)(ws + WS_U), (const float*)(ws + WS_DG), vcu * NTHREADS + tid, G * NTHREADS);
    BAR_AFTER(4);
    if (IN(5)) {
        att::phase((char*)lds_raw, lds, (bf16_t*)(ws + WS_QN), (const bf16_t*)(ws + WS_QR), (const bf16_t*)(ws + WS_KN), (const bf16_t*)(ws + WS_KR), (const bf16_t*)a.out, vcu, G);
        hg::phase<true>((char*)lds_raw, lds, hp, vcu, G);
    }
    BAR_AFTER(5);
    if (IN(6)) {
        { pg8::Gemm g{(const bf16_t*)(ws + WS_OG), (const bf16_t*)(ws + WS_WOHG), S, D, D}; pg8::StaticOrder So; So.init(S, D, G, bx);
          pg8::EpiYa E{(float*)(ws + WS_YAS), (const bf16_t*)(ws + WS_SA)};
          pg8::gemm_phase<pg8::EpiYa, pg8::StaticOrder, true, true>(lds, g, So, E); }
        { pg8::Gemm g{(const bf16_t*)(ws + WS_QN), (const bf16_t*)(ws + WS_WOMLA), S, D, D}; pg8::StaticOrder So; So.init(S, D, G, bx);
          pg8::EpiYb E{(const float*)(ws + WS_YAS), (const bf16_t*)(ws + WS_SB), (bf16_t*)(ws + WS_MERGED)};
          pg8::gemm_phase<pg8::EpiYb, pg8::StaticOrder, true, true>(lds, g, So, E); }
    }
    BAR_AFTER(6);
    if (IN(7)) {
        pg8::Gemm g{(const bf16_t*)(ws + WS_MERGED), (const bf16_t*)(ws + WS_WOUT), S, D, D}; pg8::StaticOrder So; So.init(S, D, G, bx);
        pg8::EpiF32SS E{(float*)(ws + WS_Y), (float*)(ws + WS_SSY)};
        pg8::gemm_phase<pg8::EpiF32SS, pg8::StaticOrder, true, true>(lds, g, So, E);
    }
    BAR_AFTER(7);
    if (IN(8)) p9_rows_mid(a, gw, NGW, lane);
    BAR_AFTER(8);
    if (IN(9)) {
        pg8::Gemm g{(const bf16_t*)(ws + WS_H), (const bf16_t*)(ws + WS_WGU), S, GU_W, D}; pg8::StaticOrder So; So.init(S, GU_W, G, bx);
        pg8::EpiGu E{(bf16_t*)(ws + WS_ACT), DFF};
        pg8::gemm_phase<pg8::EpiGu, pg8::StaticOrder, true, true>(lds, g, So, E);
    }
    BAR_AFTER(9);
    if (IN(10)) {
        pg8::Gemm g{(const bf16_t*)(ws + WS_ACT), (const bf16_t*)(ws + WS_WDN), S, D, DFF}; pg8::StaticOrder So; So.init(S, D, G, bx);
        pg8::EpiF32SS E{(float*)(ws + WS_Y2), (float*)(ws + WS_SSY2)};
        pg8::gemm_phase<pg8::EpiF32SS, pg8::StaticOrder, true, true>(lds, g, So, E);
    }
    BAR_AFTER(10);
    if (IN(11)) p12_rows_final(a, gw, NGW, lane);
#undef IN
#undef BAR_AFTER
}
extern "C" void kernel_launch(void* const* d_in, const int* in_sizes, int n_in, void* d_out, int out_size, void* d_ws, size_t ws_size, hipStream_t stream) {
    static int grid = 0;
    if (grid == 0) {
        if (n_in != 21 || out_size != S * D || ws_size < WS_END) { fprintf(stderr, "kernel_launch: unexpected shapes (n_in %d out %d ws %zu)\n", n_in, out_size, ws_size); grid = -1; return; }
        int dev = 0, cus = 0;
        if (hipGetDevice(&dev) != hipSuccess || hipDeviceGetAttribute(&cus, hipDeviceAttributeMultiprocessorCount, dev) != hipSuccess) { grid = -1; return; }
        if (hipFuncSetAttribute((const void*)fwd, hipFuncAttributeMaxDynamicSharedMemorySize, LDS_BYTES) != hipSuccess) { fprintf(stderr, "kernel_launch: hipFuncSetAttribute failed\n"); grid = -1; return; }
        int per_cu = 0;
        if (hipOccupancyMaxActiveBlocksPerMultiprocessor(&per_cu, (const void*)fwd, NTHREADS, LDS_BYTES) != hipSuccess || per_cu < 1) { fprintf(stderr, "kernel_launch: occupancy query failed (%d)\n", per_cu); (void)hipGetLastError(); per_cu = 1; }
        grid = cus;
    }
    if (grid < 0) return;
    Args a{};
    for (int i = 0; i < 21; ++i) a.in[i] = d_in[i];
    a.out = (float*)d_out; a.ws = (unsigned char*)d_ws;
    auto run = [&](int lo, int hi) { a.ph_lo = lo; a.ph_hi = hi; hipLaunchKernelGGL(fwd, dim3(grid), dim3(NTHREADS), LDS_BYTES, stream, a); };
    if (hipMemsetAsync((char*)d_ws + WS_CTL, 0, 65536, stream) != hipSuccess) { fprintf(stderr, "kernel_launch: hipMemsetAsync failed\n"); return; }
    run(0, 12);
}
```

```cpp
#ifndef PROBE_DUP
#define PROBE_DUP 0
#endif
#include <hip/hip_runtime.h>
#include <hip/hip_bf16.h>
#include <hip/hip_fp16.h>
#include <cstdio>
#include <cstdint>

typedef unsigned short bf16_t;
typedef unsigned short f16_t;

constexpr int S = 8192, D = 2048, H = 16, HK = 128, HV = 128;
constexpr int QL = 512, KVL = 512, NOPE = 128, ROPE = 64, VD = 128, QKD = 192;
constexpr int DFF = 5632, NMOD = 6;
constexpr int IN_W = 13376, IN_WP = 13568;
constexpr int UQ_W = 3072, UKV_W = 4096, GU_W = 11264;
constexpr float EPS = 1e-6f;
constexpr float QSCALE = 0.07216878364870322f * 1.4426950408889634f;

constexpr size_t MiB = 1u << 20;
constexpr size_t WS_CTL = 0;
constexpr size_t WS_MOD = 1 * MiB;
constexpr size_t WS_LB = 1 * MiB + 64 * 1024;
constexpr size_t WS_DG = 1 * MiB + 128 * 1024;
constexpr size_t WS_ROPE = 2 * MiB;
constexpr size_t WS_SSQ = 4 * MiB;
constexpr size_t WS_SSKV = 5 * MiB;
constexpr size_t WS_SSY = 6 * MiB;
constexpr size_t WS_SSY2 = 7 * MiB;
constexpr size_t WS_WIN = 8 * MiB;
constexpr size_t WS_QN = 8 * MiB;
constexpr size_t WS_QR = 40 * MiB;
constexpr size_t WS_WOHG = 61 * MiB;
constexpr size_t WS_WUQ = 69 * MiB;
constexpr size_t WS_WUKV = 72 * MiB;
constexpr size_t WS_WOMLA = 76 * MiB;
constexpr size_t WS_WOUT = 84 * MiB;
constexpr size_t WS_WGU = 92 * MiB;
constexpr size_t WS_WDN = 136 * MiB;
constexpr size_t WS_QH = 158 * MiB;
constexpr size_t WS_G16 = 190 * MiB;
constexpr size_t WS_V = 222 * MiB;
constexpr size_t WS_OG = 254 * MiB;
constexpr size_t WS_SA = 286 * MiB;
constexpr size_t WS_SB = 318 * MiB;
constexpr size_t WS_CQ = 350 * MiB;
constexpr size_t WS_CKV = 358 * MiB;
constexpr size_t WS_KR = 366 * MiB;
constexpr size_t WS_H = 368 * MiB;
constexpr size_t WS_KN = 368 * MiB;
constexpr size_t WS_U = 400 * MiB;
constexpr size_t WS_YAS = 158 * MiB;
constexpr size_t WS_MERGED = 222 * MiB;
constexpr size_t WS_Y = 254 * MiB;
constexpr size_t WS_ACT = 158 * MiB;
constexpr size_t WS_Y2 = 254 * MiB;
constexpr size_t WS_SCR2 = 318 * MiB;
constexpr size_t WS_END = 416 * MiB;

__device__ __forceinline__ float bf2f(bf16_t v) { return __uint_as_float((unsigned)v << 16); }
__device__ __forceinline__ bf16_t f2bf(float f) { unsigned u = __float_as_uint(f); return (bf16_t)((u + 0x7fffu + ((u >> 16) & 1u)) >> 16); }
__device__ __forceinline__ float h2f(f16_t v) { return __half2float(__ushort_as_half(v)); }
__device__ __forceinline__ f16_t f2h(float f) { return __half_as_ushort(__float2half_rn(f)); }
__device__ __forceinline__ float sigmoidf_(float x) { return 1.f / (1.f + __expf(-x)); }
__device__ __forceinline__ float siluf_(float x) { return x / (1.f + __expf(-x)); }

__host__ __device__ inline int src_in(int n) {
    if (n < 8192) return n;
    if (n < 10240) return n - 8192 + 9280;
    if (n < 12288) return n - 10240 + 11328;
    if (n < 12800) return n - 12288 + 8192;
    if (n < 13312) return n - 12800 + 8704;
    if (n < 13376) { const int i = n - 13312; return 9216 + 32 * (i & 1) + (i >> 1); }
    return -1;
}
__host__ __device__ inline int src_uq(int n) {
    if (n < 2048) return (n >> 7) * 192 + (n & 127);
    const int m = n - 2048, h = m >> 6, i = m & 63; return h * 192 + 128 + 32 * (i & 1) + (i >> 1);
}
__host__ __device__ inline int src_gu(int n) { const int t = n >> 8, r = n & 255; return r < 128 ? 128 * t + r : 5632 + 128 * t + (r - 128); }
__host__ __device__ inline int src_id(int n) { return n; }

namespace pg8 {
#define PG8_LAS __attribute__((address_space(3)))
typedef unsigned short bf16_t;
typedef short bf16x8 __attribute__((ext_vector_type(8)));
typedef float f32x4 __attribute__((ext_vector_type(4)));
typedef unsigned u32x4 __attribute__((ext_vector_type(4)));
constexpr int BM = 256, BK = 64, HALF = 128, HTB = HALF * BK * 2  , STAGE_BYTES = 8 * HTB, NXCD = 8, WGM = 8;

__host__ __device__ __forceinline__ int lds_byte(int r, int c) { const int st = (r >> 4) * 2 + (c >> 5), rr = r & 15, cc = c & 31, ob = rr * 64 + cc * 2; return st * 1024 + (ob ^ (((ob >> 9) & 1) << 5)); }
__host__ __device__ __forceinline__ void stage_rc(int b, int& R, int& C) { const int st = b / 1024, sb = b % 1024, swz = sb ^ (((sb >> 9) & 1) << 5); R = (st >> 1) * 16 + swz / 64; C = (st & 1) * 32 + (swz % 64) / 2; }
__host__ __device__ __forceinline__ int perm32(int rho) { const int n = rho >> 4, i = rho & 15; return 8 * (i >> 2) + 4 * n + (i & 3); }

struct Unit { int pm, pn; };
struct Gemm { const bf16_t* A; const bf16_t* Bt; int M, N, K; };

struct StaticOrder {
    int nM, nN, nwg, G, c;
    __host__ __device__ void init(int M, int N, int G_, int c_) { nM = M / BM; nN = N / BM; nwg = nM * nN; G = G_; c = c_; }
    __host__ __device__ bool next(int i, Unit& u) const {
        const long L = (long)i * G + c; if (L >= nwg) return false;
        int wgid = (int)L; { const int q = nwg / NXCD, r = nwg % NXCD, xcd = wgid % NXCD, off = wgid / NXCD; wgid = (xcd < r ? xcd * (q + 1) : r * (q + 1) + (xcd - r) * q) + off; }
        const int nig = WGM * nN, gid = wgid / nig, fm = gid * WGM, gsz = (nM - fm) < WGM ? (nM - fm) : WGM;
        u.pm = fm + ((wgid % nig) % gsz); u.pn = (wgid % nig) / gsz; return true;
    }
    __device__ __forceinline__ void a_ready(const Unit&) const {}
    __device__ __forceinline__ void done(const Unit&) const {}
};

__device__ __forceinline__ unsigned cvt_pk_bf16(float lo, float hi) { unsigned r; asm volatile("v_cvt_pk_bf16_f32 %0, %1, %2" : "=v"(r) : "v"(lo), "v"(hi)); return r; }
__device__ __forceinline__ float sigm(float x) { return __builtin_amdgcn_rcpf(1.f + __expf(-x)); }
__device__ __forceinline__ unsigned cvt_pk_f16(float lo, float hi) { typedef _Float16 h2v __attribute__((ext_vector_type(2))); h2v v = {(_Float16)lo, (_Float16)hi}; return __builtin_bit_cast(unsigned, v); }
__device__ __forceinline__ u32x4 pack_bf16x8(f32x4 a, f32x4 b) { u32x4 w; w.x = cvt_pk_bf16(a[0], a[1]); w.y = cvt_pk_bf16(a[2], a[3]); w.z = cvt_pk_bf16(b[0], b[1]); w.w = cvt_pk_bf16(b[2], b[3]); return w; }
__device__ __forceinline__ void unpack_bf16x8(u32x4 w, f32x4& a, f32x4& b) {
    a[0] = __uint_as_float(w.x << 16); a[1] = __uint_as_float(w.x & 0xffff0000u); a[2] = __uint_as_float(w.y << 16); a[3] = __uint_as_float(w.y & 0xffff0000u);
    b[0] = __uint_as_float(w.z << 16); b[1] = __uint_as_float(w.z & 0xffff0000u); b[2] = __uint_as_float(w.w << 16); b[3] = __uint_as_float(w.w & 0xffff0000u); }
__device__ __forceinline__ float sumsq8(f32x4 a, f32x4 b) { return ((a[0] * a[0] + a[1] * a[1]) + (a[2] * a[2] + a[3] * a[3])) + ((b[0] * b[0] + b[1] * b[1]) + (b[2] * b[2] + b[3] * b[3])); }

struct EpiIn {
    static constexpr bool PERM = true, AFTER_DRAIN = false;
    unsigned short *qh, *g16, *v, *og, *sa, *sb, *cq, *ckv, *kr; const float *lb, *rope; float *ssq, *sskv;
    template <int MODE> __device__ __forceinline__ void seg(const f32x4 (&acc)[2][2][4][2], unsigned short* base, int row0, int colb) const {
        f32x4 l0[2], l1[2];
        if (MODE == 3) {
#pragma unroll
            for (int bj = 0; bj < 2; ++bj) { l0[bj] = *(const f32x4*)(lb + colb + bj * HALF); l1[bj] = *(const f32x4*)(lb + colb + bj * HALF + 4); } }
#pragma unroll
        for (int ai = 0; ai < 2; ++ai)
#pragma unroll
            for (int m = 0; m < 4; ++m) { unsigned short* rowp = base + (size_t)(row0 + ai * HALF + m * 16) * 2048 + colb;
#pragma unroll
                for (int bj = 0; bj < 2; ++bj) { f32x4 a = acc[ai][bj][m][0], b = acc[ai][bj][m][1]; u32x4 w;
                    if (MODE == 1) {
#pragma unroll
                        for (int e = 0; e < 4; ++e) { a[e] = a[e] * sigm(a[e]); b[e] = b[e] * sigm(b[e]); } }
                    if (MODE == 2) {
#pragma unroll
                        for (int e = 0; e < 4; ++e) { a[e] = sigm(a[e]); b[e] = sigm(b[e]); } }
                    if (MODE == 3) {
#pragma unroll
                        for (int e = 0; e < 4; ++e) { a[e] = __logf(l0[bj][e] + (1.f - l0[bj][e]) * sigm(a[e])); b[e] = __logf(l1[bj][e] + (1.f - l1[bj][e]) * sigm(b[e])); }
                        w.x = cvt_pk_f16(a[0], a[1]); w.y = cvt_pk_f16(a[2], a[3]); w.z = cvt_pk_f16(b[0], b[1]); w.w = cvt_pk_f16(b[2], b[3]); }
                    else w = pack_bf16x8(a, b);
                    *(u32x4*)(rowp + bj * HALF) = w; } }
    }
    __device__ __forceinline__ void operator()(const f32x4 (&acc)[2][2][4][2], const Unit& u, int wr, int wc, int fr, int fq) const {
        const int row0 = u.pm * BM + wr * 64 + fr, pn = u.pn, cw = wc * 32 + 8 * fq;
        if (pn < 48) { const int sg = pn >> 3, colb = (pn & 7) * 256 + cw;
            if (sg == 0) seg<1>(acc, qh, row0, colb); else if (sg == 1) seg<3>(acc, g16, row0, colb); else if (sg == 2) seg<0>(acc, v, row0, colb);
            else if (sg == 3) seg<1>(acc, og, row0, colb); else if (sg == 4) seg<2>(acc, sa, row0, colb); else seg<2>(acc, sb, row0, colb); }
        else if (pn < 52) { unsigned short* base = pn < 50 ? cq : ckv; float* ss = pn < 50 ? ssq : sskv; const int colb = (pn & 1) * 256 + cw, slot = (pn & 1) * 4 + wc;
#pragma unroll
            for (int ai = 0; ai < 2; ++ai)
#pragma unroll
                for (int m = 0; m < 4; ++m) { const int row = row0 + ai * HALF + m * 16; unsigned short* rowp = base + (size_t)row * 512 + colb; float s = 0.f;
#pragma unroll
                    for (int bj = 0; bj < 2; ++bj) { const f32x4 a = acc[ai][bj][m][0], b = acc[ai][bj][m][1]; s += sumsq8(a, b); *(u32x4*)(rowp + bj * HALF) = pack_bf16x8(a, b); }
                    s += __shfl_xor(s, 16); s += __shfl_xor(s, 32);
                    if (fq == 0) ss[(size_t)row * 8 + slot] = s; } }
        else if (wc < 2) {
#pragma unroll
            for (int ai = 0; ai < 2; ++ai)
#pragma unroll
                for (int m = 0; m < 4; ++m) { const int row = row0 + ai * HALF + m * 16; const float* rp = rope + ((size_t)row * 32 + 16 * wc + 4 * fq) * 2;
                    const f32x4 c0 = *(const f32x4*)rp, c1 = *(const f32x4*)(rp + 4); const f32x4 a = acc[ai][0][m][0], b = acc[ai][0][m][1]; f32x4 oa, ob;
                    oa[0] = a[0] * c0[0] - a[1] * c0[1]; oa[1] = a[1] * c0[0] + a[0] * c0[1]; oa[2] = a[2] * c0[2] - a[3] * c0[3]; oa[3] = a[3] * c0[2] + a[2] * c0[3];
                    ob[0] = b[0] * c1[0] - b[1] * c1[1]; ob[1] = b[1] * c1[0] + b[0] * c1[1]; ob[2] = b[2] * c1[2] - b[3] * c1[3]; ob[3] = b[3] * c1[2] + b[2] * c1[3];
                    *(u32x4*)(kr + (size_t)row * 64 + cw) = pack_bf16x8(oa, ob); } }
    }
};
struct EpiUq {
    static constexpr bool PERM = true, AFTER_DRAIN = false;
    unsigned short *qn, *qr; const float *ssq, *rope; float qscale, eps;
    __device__ __forceinline__ void operator()(const f32x4 (&acc)[2][2][4][2], const Unit& u, int wr, int wc, int fr, int fq) const {
        const int row0 = u.pm * BM + wr * 64 + fr, pn = u.pn, cw = wc * 32 + 8 * fq;
#pragma unroll
        for (int ai = 0; ai < 2; ++ai)
#pragma unroll
            for (int m = 0; m < 4; ++m) { const int row = row0 + ai * HALF + m * 16;
                const f32x4 p0 = *(const f32x4*)(ssq + (size_t)row * 8), p1 = *(const f32x4*)(ssq + (size_t)row * 8 + 4);
                const float rs = __builtin_amdgcn_rsqf((((p0[0] + p0[1]) + (p0[2] + p0[3])) + ((p1[0] + p1[1]) + (p1[2] + p1[3]))) * (1.f / 512.f) + eps) * qscale;
                if (pn < 8) { unsigned short* rowp = qn + (size_t)row * 2048 + pn * 256 + cw;
#pragma unroll
                    for (int bj = 0; bj < 2; ++bj) *(u32x4*)(rowp + bj * HALF) = pack_bf16x8(acc[ai][bj][m][0] * rs, acc[ai][bj][m][1] * rs); }
                else { unsigned short* rowp = qr + (size_t)row * 1024 + (pn - 8) * 256 + cw; const float* rp = rope + ((size_t)row * 32 + 16 * (wc & 1) + 4 * fq) * 2;
                    const f32x4 c0 = *(const f32x4*)rp, c1 = *(const f32x4*)(rp + 4);
#pragma unroll
                    for (int bj = 0; bj < 2; ++bj) { const f32x4 a = acc[ai][bj][m][0] * rs, b = acc[ai][bj][m][1] * rs; f32x4 oa, ob;
                        oa[0] = a[0] * c0[0] - a[1] * c0[1]; oa[1] = a[1] * c0[0] + a[0] * c0[1]; oa[2] = a[2] * c0[2] - a[3] * c0[3]; oa[3] = a[3] * c0[2] + a[2] * c0[3];
                        ob[0] = b[0] * c1[0] - b[1] * c1[1]; ob[1] = b[1] * c1[0] + b[0] * c1[1]; ob[2] = b[2] * c1[2] - b[3] * c1[3]; ob[3] = b[3] * c1[2] + b[2] * c1[3];
                        *(u32x4*)(rowp + bj * HALF) = pack_bf16x8(oa, ob); } } }
    }
};
struct EpiUkv {
    static constexpr bool PERM = true, AFTER_DRAIN = false;
    unsigned short *kn, *vm; const float* sskv; float eps;
    __device__ __forceinline__ void operator()(const f32x4 (&acc)[2][2][4][2], const Unit& u, int wr, int wc, int fr, int fq) const {
        const int row0 = u.pm * BM + wr * 64 + fr, colb = u.pn * 128 + wc * 32 + 8 * fq;
#pragma unroll
        for (int ai = 0; ai < 2; ++ai)
#pragma unroll
            for (int m = 0; m < 4; ++m) { const int row = row0 + ai * HALF + m * 16;
                const f32x4 p0 = *(const f32x4*)(sskv + (size_t)row * 8), p1 = *(const f32x4*)(sskv + (size_t)row * 8 + 4);
                const float rs = __builtin_amdgcn_rsqf((((p0[0] + p0[1]) + (p0[2] + p0[3])) + ((p1[0] + p1[1]) + (p1[2] + p1[3]))) * (1.f / 512.f) + eps);
                *(u32x4*)(kn + (size_t)row * 2048 + colb) = pack_bf16x8(acc[ai][0][m][0] * rs, acc[ai][0][m][1] * rs);
                *(u32x4*)(vm + (size_t)row * 2048 + colb) = pack_bf16x8(acc[ai][1][m][0] * rs, acc[ai][1][m][1] * rs); }
    }
};
struct EpiYa {
    static constexpr bool PERM = true, AFTER_DRAIN = false;
    float* yas; const unsigned short* sa;
    __device__ __forceinline__ void operator()(const f32x4 (&acc)[2][2][4][2], const Unit& u, int wr, int wc, int fr, int fq) const {
        const int row0 = u.pm * BM + wr * 64 + fr, colb = u.pn * 256 + wc * 32 + 8 * fq;
#pragma unroll
        for (int ai = 0; ai < 2; ++ai)
#pragma unroll
            for (int m = 0; m < 4; ++m) { const size_t off = (size_t)(row0 + ai * HALF + m * 16) * 2048 + colb;
#pragma unroll
                for (int bj = 0; bj < 2; ++bj) { f32x4 ga, gb; unpack_bf16x8(*(const u32x4*)(sa + off + bj * HALF), ga, gb);
                    *(f32x4*)(yas + off + bj * HALF) = acc[ai][bj][m][0] * ga; *(f32x4*)(yas + off + bj * HALF + 4) = acc[ai][bj][m][1] * gb; } }
    }
};
struct EpiYb {
    static constexpr bool PERM = true, AFTER_DRAIN = false;
    const float* yas; const unsigned short* sb; unsigned short* merged;
    __device__ __forceinline__ void operator()(const f32x4 (&acc)[2][2][4][2], const Unit& u, int wr, int wc, int fr, int fq) const {
        const int row0 = u.pm * BM + wr * 64 + fr, colb = u.pn * 256 + wc * 32 + 8 * fq;
#pragma unroll
        for (int ai = 0; ai < 2; ++ai)
#pragma unroll
            for (int m = 0; m < 4; ++m) { const size_t off = (size_t)(row0 + ai * HALF + m * 16) * 2048 + colb;
#pragma unroll
                for (int bj = 0; bj < 2; ++bj) { f32x4 ga, gb; unpack_bf16x8(*(const u32x4*)(sb + off + bj * HALF), ga, gb);
                    const f32x4 y0 = *(const f32x4*)(yas + off + bj * HALF), y1 = *(const f32x4*)(yas + off + bj * HALF + 4);
                    *(u32x4*)(merged + off + bj * HALF) = pack_bf16x8(y0 + acc[ai][bj][m][0] * ga, y1 + acc[ai][bj][m][1] * gb); } }
    }
};
struct EpiF32SS {
    static constexpr bool PERM = true, AFTER_DRAIN = false;
    float* y; float* ss;
    __device__ __forceinline__ void operator()(const f32x4 (&acc)[2][2][4][2], const Unit& u, int wr, int wc, int fr, int fq) const {
        const int row0 = u.pm * BM + wr * 64 + fr, colb = u.pn * 256 + wc * 32 + 8 * fq, slot = u.pn * 4 + wc;
#pragma unroll
        for (int ai = 0; ai < 2; ++ai)
#pragma unroll
            for (int m = 0; m < 4; ++m) { const int row = row0 + ai * HALF + m * 16; const size_t off = (size_t)row * 2048 + colb; float s = 0.f;
#pragma unroll
                for (int bj = 0; bj < 2; ++bj) { const f32x4 a = acc[ai][bj][m][0], b = acc[ai][bj][m][1]; s += sumsq8(a, b);
                    *(f32x4*)(y + off + bj * HALF) = a; *(f32x4*)(y + off + bj * HALF + 4) = b; }
                s += __shfl_xor(s, 16); s += __shfl_xor(s, 32);
                if (fq == 0) ss[(size_t)row * 32 + slot] = s; }
    }
};
struct EpiGu {
    static constexpr bool PERM = true, AFTER_DRAIN = false;
    unsigned short* act; int ldc;
    __device__ __forceinline__ void operator()(const f32x4 (&acc)[2][2][4][2], const Unit& u, int wr, int wc, int fr, int fq) const {
        const int row0 = u.pm * BM + wr * 64 + fr, colb = u.pn * 128 + wc * 32 + 8 * fq;
#pragma unroll
        for (int ai = 0; ai < 2; ++ai)
#pragma unroll
            for (int m = 0; m < 4; ++m) { f32x4 a = acc[ai][0][m][0], b = acc[ai][0][m][1];
#pragma unroll
                for (int e = 0; e < 4; ++e) { a[e] = a[e] * sigm(a[e]) * acc[ai][1][m][0][e]; b[e] = b[e] * sigm(b[e]) * acc[ai][1][m][1][e]; }
                *(u32x4*)(act + (size_t)(row0 + ai * HALF + m * 16) * ldc + colb) = pack_bf16x8(a, b); }
    }
};
template <class Epi, class Sched, bool ALIGN_EPI = false, bool SP2 = false>
__device__ __forceinline__ void gemm_phase(PG8_LAS unsigned char* lds, const Gemm g, const Sched& S, const Epi& E) {
    const int tid = threadIdx.x, wid = __builtin_amdgcn_readfirstlane(tid >> 6), lane = tid & 63, wr = wid >> 2, wc = wid & 3, fr = lane & 15, fq = lane >> 4;
    const int K = g.K, nt = K / BK;
    unsigned voffA[2], voffB[2];
#pragma unroll
    for (int i = 0; i < 2; ++i) { int R, C; stage_rc(tid * 16 + i * 8192, R, C); const int Rb = Epi::PERM ? ((R & ~31) + perm32(R & 31)) : R;
        voffA[i] = (unsigned)(R * K + C) * 2u; voffB[i] = (unsigned)(Rb * K + C) * 2u; }
    const size_t kstep = (size_t)(BK * 2);
    const size_t hstep = (size_t)HALF * K * 2;
    const size_t tstep = 2 * hstep;
    const unsigned ldsw = (unsigned)wid * 1024u;
    const int aoff = lds_byte(wr * 64 + fr, fq * 8), boff = lds_byte(wc * 32 + fr, fq * 8);
#define PG8_SA(b, h) (((b) * 2 + (h)) * HTB)
#define PG8_SB(b, h) ((4 + (b) * 2 + (h)) * HTB)
#define PG8_STAGE(bufoff, gbase, voff) do { _Pragma("unroll") for (int _i = 0; _i < 2; ++_i) \
        __builtin_amdgcn_global_load_lds((const unsigned*)((const char*)(gbase) + (voff)[_i]), (PG8_LAS unsigned*)(lds + (bufoff) + ldsw + _i * 8192), 16, 0, 0); } while (0)
#define PG8_LDA(dst, b, h) do { _Pragma("unroll") for (int m = 0; m < 4; ++m) _Pragma("unroll") for (int k = 0; k < 2; ++k) dst[m][k] = *(const PG8_LAS bf16x8*)(lds + PG8_SA(b, h) + aoff + m * 2048 + k * 1024); } while (0)
#define PG8_LDB(dst, b, h) do { _Pragma("unroll") for (int n = 0; n < 2; ++n) _Pragma("unroll") for (int k = 0; k < 2; ++k) dst[n][k] = *(const PG8_LAS bf16x8*)(lds + PG8_SB(b, h) + boff + n * 2048 + k * 1024); } while (0)
#define PG8_MMA(ai, bj, At, Bt) do { __builtin_amdgcn_s_setprio(1); _Pragma("unroll") for (int m = 0; m < 4; ++m) _Pragma("unroll") for (int n = 0; n < 2; ++n) _Pragma("unroll") for (int k = 0; k < 2; ++k) \
        acc[ai][bj][m][n] = __builtin_amdgcn_mfma_f32_16x16x32_bf16(Bt[n][k], At[m][k], acc[ai][bj][m][n], 0, 0, 0); __builtin_amdgcn_s_setprio(0); } while (0)
#define PG8_WAIT_V(n) asm volatile("s_waitcnt vmcnt(" #n ")" ::: "memory")
#define PG8_WAIT_L(n) asm volatile("s_waitcnt lgkmcnt(" #n ")" ::: "memory")
#define PG8_BAR __builtin_amdgcn_s_barrier()
#define PG8_SCHED __builtin_amdgcn_sched_barrier(0)
    Unit cur, nxt; int ui = 0;
    if (!S.next(0, cur)) return;
    f32x4 acc[2][2][4][2];
#pragma unroll
    for (int a = 0; a < 2; ++a)
#pragma unroll
        for (int b = 0; b < 2; ++b)
#pragma unroll
            for (int m = 0; m < 4; ++m)
#pragma unroll
                for (int n = 0; n < 2; ++n) acc[a][b][m][n] = (f32x4){0.f, 0.f, 0.f, 0.f};
    bf16x8 At[4][2], B0[2][2], B1[2][2];
    const char* cA = (const char*)g.A + (size_t)cur.pm * tstep; const char* cB = (const char*)g.Bt + (size_t)cur.pn * tstep;
    S.a_ready(cur);
    if constexpr (SP2) {
        PG8_STAGE(PG8_SB(0, 0), cB, voffB); PG8_STAGE(PG8_SB(0, 1), cB + hstep, voffB); PG8_STAGE(PG8_SA(0, 0), cA, voffA); PG8_STAGE(PG8_SA(0, 1), cA + hstep, voffA);
        if (wr == 1) PG8_BAR;
        PG8_WAIT_V(2); PG8_BAR;
        PG8_STAGE(PG8_SB(1, 0), cB + kstep, voffB); PG8_STAGE(PG8_SA(1, 0), cA + kstep, voffA); PG8_STAGE(PG8_SB(1, 1), cB + hstep + kstep, voffB);
        PG8_WAIT_V(6); PG8_BAR;
    } else {
        PG8_STAGE(PG8_SB(0, 0), cB, voffB); PG8_STAGE(PG8_SA(0, 0), cA, voffA); PG8_STAGE(PG8_SB(0, 1), cB + hstep, voffB); PG8_STAGE(PG8_SA(0, 1), cA + hstep, voffA);
        if (wr == 1) PG8_BAR;
        PG8_WAIT_V(4); PG8_BAR;
        PG8_STAGE(PG8_SB(1, 0), cB + kstep, voffB); PG8_STAGE(PG8_SA(1, 0), cA + kstep, voffA); PG8_STAGE(PG8_SB(1, 1), cB + hstep + kstep, voffB);
        PG8_WAIT_V(6); PG8_BAR;
    }
    for (;;) {
        const bool has_next = S.next(ui + 1, nxt);
        const char* nA = has_next ? (const char*)g.A + (size_t)nxt.pm * tstep : cA; const char* nB = has_next ? (const char*)g.Bt + (size_t)nxt.pn * tstep : cB;
        for (int t = 0; t < nt; t += 2) {
            const bool last = (t == nt - 2);
            const char* a1 = cA + (size_t)(t + 1) * kstep;
            const char* a2 = last ? nA : cA + (size_t)(t + 2) * kstep; const char* b2 = last ? nB : cB + (size_t)(t + 2) * kstep;
            const char* a3 = a2 + kstep; const char* b3 = b2 + kstep;
            if (last && has_next) S.a_ready(nxt);
            if constexpr (SP2) {
            PG8_LDB(B0, 0, 0); PG8_LDB(B1, 0, 1); PG8_SCHED; PG8_LDA(At, 0, 0); PG8_STAGE(PG8_SA(1, 1), a1 + hstep, voffA);
            PG8_WAIT_V(8); PG8_WAIT_L(0); PG8_BAR; PG8_MMA(0, 0, At, B0); PG8_MMA(0, 1, At, B1); PG8_BAR; PG8_SCHED;
            PG8_LDA(At, 0, 1); PG8_STAGE(PG8_SB(0, 0), b2, voffB); PG8_STAGE(PG8_SB(0, 1), b2 + hstep, voffB); PG8_STAGE(PG8_SA(0, 0), a2, voffA);
            PG8_WAIT_V(8); PG8_WAIT_L(0); PG8_BAR; PG8_MMA(1, 0, At, B0); PG8_MMA(1, 1, At, B1); PG8_BAR; PG8_SCHED;
            PG8_LDB(B0, 1, 0); PG8_LDB(B1, 1, 1); PG8_SCHED; PG8_LDA(At, 1, 0); PG8_STAGE(PG8_SA(0, 1), a2 + hstep, voffA);
            PG8_WAIT_V(8); PG8_WAIT_L(0); PG8_BAR; PG8_MMA(0, 0, At, B0); PG8_MMA(0, 1, At, B1); PG8_BAR; PG8_SCHED;
            PG8_LDA(At, 1, 1); PG8_STAGE(PG8_SB(1, 0), b3, voffB); PG8_STAGE(PG8_SB(1, 1), b3 + hstep, voffB); PG8_STAGE(PG8_SA(1, 0), a3, voffA);
            PG8_WAIT_V(8); PG8_WAIT_L(0); PG8_BAR; PG8_MMA(1, 0, At, B0); PG8_MMA(1, 1, At, B1); PG8_BAR; PG8_SCHED;
            } else {
            PG8_LDB(B0, 0, 0); PG8_SCHED; PG8_LDA(At, 0, 0); PG8_STAGE(PG8_SA(1, 1), a1 + hstep, voffA);
            PG8_WAIT_L(8); PG8_BAR; PG8_WAIT_L(0); PG8_MMA(0, 0, At, B0); PG8_BAR; PG8_SCHED;
            PG8_LDB(B1, 0, 1); PG8_STAGE(PG8_SB(0, 0), b2, voffB);
            PG8_BAR; PG8_WAIT_L(0); PG8_MMA(0, 1, At, B1); PG8_BAR;
            PG8_LDA(At, 0, 1); PG8_STAGE(PG8_SA(0, 0), a2, voffA);
            PG8_BAR; PG8_WAIT_L(0); PG8_MMA(1, 0, At, B0); PG8_BAR; PG8_SCHED;
            PG8_STAGE(PG8_SB(0, 1), b2 + hstep, voffB);
            PG8_WAIT_V(6); PG8_BAR; PG8_MMA(1, 1, At, B1); PG8_BAR;
            PG8_LDB(B0, 1, 0); PG8_SCHED; PG8_LDA(At, 1, 0); PG8_STAGE(PG8_SA(0, 1), a2 + hstep, voffA);
            PG8_WAIT_L(8); PG8_BAR; PG8_WAIT_L(0); PG8_MMA(0, 0, At, B0); PG8_BAR; PG8_SCHED;
            PG8_LDB(B1, 1, 1); PG8_STAGE(PG8_SB(1, 0), b3, voffB);
            PG8_BAR; PG8_WAIT_L(0); PG8_MMA(0, 1, At, B1); PG8_BAR;
            PG8_LDA(At, 1, 1); PG8_STAGE(PG8_SA(1, 0), a3, voffA);
            PG8_BAR; PG8_WAIT_L(0); PG8_MMA(1, 0, At, B0); PG8_BAR; PG8_SCHED;
            PG8_STAGE(PG8_SB(1, 1), b3 + hstep, voffB);
            PG8_WAIT_V(6); PG8_BAR; PG8_MMA(1, 1, At, B1); PG8_BAR;
            }
        }
        if constexpr (ALIGN_EPI) { if (wr == 0) PG8_BAR; }
        if constexpr (!Epi::AFTER_DRAIN) { E(acc, cur, wr, wc, fr, fq); S.done(cur); }
        if (!has_next) break;
#pragma unroll
        for (int a = 0; a < 2; ++a)
#pragma unroll
            for (int b = 0; b < 2; ++b)
#pragma unroll
                for (int m = 0; m < 4; ++m)
#pragma unroll
                    for (int n = 0; n < 2; ++n) acc[a][b][m][n] = (f32x4){0.f, 0.f, 0.f, 0.f};
        cur = nxt; cA = nA; cB = nB; ++ui;
        if constexpr (ALIGN_EPI) { if (wr == 1) PG8_BAR; }
    }
    PG8_WAIT_V(0);
    if constexpr (!ALIGN_EPI) { if (wr == 0) PG8_BAR; }
    PG8_BAR;
    if constexpr (Epi::AFTER_DRAIN) { E.fused(acc, cur, wr, wc, fr, fq, lds, wid, lane); S.done(cur); }
#undef PG8_SA
#undef PG8_SB
#undef PG8_STAGE
#undef PG8_LDA
#undef PG8_LDB
#undef PG8_MMA
#undef PG8_WAIT_V
#undef PG8_WAIT_L
#undef PG8_BAR
#undef PG8_SCHED
}
}
namespace att {
typedef short bf16x8 __attribute__((ext_vector_type(8)));
typedef short s16x4 __attribute__((ext_vector_type(4)));
typedef float f32x16 __attribute__((ext_vector_type(16)));
typedef unsigned u32x4 __attribute__((ext_vector_type(4)));
constexpr int NW = 8, QBLK = 32, KVBLK = 64, QB = NW * QBLK;
constexpr int SHM_V = KVBLK * 128 * 2, SHM_K = KVBLK * 128 * 2, SHM_R = KVBLK * 64 * 2;
constexpr int OFF_V = 0, OFF_K = 2 * SHM_V, OFF_R = OFF_K + 2 * SHM_K, OFF_WS = OFF_R + 2 * SHM_R, OFF_QR = OFF_WS + NW * 64 * 4, LDS_BYTES = OFF_QR + NW * 4096;
constexpr float THR2 = 11.5f;
constexpr int LDQ = 2048, LDR = 1024, LDK = 2048, LDKR = 64;
#define LAS3 __attribute__((address_space(3)))
#define KSWZ(row, colB) ((row) * 256 + ((colB) ^ (((row) & 7) << 4)))
#define SBAR() __builtin_amdgcn_sched_barrier(0)
__device__ __forceinline__ int v_st(int k, int c) { const int kk = (k & ~0xC) | ((k & 4) << 1) | ((k & 8) >> 1); return ((kk >> 3) * 4 + (c >> 5)) * 512 + ((kk & 7) * 32 + (c & 31)) * 2; }
__device__ __forceinline__ int v_rd_base(int lane) { return ((lane & 3) << 3) | (((lane >> 2) & 3) << 6) | (((lane >> 4) & 1) << 5) | (((lane >> 5) & 1) << 8); }
constexpr int v_rd_off(int d0, int ks, int half) { return d0 * 512 + ks * 4096 + half * 2048; }
__device__ __forceinline__ int crow(int r, int hi) { return (r & 3) + 8 * (r >> 2) + 4 * hi; }
__device__ __forceinline__ unsigned cvtpk(float lo, float hi) { unsigned r; asm volatile("v_cvt_pk_bf16_f32 %0, %1, %2" : "=v"(r) : "v"(lo), "v"(hi)); return r; }
__device__ __forceinline__ bf16x8 ld8(const bf16_t* p) { return *reinterpret_cast<const bf16x8*>(p); }
__device__ __forceinline__ void mask_tile(f32x16& p0, f32x16& p1, int dq) {
    const float NEG = -__builtin_inff();
#pragma unroll
    for (int r = 0; r < 16; ++r) { const int c = (r & 3) + 8 * (r >> 2); if (dq - c < 0) p0[r] = NEG; if (dq - c - 32 < 0) p1[r] = NEG; }
}
__device__ __forceinline__ void partialSM(f32x16& p0, f32x16& p1, float& m_reg, float& mn, float& alpha) {
    float pmax = p0[0]; for (int r = 1; r < 16; ++r) pmax = fmaxf(pmax, p0[r]); for (int r = 0; r < 16; ++r) pmax = fmaxf(pmax, p1[r]);
    { auto rr = __builtin_amdgcn_permlane32_swap(__float_as_uint(pmax), __float_as_uint(pmax), false, false); pmax = fmaxf(__uint_as_float(rr[0]), __uint_as_float(rr[1])); }
    if (__builtin_expect(__all((pmax - m_reg) <= THR2), 1)) { mn = m_reg; alpha = 1.f; }
    else { mn = fmaxf(m_reg, pmax); alpha = __builtin_amdgcn_exp2f(m_reg - mn); m_reg = mn; }
    for (int r = 0; r < 16; ++r) p0[r] = p0[r] - mn; for (int r = 0; r < 16; ++r) p1[r] = p1[r] - mn;
    for (int r = 0; r < 16; ++r) p0[r] = __builtin_amdgcn_exp2f(p0[r]);
}
__device__ __forceinline__ void finishSM(f32x16& p0, f32x16& p1, float alpha, float& l_reg, bf16x8& pa0, bf16x8& pa1, bf16x8& pa2, bf16x8& pa3) {
    for (int r = 0; r < 16; ++r) p1[r] = __builtin_amdgcn_exp2f(p1[r]);
    float ps = 0; for (int r = 0; r < 16; ++r) ps += p0[r]; for (int r = 0; r < 16; ++r) ps += p1[r];
    { auto rr = __builtin_amdgcn_permlane32_swap(__float_as_uint(ps), __float_as_uint(ps), false, false); ps = __uint_as_float(rr[0]) + __uint_as_float(rr[1]); }
    l_reg = l_reg * alpha + ps;
#define PK4(P, B_, OUT) do { unsigned a0 = cvtpk(P[B_+0], P[B_+1]), a1 = cvtpk(P[B_+2], P[B_+3]); unsigned b0 = cvtpk(P[B_+4], P[B_+5]), b1 = cvtpk(P[B_+6], P[B_+7]); \
        auto r0 = __builtin_amdgcn_permlane32_swap(a0, b0, false, false); auto r1 = __builtin_amdgcn_permlane32_swap(a1, b1, false, false); \
        u32x4 w = {r0[0], r1[0], r0[1], r1[1]}; OUT = *reinterpret_cast<bf16x8*>(&w); } while (0)
    PK4(p0, 0, pa0); PK4(p0, 8, pa1); PK4(p1, 0, pa2); PK4(p1, 8, pa3);
#undef PK4
}
template <int KB> __device__ __forceinline__ void qkt(f32x16& p0, f32x16& p1, const char* lds, int r32, int hi, const bf16x8* qr, const char* qrl) {
    p0 = f32x16{}; p1 = f32x16{};
    const char* kb[4];
#pragma unroll
    for (int dd = 0; dd < 4; ++dd) kb[dd] = lds + OFF_K + KB * SHM_K + KSWZ(r32, (dd * 16 + hi * 8) * 2);
#pragma unroll
    for (int d0 = 0; d0 < 8; ++d0) { const char* a = kb[d0 & 3] + (d0 >> 2) * 128;
        bf16x8 b0 = *reinterpret_cast<const bf16x8*>(a); bf16x8 b1 = *reinterpret_cast<const bf16x8*>(a + 32 * 256);
        p0 = __builtin_amdgcn_mfma_f32_32x32x16_bf16(b0, qr[d0], p0, 0, 0, 0); p1 = __builtin_amdgcn_mfma_f32_32x32x16_bf16(b1, qr[d0], p1, 0, 0, 0);
        if (d0 == 3 || d0 == 7) SBAR(); }
#pragma unroll
    for (int d0 = 0; d0 < 4; ++d0) { const char* a = lds + OFF_R + KB * SHM_R + d0 * 2048 + r32 * 32 + hi * 16;
        bf16x8 b0 = *reinterpret_cast<const bf16x8*>(a); bf16x8 b1 = *reinterpret_cast<const bf16x8*>(a + 1024);
        const bf16x8 qf = *reinterpret_cast<const bf16x8*>(qrl + d0 * 1024);
        p0 = __builtin_amdgcn_mfma_f32_32x32x16_bf16(b0, qf, p0, 0, 0, 0); p1 = __builtin_amdgcn_mfma_f32_32x32x16_bf16(b1, qf, p1, 0, 0, 0); }
}
template <int VB> __device__ __forceinline__ void pv_tile(f32x16* o, int vb0, bf16x8 pa0, bf16x8 pa1, bf16x8 pa2, bf16x8 pa3) {
#define TRRD(dst, off) asm volatile("ds_read_b64_tr_b16 %0, %1 offset:%2" : "=&v"(dst) : "v"(vb0), "i"(off) : "memory")
#define PV_D0(d0) do { s16x4 l0, l1, l2, l3, h0, h1, h2, h3; constexpr int b_ = OFF_V + VB * SHM_V + v_rd_off(d0, 0, 0); \
        TRRD(l0, b_); TRRD(h0, b_ + 2048); TRRD(l1, b_ + 4096); TRRD(h1, b_ + 6144); TRRD(l2, b_ + 8192); TRRD(h2, b_ + 10240); TRRD(l3, b_ + 12288); TRRD(h3, b_ + 14336); \
        asm volatile("s_waitcnt lgkmcnt(0)" ::: "memory"); SBAR(); \
        o[d0] = __builtin_amdgcn_mfma_f32_32x32x16_bf16(pa0, (bf16x8){l0[0], l0[1], l0[2], l0[3], h0[0], h0[1], h0[2], h0[3]}, o[d0], 0, 0, 0); \
        o[d0] = __builtin_amdgcn_mfma_f32_32x32x16_bf16(pa1, (bf16x8){l1[0], l1[1], l1[2], l1[3], h1[0], h1[1], h1[2], h1[3]}, o[d0], 0, 0, 0); \
        o[d0] = __builtin_amdgcn_mfma_f32_32x32x16_bf16(pa2, (bf16x8){l2[0], l2[1], l2[2], l2[3], h2[0], h2[1], h2[2], h2[3]}, o[d0], 0, 0, 0); \
        o[d0] = __builtin_amdgcn_mfma_f32_32x32x16_bf16(pa3, (bf16x8){l3[0], l3[1], l3[2], l3[3], h3[0], h3[1], h3[2], h3[3]}, o[d0], 0, 0, 0); } while (0)
    PV_D0(0); PV_D0(1); PV_D0(2); PV_D0(3);
#undef PV_D0
#undef TRRD
}
struct BlockRef { const bf16_t* Qn; const bf16_t* Qr; const bf16_t* K; const bf16_t* V; bf16_t* O; int P0; };
#define DMA16(src, dstoff) __builtin_amdgcn_global_load_lds((const unsigned*)(src), (LAS3 unsigned*)(lds3 + (dstoff)), 16, 0, 0)
#define DMA_K(t, bf) do { const bf16_t* s_ = Kh + (size_t)(t) * (KVBLK * LDK); DMA16(s_ + koff0, OFF_K + (bf) * SHM_K + wid * 2048); DMA16(s_ + koff1, OFF_K + (bf) * SHM_K + wid * 2048 + 1024); } while (0)
#define DMA_V(t, bf) do { const bf16_t* s_ = Vh + (size_t)(t) * (KVBLK * LDK); DMA16(s_ + voff0, OFF_V + (bf) * SHM_V + wid * 2048); DMA16(s_ + voff0 + 64, OFF_V + (bf) * SHM_V + wid * 2048 + 1024); } while (0)
#define DMA_R(t, bf) DMA16(KR + (size_t)(t) * (KVBLK * LDKR) + roff, OFF_R + (bf) * SHM_R + wid * 1024)
#define WAIT_BAR() asm volatile("s_waitcnt vmcnt(0) lgkmcnt(0)\n\ts_barrier" ::: "memory")
__device__ __forceinline__ void block(const BlockRef& cur, const bf16_t* KR, char* lds, LAS3 unsigned char* lds3) {
    const int tid = threadIdx.x, wid = __builtin_amdgcn_readfirstlane(tid >> 6), lane = tid & 63, r32 = lane & 31, hi = lane >> 5;
    const int NT = (cur.P0 + QB) / KVBLK;
    const int qlo = cur.P0 + wid * QBLK, qm = qlo + r32 - 4 * hi;
    float* ws = (float*)(lds + OFF_WS) + wid * 64; float* li_l = ws, * al_l = ws + 32;
    float m_reg = -1e30f, l_reg = 0; f32x16 o[4] = {};
    const int vb0 = (int)(uintptr_t)lds + v_rd_base(lane);
    char* qrl = lds + OFF_QR + wid * 4096 + lane * 16;
    const bf16_t* Kh = cur.K; const bf16_t* Vh = cur.V;
    const int kr0 = lane >> 4, kr1 = 4 + (lane >> 4);
    const int koff0 = (wid * 8 + kr0) * LDK + (((lane & 15) ^ kr0) << 3), koff1 = (wid * 8 + kr1) * LDK + (((lane & 15) ^ kr1) << 3);
    const int vkk = wid * 8 + ((lane & 31) >> 2), vk = (vkk & ~0xC) | ((vkk & 4) << 1) | ((vkk & 8) >> 1);
    const int voff0 = vk * LDK + (lane >> 5) * 32 + (lane & 3) * 8;
    const int roff = ((wid & 1) * 32 + (lane >> 1)) * LDKR + (wid >> 1) * 16 + (lane & 1) * 8;
    bf16x8 qr[8];
#define RESC(a) do { if (__any((a) < 1.f)) { if (hi == 0) al_l[r32] = (a); asm volatile("s_waitcnt lgkmcnt(0)" ::: "memory"); \
                     for (int d_ = 0; d_ < 4; ++d_) for (int r = 0; r < 16; ++r) o[d_][r] *= al_l[crow(r, hi)]; } } while (0)
#define KBASE(t) ((t) * KVBLK)
#define MASKT(P0_, P1_, t) do { const int kb_ = KBASE(t); if (kb_ + KVBLK - 1 > qlo) mask_tile(P0_, P1_, qm - kb_); } while (0)
    f32x16 pA0, pA1, pB0, pB1; float mnA, mnB, alA, alB; bf16x8 pa0, pa1, pa2, pa3;
    DMA_K(0, 0); DMA_R(0, 0);
#pragma unroll
    for (int d0 = 0; d0 < 8; ++d0) qr[d0] = ld8(cur.Qn + (size_t)(wid * QBLK + r32) * LDQ + d0 * 16 + hi * 8);
    { bf16x8 t_[4];
#pragma unroll
      for (int d0 = 0; d0 < 4; ++d0) t_[d0] = ld8(cur.Qr + (size_t)(wid * QBLK + r32) * LDR + d0 * 16 + hi * 8);
#pragma unroll
      for (int d0 = 0; d0 < 4; ++d0) *(bf16x8*)(qrl + d0 * 1024) = t_[d0]; }
    WAIT_BAR();
    DMA_K(1, 1); DMA_R(1, 1); DMA_V(0, 0);
    SBAR(); qkt<0>(pA0, pA1, lds, r32, hi, qr, qrl);
    MASKT(pA0, pA1, 0); partialSM(pA0, pA1, m_reg, mnA, alA);
    WAIT_BAR();
#define STEP(PX0, PX1, mnX, alX, PY0, PY1, alY, t, KB, VB) do { \
        if ((t) + 1 < NT) { DMA_K((t) + 1, VB); DMA_R((t) + 1, VB); } DMA_V((t), KB); \
        SBAR(); qkt<KB>(PX0, PX1, lds, r32, hi, qr, qrl); \
        finishSM(PY0, PY1, alY, l_reg, pa0, pa1, pa2, pa3); SBAR(); \
        pv_tile<VB>(o, vb0, pa0, pa1, pa2, pa3); MASKT(PX0, PX1, (t)); partialSM(PX0, PX1, m_reg, mnX, alX); \
        RESC(alX); WAIT_BAR(); } while (0)
    for (int t = 1; t + 1 < NT; t += 2) {
        STEP(pB0, pB1, mnB, alB, pA0, pA1, alA, t, 1, 0);
        STEP(pA0, pA1, mnA, alA, pB0, pB1, alB, t + 1, 0, 1);
    }
    STEP(pB0, pB1, mnB, alB, pA0, pA1, alA, NT - 1, 1, 0);
    finishSM(pB0, pB1, alB, l_reg, pa0, pa1, pa2, pa3); SBAR(); pv_tile<1>(o, vb0, pa0, pa1, pa2, pa3);
    if (hi == 0) li_l[r32] = l_reg; asm volatile("s_waitcnt lgkmcnt(0)" ::: "memory");
    float rli[16];
#pragma unroll
    for (int r = 0; r < 16; ++r) rli[r] = __builtin_amdgcn_rcpf(li_l[crow(r, hi)]);
    bf16_t* Ow = cur.O + (size_t)(wid * QBLK) * LDQ;
#pragma unroll
    for (int r = 0; r < 16; ++r) { const int orow = crow(r, hi);
#pragma unroll
        for (int d0 = 0; d0 < 4; ++d0) { const float v = o[d0][r] * rli[r]; const float vn = __shfl_xor(v, 1);
            if ((r32 & 1) == 0) *(unsigned*)(Ow + (size_t)orow * LDQ + d0 * 32 + r32) = cvtpk(v, vn); } }
    WAIT_BAR();
#undef RESC
#undef KBASE
#undef MASKT
#undef STEP
}
#undef DMA16
#undef DMA_K
#undef DMA_V
#undef DMA_R
#undef WAIT_BAR
__device__ __forceinline__ BlockRef make_ref(int h, int qb, const bf16_t* qn, const bf16_t* qr, const bf16_t* kn, const bf16_t* vm, bf16_t* ob) {
    BlockRef r; r.Qn = qn + (size_t)qb * QB * LDQ + h * 128; r.Qr = qr + (size_t)qb * QB * LDR + h * 64; r.K = kn + h * 128; r.V = vm + h * 128; r.O = ob + (size_t)qb * QB * LDQ + h * 128; r.P0 = qb * QB; return r;
}
__device__ __forceinline__ void phase(char* lds, LAS3 unsigned char* lds3, const bf16_t* qn, const bf16_t* qr, const bf16_t* kn, const bf16_t* kr, const bf16_t* vm, bf16_t* ob, int vcu, int G) {
    constexpr int NITEMS = H * 16;
    for (int L = vcu; L < NITEMS; L += G) {
        const int h = L >> 4, x = L & 15;
        block(make_ref(h, x, qn, qr, kn, vm, ob), kr, lds, lds3);
        block(make_ref(h, 31 - x, qn, qr, kn, vm, ob), kr, lds, lds3);
    }
}
#undef KSWZ
#undef LAS3
#undef SBAR
}
namespace hg {
typedef short bf16x8 __attribute__((ext_vector_type(8)));
typedef short s16x4 __attribute__((ext_vector_type(4)));
typedef float f32x16 __attribute__((ext_vector_type(16)));
typedef float f32x4 __attribute__((ext_vector_type(4)));
typedef unsigned u32x4 __attribute__((ext_vector_type(4)));
typedef unsigned u32x2 __attribute__((ext_vector_type(2)));
typedef _Float16 f16x8 __attribute__((ext_vector_type(8)));
#define LAS3 __attribute__((address_space(3)))
#define KSWZ(row, colB) ((row) * 256 + ((colB) ^ (((row) & 7) << 4)))
#define SBAR() __builtin_amdgcn_sched_barrier(0)
constexpr int O_QES = 0, O_KES = 16384, O_KET = 32768, O_V = 49152, O_ST = 65536, O_BL = 98304, O_SEG = 131072, O_DL = 133120, O_END = 133632;
constexpr int LD = 2048;
__device__ __forceinline__ int crow(int r, int hi) { return (r & 3) + 8 * (r >> 2) + 4 * hi; }
__device__ __forceinline__ unsigned cvtpk(float lo, float hi) { unsigned r; asm volatile("v_cvt_pk_bf16_f32 %0, %1, %2" : "=v"(r) : "v"(lo), "v"(hi)); return r; }
__device__ __forceinline__ int v_rd_base(int lane) { return ((lane & 3) << 3) | (((lane >> 2) & 3) << 6) | (((lane >> 4) & 1) << 5) | (((lane >> 5) & 1) << 8); }

struct Ptrs { const bf16_t* qh; const f16_t* g16; const bf16_t* v; const bf16_t* og; bf16_t* og_out; const float* ghg; float* U; float* Dg; };

template <bool OUT>
__device__ __forceinline__ void unit(char* lds, LAS3 unsigned char* lds3, const Ptrs& P, int h, int grp) {
    const int tid = threadIdx.x, wid = __builtin_amdgcn_readfirstlane(tid >> 6), lane = tid & 63, r32 = lane & 31, hi = lane >> 5;
    const int tb = wid & 1, vq = wid >> 1;
    const size_t colh = (size_t)h * 128;
    const int vkk = wid * 8 + ((lane & 31) >> 2), vk = (vkk & ~0xC) | ((vkk & 4) << 1) | ((vkk & 8) >> 1);
    const int voff0 = vk * LD + (lane >> 5) * 32 + (lane & 3) * 8;
    const int vb = (int)(uintptr_t)lds + O_V + v_rd_base(lane) + vq * 512;
    f32x16 Sf[2];
    float gsum[16];
#pragma unroll
    for (int j = 0; j < 16; ++j) gsum[j] = 0.f;
    if (OUT) {
        const float* Sin = P.U + ((size_t)(grp * 16 + h) * 128) * 128;
#pragma unroll
        for (int i = 0; i < 2; ++i)
#pragma unroll
            for (int r = 0; r < 16; ++r) Sf[i][r] = Sin[(size_t)(32 * (2 * tb + i) + crow(r, hi)) * 128 + 32 * vq + r32];
    } else { Sf[0] = f32x16{}; Sf[1] = f32x16{}; }
#define WRITE_ST() do { _Pragma("unroll") for (int i = 0; i < 2; ++i) _Pragma("unroll") for (int g = 0; g < 4; ++g) { const int row = 32 * vq + r32, ch = 4 * (2 * tb + i) + g; \
        u32x2 w; w.x = cvtpk(Sf[i][4 * g], Sf[i][4 * g + 1]); w.y = cvtpk(Sf[i][4 * g + 2], Sf[i][4 * g + 3]); \
        *(u32x2*)(lds + O_ST + row * 256 + ((ch * 16) ^ ((row & 7) << 4)) + 8 * hi) = w; } } while (0)
    if (OUT) WRITE_ST();
#define BAR_L() asm volatile("s_waitcnt lgkmcnt(0)\n\ts_barrier" ::: "memory")
#define BAR_VL() asm volatile("s_waitcnt vmcnt(0) lgkmcnt(0)\n\ts_barrier" ::: "memory")
#define DMA_V(tok) do { const bf16_t* s_ = P.v + (size_t)(tok) * LD + colh; \
        __builtin_amdgcn_global_load_lds((const unsigned*)(s_ + voff0), (LAS3 unsigned*)(lds3 + O_V + wid * 2048), 16, 0, 0); \
        __builtin_amdgcn_global_load_lds((const unsigned*)(s_ + voff0 + 64), (LAS3 unsigned*)(lds3 + O_V + wid * 2048 + 1024), 16, 0, 0); } while (0)
    const int t = tid >> 3, kc = (tid & 7) * 16, tl = lane >> 3;
    const size_t grow = ((size_t)grp * 512 + t) * LD + colh + kc;
    f16x8 g0 = *(const f16x8*)(P.g16 + grow), g1 = *(const f16x8*)(P.g16 + grow + 8);
    bf16x8 q0 = {}, q1 = {};
    if (OUT) { q0 = *(const bf16x8*)(P.qh + grow); q1 = *(const bf16x8*)(P.qh + grow + 8); }
    DMA_V((size_t)grp * 512);
    for (int c = 0; c < 8; ++c) {
        const size_t tok0 = (size_t)grp * 512 + c * 64;
        float gl[16], b[16];
#pragma unroll
        for (int j = 0; j < 16; ++j) { gl[j] = (float)(j < 8 ? g0[j] : g1[j - 8]); b[j] = gl[j]; }
#pragma unroll
        for (int j = 0; j < 16; ++j) { float y = __shfl_up(b[j], 8); if (tl >= 1) b[j] += y; y = __shfl_up(b[j], 16); if (tl >= 2) b[j] += y; y = __shfl_up(b[j], 32); if (tl >= 4) b[j] += y; }
        if (tl == 7) { float* sg = (float*)(lds + O_SEG) + wid * 128 + kc;
#pragma unroll
            for (int j4 = 0; j4 < 4; ++j4) *(f32x4*)(sg + 4 * j4) = (f32x4){b[4 * j4], b[4 * j4 + 1], b[4 * j4 + 2], b[4 * j4 + 3]}; }
        BAR_L();
        { const float* sg = (const float*)(lds + O_SEG) + kc;
#pragma unroll
          for (int w = 0; w < 7; ++w) if (w < wid) {
#pragma unroll
              for (int j4 = 0; j4 < 4; ++j4) { const f32x4 x = *(const f32x4*)(sg + w * 128 + 4 * j4); b[4 * j4] += x[0]; b[4 * j4 + 1] += x[1]; b[4 * j4 + 2] += x[2]; b[4 * j4 + 3] += x[3]; } } }
        { float ke[16];
#pragma unroll
          for (int j = 0; j < 16; ++j) ke[j] = (1.f - __expf(gl[j])) * __expf(-b[j]);
          if (OUT) { float qe[16];
#pragma unroll
              for (int j = 0; j < 16; ++j) qe[j] = bf2f((bf16_t)(j < 8 ? q0[j] : q1[j - 8])) * __expf(b[j]);
              u32x4 w0 = {cvtpk(qe[0], qe[1]), cvtpk(qe[2], qe[3]), cvtpk(qe[4], qe[5]), cvtpk(qe[6], qe[7])}, w1 = {cvtpk(qe[8], qe[9]), cvtpk(qe[10], qe[11]), cvtpk(qe[12], qe[13]), cvtpk(qe[14], qe[15])};
              *(u32x4*)(lds + O_QES + KSWZ(t, kc * 2)) = w0; *(u32x4*)(lds + O_QES + KSWZ(t, kc * 2 + 16)) = w1;
              u32x4 k0 = {cvtpk(ke[0], ke[1]), cvtpk(ke[2], ke[3]), cvtpk(ke[4], ke[5]), cvtpk(ke[6], ke[7])}, k1 = {cvtpk(ke[8], ke[9]), cvtpk(ke[10], ke[11]), cvtpk(ke[12], ke[13]), cvtpk(ke[14], ke[15])};
              *(u32x4*)(lds + O_KES + KSWZ(t, kc * 2)) = k0; *(u32x4*)(lds + O_KES + KSWZ(t, kc * 2 + 16)) = k1; }
          { char* kt = lds + O_KET + (t >> 4) * 4096 + kc * 32 + ((t >> 3) & 1) * 16 + (t & 7) * 2;
#pragma unroll
            for (int j = 0; j < 16; ++j) *(unsigned short*)(kt + j * 32) = f2bf(ke[j]); }
          if (t == 63) {
#pragma unroll
              for (int j = 0; j < 16; ++j) { ((float*)(lds + O_DL))[kc + j] = __expf(b[j]); gsum[j] += b[j]; } } }
        BAR_VL();
        bf16x8 e0 = {}, e1 = {};
        if (OUT) { e0 = *(const bf16x8*)(P.og + grow + (size_t)c * 64 * LD); e1 = *(const bf16x8*)(P.og + grow + (size_t)c * 64 * LD + 8); }
        if (c < 7) { const size_t nx = grow + (size_t)(c + 1) * 64 * LD; g0 = *(const f16x8*)(P.g16 + nx); g1 = *(const f16x8*)(P.g16 + nx + 8);
            if (OUT) { q0 = *(const bf16x8*)(P.qh + nx); q1 = *(const bf16x8*)(P.qh + nx + 8); } }
        bf16x8 vf[4];
        { s16x4 lo[4], hh[4];
#pragma unroll
          for (int ks = 0; ks < 4; ++ks) { asm volatile("ds_read_b64_tr_b16 %0, %1 offset:%2" : "=&v"(lo[ks]) : "v"(vb), "i"(ks * 4096) : "memory"); asm volatile("ds_read_b64_tr_b16 %0, %1 offset:%2" : "=&v"(hh[ks]) : "v"(vb), "i"(ks * 4096 + 2048) : "memory"); }
          asm volatile("s_waitcnt lgkmcnt(0)" ::: "memory"); SBAR();
#pragma unroll
          for (int ks = 0; ks < 4; ++ks) vf[ks] = (bf16x8){lo[ks][0], lo[ks][1], lo[ks][2], lo[ks][3], hh[ks][0], hh[ks][1], hh[ks][2], hh[ks][3]}; }
        f32x16 o = f32x16{};
        if (OUT) {
            bf16x8 qr[8];
#pragma unroll
            for (int ks = 0; ks < 8; ++ks) qr[ks] = *(const bf16x8*)(lds + O_QES + KSWZ(32 * tb + r32, (ks * 16 + hi * 8) * 2));
            f32x16 p0 = f32x16{}, p1 = f32x16{};
#pragma unroll
            for (int ks = 0; ks < 8; ++ks) p0 = __builtin_amdgcn_mfma_f32_32x32x16_bf16(*(const bf16x8*)(lds + O_KES + KSWZ(r32, (ks * 16 + hi * 8) * 2)), qr[ks], p0, 0, 0, 0);
            if (tb == 1) {
#pragma unroll
                for (int ks = 0; ks < 8; ++ks) p1 = __builtin_amdgcn_mfma_f32_32x32x16_bf16(*(const bf16x8*)(lds + O_KES + KSWZ(32 + r32, (ks * 16 + hi * 8) * 2)), qr[ks], p1, 0, 0, 0);
#pragma unroll
                for (int r = 0; r < 16; ++r) if (crow(r, hi) > r32) p1[r] = 0.f;
            } else {
#pragma unroll
                for (int r = 0; r < 16; ++r) if (crow(r, hi) > r32) p0[r] = 0.f;
            }
            bf16x8 pa0, pa1, pa2, pa3;
#define PK4(Pv, B_, OUTF) do { unsigned a0 = cvtpk(Pv[B_+0], Pv[B_+1]), a1 = cvtpk(Pv[B_+2], Pv[B_+3]); unsigned b0 = cvtpk(Pv[B_+4], Pv[B_+5]), b1 = cvtpk(Pv[B_+6], Pv[B_+7]); \
        auto r0 = __builtin_amdgcn_permlane32_swap(a0, b0, false, false); auto r1 = __builtin_amdgcn_permlane32_swap(a1, b1, false, false); \
        u32x4 w = {r0[0], r1[0], r0[1], r1[1]}; OUTF = *reinterpret_cast<bf16x8*>(&w); } while (0)
            PK4(p0, 0, pa0); PK4(p0, 8, pa1); PK4(p1, 0, pa2); PK4(p1, 8, pa3);
#undef PK4
            o = __builtin_amdgcn_mfma_f32_32x32x16_bf16(pa0, vf[0], o, 0, 0, 0); o = __builtin_amdgcn_mfma_f32_32x32x16_bf16(pa1, vf[1], o, 0, 0, 0);
            o = __builtin_amdgcn_mfma_f32_32x32x16_bf16(pa2, vf[2], o, 0, 0, 0); o = __builtin_amdgcn_mfma_f32_32x32x16_bf16(pa3, vf[3], o, 0, 0, 0);
#pragma unroll
            for (int ks = 0; ks < 8; ++ks) o = __builtin_amdgcn_mfma_f32_32x32x16_bf16(qr[ks], *(const bf16x8*)(lds + O_ST + KSWZ(32 * vq + r32, (ks * 16 + hi * 8) * 2)), o, 0, 0, 0);
        }
#pragma unroll
        for (int i = 0; i < 2; ++i) { const int kb = 2 * tb + i; f32x16 acc = f32x16{};
#pragma unroll
            for (int ks = 0; ks < 4; ++ks) acc = __builtin_amdgcn_mfma_f32_32x32x16_bf16(*(const bf16x8*)(lds + O_KET + ks * 4096 + (32 * kb + r32) * 32 + hi * 16), vf[ks], acc, 0, 0, 0);
#pragma unroll
            for (int r = 0; r < 16; ++r) Sf[i][r] = ((const float*)(lds + O_DL))[32 * kb + crow(r, hi)] * (Sf[i][r] + acc[r]); }
        BAR_L();
        if (!OUT) { if (c < 7) DMA_V(tok0 + 64); }
        if (OUT) {
            WRITE_ST();
            { float* ot = (float*)(lds + O_BL);
#pragma unroll
              for (int r = 0; r < 16; ++r) ot[(32 * tb + crow(r, hi)) * 128 + 32 * vq + r32] = o[r]; }
            BAR_L();
            { const int vc = kc; const float* ot = (const float*)(lds + O_BL) + t * 128 + vc; float x[16]; float ss = 0.f;
#pragma unroll
              for (int j4 = 0; j4 < 4; ++j4) { const f32x4 y = *(const f32x4*)(ot + 4 * j4); x[4 * j4] = y[0]; x[4 * j4 + 1] = y[1]; x[4 * j4 + 2] = y[2]; x[4 * j4 + 3] = y[3]; ss += (y[0] * y[0] + y[1] * y[1]) + (y[2] * y[2] + y[3] * y[3]); }
              ss += __shfl_xor(ss, 1); ss += __shfl_xor(ss, 2); ss += __shfl_xor(ss, 4);
              const float rstd = rsqrtf(ss * (1.f / 128.f) + EPS);
              bf16_t* op = P.og_out + (tok0 + t) * LD + colh + vc;
#pragma unroll
              for (int j = 0; j < 16; ++j) x[j] = x[j] * rstd * P.ghg[vc + j] * bf2f((bf16_t)(j < 8 ? e0[j] : e1[j - 8]));
              if (c < 7) DMA_V(tok0 + 64);
              u32x4 w0 = {cvtpk(x[0], x[1]), cvtpk(x[2], x[3]), cvtpk(x[4], x[5]), cvtpk(x[6], x[7])}, w1 = {cvtpk(x[8], x[9]), cvtpk(x[10], x[11]), cvtpk(x[12], x[13]), cvtpk(x[14], x[15])};
              *(u32x4*)op = w0; *(u32x4*)(op + 8) = w1; }
        }
    }
    BAR_VL();
#undef BAR_L
#undef BAR_VL
#undef DMA_V
    if (!OUT) {
        float* Uo = P.U + ((size_t)(grp * 16 + h) * 128) * 128;
#pragma unroll
        for (int i = 0; i < 2; ++i)
#pragma unroll
            for (int r = 0; r < 16; ++r) Uo[(size_t)(32 * (2 * tb + i) + crow(r, hi)) * 128 + 32 * vq + r32] = Sf[i][r];
        if ((tid >> 3) == 63) { const int kc = (tid & 7) * 16;
#pragma unroll
            for (int j = 0; j < 16; ++j) P.Dg[(size_t)(grp * 16 + h) * 128 + kc + j] = __expf(gsum[j]); }
    }
#undef WRITE_ST
}
template <bool OUT> __device__ __forceinline__ void phase(char* lds, LAS3 unsigned char* lds3, const Ptrs& P, int vcu, int G) {
    for (int u = vcu; u < 256; u += G) unit<OUT>(lds, lds3, P, u >> 4, u & 15);
}
__device__ __forceinline__ void scan_phase(float* U, const float* Dg, int gt, int NGT) {
    for (int e = gt; e < 16 * 128 * 128; e += NGT) { const int hk = e >> 7; float cur = 0.f;
#pragma unroll
        for (int g = 0; g < 16; ++g) { const size_t idx = (size_t)g * (16 * 128 * 128) + e; const float u = U[idx], d = Dg[(size_t)g * (16 * 128) + hk]; U[idx] = cur; cur = d * cur + u; } }
}
#undef LAS3
#undef KSWZ
#undef SBAR
}
#define GAS __attribute__((address_space(1)))
#define LAS __attribute__((address_space(3)))
typedef float f32x4 __attribute__((ext_vector_type(4)));
typedef unsigned v4u __attribute__((ext_vector_type(4)));
typedef unsigned v2u __attribute__((ext_vector_type(2)));
constexpr int NWAVES = 8, NTHREADS = 512;
constexpr int RING_BYTES = 131072, LDS_BYTES = 147456;
constexpr int MISC_OFF = LDS_BYTES - 256, CW_BAR = 4096;
#define LDS_WAIT() asm volatile("s_waitcnt lgkmcnt(0)" ::: "memory")
__device__ __forceinline__ unsigned pk2(float lo, float hi) { return (unsigned)f2bf(lo) | ((unsigned)f2bf(hi) << 16); }
__device__ __forceinline__ float wave_sum(float v) {
#pragma unroll
    for (int o = 1; o < 64; o <<= 1) v += __shfl_xor(v, o);
    return v;
}
#define XB_TMO      128
#define XB_XCNT(j)  (256  + 64 * (j))
#define XB_XSUB(j)  (1280 + 64 * (j))
#define XB_XGEN(j)  (2304 + 64 * (j))
#define XB_TOP      3328
#define XB_TOPGEN   3392
#define XCD_BAR_WORDS 3456
#define XB_SPIN_CAP (1u << 18)

__device__ __forceinline__ unsigned xb_ld(unsigned* p)              { return __hip_atomic_load(p, __ATOMIC_RELAXED, __HIP_MEMORY_SCOPE_AGENT); }
__device__ __forceinline__ unsigned xb_add(unsigned* p, unsigned v) { return __hip_atomic_fetch_add(p, v, __ATOMIC_RELAXED, __HIP_MEMORY_SCOPE_AGENT); }
__device__ __forceinline__ unsigned xb_xcc_id() { return (unsigned)__builtin_amdgcn_s_getreg((3 << 11) | 20) & 0xFu; }
#define XB_SPIN(cond, bar) do { unsigned _sp = 0; while (cond) { __builtin_amdgcn_s_sleep(1); \
    if ((++_sp & 255u) == 0u) { if (xb_ld(&(bar)[XB_TMO])) break; if (_sp > XB_SPIN_CAP) { atomicAdd(&(bar)[XB_TMO], 1u); break; } } } } while (0)

struct XcdBarrier {
    unsigned* bar; unsigned x;
    volatile LAS unsigned* st;
};

__device__ __forceinline__ XcdBarrier xcd_barrier_post(unsigned* bar, volatile LAS unsigned* st) {
    XcdBarrier b; b.bar = bar; b.x = xb_xcc_id(); b.st = st;
    if (threadIdx.x == 0) (void)xb_add(&bar[XB_XCNT(b.x)], 1u);
    return b;
}
__device__ __forceinline__ void xcd_barrier_complete(unsigned* bar, unsigned x, unsigned& nloc, unsigned& nx) {
    const unsigned G = gridDim.x * gridDim.y * gridDim.z;
    unsigned sum, cnt, mine, sp = 0u;
    for (;;) {
        sum = 0u; cnt = 0u; mine = 0u;
#pragma unroll
        for (unsigned j = 0; j < 16; ++j) { const unsigned c = xb_ld(&bar[XB_XCNT(j)]); sum += c; cnt += (c > 0u) ? 1u : 0u; mine = (j == x) ? c : mine; }
        if (sum == G) break;
        __builtin_amdgcn_s_sleep(1);
        if ((++sp & 255u) == 0u) { if (xb_ld(&bar[XB_TMO])) break; if (sp > XB_SPIN_CAP) { atomicAdd(&bar[XB_TMO], 1u); break; } }
    }
    nloc = mine > 0u ? mine : 1u; nx = cnt > 0u ? cnt : 1u;
}

__device__ __forceinline__ void xcd_barrier(const XcdBarrier& b) {
    asm volatile("s_waitcnt vmcnt(0)" ::: "memory");
    __syncthreads();
    if (threadIdx.x == 0) {
        unsigned* bar = b.bar;
        __builtin_amdgcn_s_waitcnt(0);
        unsigned nloc = b.st[0], nx = b.st[1];
        if (nloc == 0u) { xcd_barrier_complete(bar, b.x, nloc, nx); b.st[0] = nloc; b.st[1] = nx; }
        const unsigned old = xb_add(&bar[XB_XSUB(b.x)], 1u);
        const unsigned gen = old / nloc;
        if (old + 1u == (gen + 1u) * nloc) {
            __builtin_amdgcn_fence(__ATOMIC_RELEASE, "agent");
            asm volatile("s_waitcnt vmcnt(0)" ::: "memory");
            const unsigned og = xb_add(&bar[XB_TOP], 1u);
            const unsigned tg = og / nx;
            if (og + 1u == (tg + 1u) * nx) xb_add(&bar[XB_TOPGEN], 1u);
            else XB_SPIN(xb_ld(&bar[XB_TOPGEN]) == tg, bar);
            __builtin_amdgcn_fence(__ATOMIC_ACQUIRE, "agent");
            xb_add(&bar[XB_XGEN(b.x)], 1u);
            asm volatile("s_waitcnt vmcnt(0)" ::: "memory");
        } else {
            XB_SPIN(xb_ld(&bar[XB_XGEN(b.x)]) == gen, bar);
            __builtin_amdgcn_fence(__ATOMIC_ACQUIRE, "agent");
            asm volatile("s_waitcnt vmcnt(0)" ::: "memory");
        }
    }
    __syncthreads();
}

struct Args { const void* in[21]; float* out; unsigned char* ws; int ph_lo, ph_hi; };

template <int MAP> __device__ __forceinline__ int src_map(int n) { return MAP == 0 ? src_in(n) : MAP == 1 ? src_uq(n) : MAP == 2 ? src_gu(n) : n; }
template <int MAP> __device__ __forceinline__ void p0_transpose_item(const float* W, int K, int N, int NP, const float* scale, bf16_t* WT, LAS float* scr, int item, int lane) {
    const int nblk = NP / 64, kb = item / nblk, nb = item % nblk, k0 = 64 * kb, n0 = 64 * nb;
    const int nq = (lane & 15) * 4, kr = lane >> 4;
    const int s0 = src_map<MAP>(n0 + nq), s1 = src_map<MAP>(n0 + nq + 1), s2 = src_map<MAP>(n0 + nq + 2), s3 = src_map<MAP>(n0 + nq + 3);
    f32x4 v[16];
    if (__all(s0 >= 0 && s1 == s0 + 1 && s2 == s0 + 2 && s3 == s0 + 3)) {
#pragma unroll
        for (int i = 0; i < 16; ++i) v[i] = *(const f32x4*)(W + (size_t)(k0 + 4 * i + kr) * N + s0);
    } else {
#pragma unroll
        for (int i = 0; i < 16; ++i) { const float* wr = W + (size_t)(k0 + 4 * i + kr) * N; v[i][0] = s0 >= 0 ? wr[s0] : 0.f; v[i][1] = s1 >= 0 ? wr[s1] : 0.f; v[i][2] = s2 >= 0 ? wr[s2] : 0.f; v[i][3] = s3 >= 0 ? wr[s3] : 0.f; }
    }
    if (scale) {
#pragma unroll
        for (int i = 0; i < 16; ++i) v[i] *= scale[k0 + 4 * i + kr]; }
#pragma unroll
    for (int i = 0; i < 16; ++i)
#pragma unroll
        for (int q = 0; q < 4; ++q) scr[(nq + q) * 65 + 4 * i + kr] = v[i][q];
    LDS_WAIT(); asm volatile("" ::: "memory");
    const int c = lane & 7;
#pragma unroll
    for (int j = 0; j < 8; ++j) { const int n = (lane >> 3) + 8 * j; const LAS float* s = scr + n * 65 + 8 * c;
        v4u o; o.x = pk2(s[0], s[1]); o.y = pk2(s[2], s[3]); o.z = pk2(s[4], s[5]); o.w = pk2(s[6], s[7]);
        *(GAS v4u*)(WT + (size_t)(n0 + n) * K + k0 + 8 * c) = o; }
    LDS_WAIT(); asm volatile("" ::: "memory");
}
__device__ __forceinline__ void p0_prologue(const Args& a, LAS unsigned char* lds, int vcu, int G, int wave, int lane, int tid) {
    unsigned char* ws = a.ws;
    { LAS float* scr = (LAS float*)(lds + wave * 16640);
      const int gw = vcu * NWAVES + wave, NGW = G * NWAVES;
      constexpr int I_IN = (D / 64) * (IN_WP / 64), I_SQ = (D / 64) * (D / 64), I_UQ = (QL / 64) * (UQ_W / 64), I_UKV = (KVL / 64) * (UKV_W / 64), I_GU = (D / 64) * (GU_W / 64), I_DN = (DFF / 64) * (D / 64);
      constexpr int NITEMS = I_IN + 3 * I_SQ + I_UQ + I_UKV + I_GU + I_DN;
      for (int it = gw; it < NITEMS; it += NGW) { int r = it;
          if (r < I_IN) { p0_transpose_item<0>((const float*)a.in[6], D, IN_W, IN_WP, nullptr, (bf16_t*)(ws + WS_WIN), scr, r, lane); continue; } r -= I_IN;
          if (r < I_GU) { p0_transpose_item<2>((const float*)a.in[18], D, GU_W, GU_W, nullptr, (bf16_t*)(ws + WS_WGU), scr, r, lane); continue; } r -= I_GU;
          if (r < I_DN) { p0_transpose_item<3>((const float*)a.in[19], DFF, D, D, nullptr, (bf16_t*)(ws + WS_WDN), scr, r, lane); continue; } r -= I_DN;
          if (r < I_SQ) { p0_transpose_item<3>((const float*)a.in[9], D, D, D, nullptr, (bf16_t*)(ws + WS_WOHG), scr, r, lane); continue; } r -= I_SQ;
          if (r < I_SQ) { p0_transpose_item<3>((const float*)a.in[14], D, D, D, nullptr, (bf16_t*)(ws + WS_WOMLA), scr, r, lane); continue; } r -= I_SQ;
          if (r < I_SQ) { p0_transpose_item<3>((const float*)a.in[15], D, D, D, nullptr, (bf16_t*)(ws + WS_WOUT), scr, r, lane); continue; } r -= I_SQ;
          if (r < I_UQ) { p0_transpose_item<1>((const float*)a.in[11], QL, UQ_W, UQ_W, (const float*)a.in[10], (bf16_t*)(ws + WS_WUQ), scr, r, lane); continue; } r -= I_UQ;
          p0_transpose_item<3>((const float*)a.in[13], KVL, UKV_W, UKV_W, (const float*)a.in[12], (bf16_t*)(ws + WS_WUKV), scr, r, lane);
      } }
    __syncthreads();
    { const int gt = vcu * NTHREADS + tid, NGT = G * NTHREADS; const int* pos = (const int*)a.in[2]; float* rope = (float*)(ws + WS_ROPE);
      const int j = gt & 31; const float inv = (float)pow(10000.0, -(double)(2 * j) / 64.0);
      for (int i = gt; i < S * 32; i += NGT) { const int t = i >> 5; const float ang = (float)pos[t] * inv; double sn, cs; sincos((double)ang, &sn, &cs);
          rope[2 * i] = (float)cs; rope[2 * i + 1] = (float)sn; }
      if (gt < 2048) { const float* ll = (const float*)a.in[7]; const float x0 = ll[gt], x1 = ll[2048 + gt], m = fmaxf(x0, x1); const float e0 = expf(x0 - m), e1 = expf(x1 - m); ((float*)(ws + WS_LB))[gt] = e0 / (e0 + e1); } }
    { LAS float* sc = (LAS float*)lds; LAS float* part = (LAS float*)(lds + 8192);
      const float* c = (const float*)a.in[1]; const float* w_ada = (const float*)a.in[3]; const float* b_ada = (const float*)a.in[4];
      for (int i = tid; i < D; i += NTHREADS) { const float cv = c[i]; sc[i] = cv / (1.f + expf(-cv)); }
      __syncthreads();
      for (int cb = vcu; cb < (NMOD * D) / 48; cb += G) {
          const int rg = tid / 12, cg = tid % 12; f32x4 acc = {0.f, 0.f, 0.f, 0.f};
          if (rg < 42) { const float* wp = w_ada + (size_t)cb * 48 + cg * 4;
              for (int r0 = rg; r0 < D; r0 += 42 * 7) { f32x4 w[7];
#pragma unroll
                  for (int u = 0; u < 7; ++u) { const int r = r0 + 42 * u; w[u] = r < D ? *(const f32x4*)(wp + (size_t)r * (NMOD * D)) : (f32x4){0.f, 0.f, 0.f, 0.f}; }
#pragma unroll
                  for (int u = 0; u < 7; ++u) { const int r = r0 + 42 * u; if (r < D) acc += w[u] * sc[r]; } }
              *(LAS f32x4*)(part + rg * 48 + cg * 4) = acc; }
          __syncthreads();
          if (tid < 48) { float s = 0.f; for (int r = 0; r < 42; ++r) s += part[r * 48 + tid]; ((float*)(ws + WS_MOD))[cb * 48 + tid] = s + b_ada[cb * 48 + tid]; }
          __syncthreads();
      } }
}
__device__ __forceinline__ void p1_rows_h(const Args& a, int gw, int NGW, int lane) {
    const float* x = (const float*)a.in[0]; const float* g = (const float*)a.in[5]; const float* mod = (const float*)(a.ws + WS_MOD); bf16_t* h = (bf16_t*)(a.ws + WS_H);
    for (int row = gw; row < S; row += NGW) {
        const f32x4* xr = (const f32x4*)(x + (size_t)row * D) + lane; f32x4 v[8]; float ss = 0.f;
#pragma unroll
        for (int j = 0; j < 8; ++j) { v[j] = xr[64 * j]; ss += (v[j][0] * v[j][0] + v[j][1] * v[j][1]) + (v[j][2] * v[j][2] + v[j][3] * v[j][3]); }
        const float rstd = rsqrtf(wave_sum(ss) * (1.f / D) + EPS);
        v2u* o = (v2u*)(h + (size_t)row * D) + lane;
#pragma unroll
        for (int j = 0; j < 8; ++j) { const int cidx = 64 * j + lane; const f32x4 gg = ((const f32x4*)g)[cidx], sh = ((const f32x4*)mod)[cidx], sc = ((const f32x4*)(mod + 2048))[cidx];
            const f32x4 r = v[j] * rstd * gg * (sc + 1.f) + sh; v2u w; w.x = pk2(r[0], r[1]); w.y = pk2(r[2], r[3]); o[64 * j] = w; }
    }
}
__device__ __forceinline__ void p9_rows_mid(const Args& a, int gw, int NGW, int lane) {
    const float* x = (const float*)a.in[0]; const float* y = (const float*)(a.ws + WS_Y); const float* ssy = (const float*)(a.ws + WS_SSY); const float* mod = (const float*)(a.ws + WS_MOD);
    const float* gpost = (const float*)a.in[16]; const float* gpre = (const float*)a.in[17]; bf16_t* h2 = (bf16_t*)(a.ws + WS_H);
    for (int row = gw; row < S; row += NGW) {
        const float rstd = rsqrtf(wave_sum(lane < 32 ? ssy[(size_t)row * 32 + lane] : 0.f) * (1.f / D) + EPS);
        const f32x4* xr = (const f32x4*)(x + (size_t)row * D) + lane; const f32x4* yr = (const f32x4*)(y + (size_t)row * D) + lane; f32x4* orow = (f32x4*)(a.out + (size_t)row * D) + lane;
        f32x4 v[8]; float ss = 0.f;
#pragma unroll
        for (int j = 0; j < 8; ++j) { const int cidx = 64 * j + lane; const f32x4 ga = ((const f32x4*)(mod + 4096))[cidx], gp = ((const f32x4*)gpost)[cidx];
            v[j] = xr[64 * j] + ga * (yr[64 * j] * rstd * gp); orow[64 * j] = v[j]; ss += (v[j][0] * v[j][0] + v[j][1] * v[j][1]) + (v[j][2] * v[j][2] + v[j][3] * v[j][3]); }
        const float r2 = rsqrtf(wave_sum(ss) * (1.f / D) + EPS);
        v2u* o = (v2u*)(h2 + (size_t)row * D) + lane;
#pragma unroll
        for (int j = 0; j < 8; ++j) { const int cidx = 64 * j + lane; const f32x4 gg = ((const f32x4*)gpre)[cidx], sh = ((const f32x4*)(mod + 6144))[cidx], sc = ((const f32x4*)(mod + 8192))[cidx];
            const f32x4 r = v[j] * r2 * gg * (sc + 1.f) + sh; v2u w; w.x = pk2(r[0], r[1]); w.y = pk2(r[2], r[3]); o[64 * j] = w; }
    }
}
__device__ __forceinline__ void p12_rows_final(const Args& a, int gw, int NGW, int lane) {
    const float* y2 = (const float*)(a.ws + WS_Y2); const float* ss2 = (const float*)(a.ws + WS_SSY2); const float* mod = (const float*)(a.ws + WS_MOD); const float* gpost = (const float*)a.in[20];
    for (int row = gw; row < S; row += NGW) {
        const float rstd = rsqrtf(wave_sum(lane < 32 ? ss2[(size_t)row * 32 + lane] : 0.f) * (1.f / D) + EPS);
        const f32x4* yr = (const f32x4*)(y2 + (size_t)row * D) + lane; f32x4* orow = (f32x4*)(a.out + (size_t)row * D) + lane;
#pragma unroll
        for (int j = 0; j < 8; ++j) { const int cidx = 64 * j + lane; const f32x4 ga = ((const f32x4*)(mod + 10240))[cidx], gp = ((const f32x4*)gpost)[cidx];
            orow[64 * j] = orow[64 * j] + ga * (yr[64 * j] * rstd * gp); }
    }
}

__global__ void __launch_bounds__(NTHREADS, 2) fwd(Args a) {
    extern __shared__ __attribute__((aligned(16))) unsigned char lds_raw[];
    LAS unsigned char* lds = (LAS unsigned char*)lds_raw;
    const int tid = threadIdx.x, lane = tid & 63, wave = __builtin_amdgcn_readfirstlane(tid >> 6);
    const int G = gridDim.x, bx = blockIdx.x, vcu = (G % 8 == 0) ? (bx % 8) * (G / 8) + bx / 8 : bx;
    const int gw = vcu * NWAVES + wave, NGW = G * NWAVES;
    unsigned char* ws = a.ws;
    const int lo = a.ph_lo, hi = a.ph_hi;
    volatile LAS unsigned* MISC = (volatile LAS unsigned*)(lds + MISC_OFF);
    if (tid < 16) MISC[tid] = 0u;
    __syncthreads();
    XcdBarrier bar = xcd_barrier_post((unsigned*)(ws + WS_CTL) + CW_BAR, MISC + 8);
#define IN(k) (lo <= (k) && (k) < hi)
#define BAR_AFTER(k) do { if (IN(k) && IN((k) + 1)) xcd_barrier(bar); } while (0)
    const hg::Ptrs hp{(const bf16_t*)(ws + WS_QH), (const f16_t*)(ws + WS_G16), (const bf16_t*)(ws + WS_V), (const bf16_t*)(ws + WS_OG), (bf16_t*)(ws + WS_OG), (const float*)a.in[8], (float*)(ws + WS_U), (float*)(ws + WS_DG)};
    if (IN(0)) p0_prologue(a, lds, vcu, G, wave, lane, tid);
#if PROBE_DUP == 100
    if (IN(0)) { __syncthreads(); p0_prologue(a, lds, vcu, G, wave, lane, tid); }
#endif
    BAR_AFTER(0);
    if (IN(1)) p1_rows_h(a, gw, NGW, lane);
    BAR_AFTER(1);
    if (IN(2)) {
        pg8::Gemm g{(const bf16_t*)(ws + WS_H), (const bf16_t*)(ws + WS_WIN), S, IN_WP, D}; pg8::StaticOrder So; So.init(S, IN_WP, G, bx);
        pg8::EpiIn E{(bf16_t*)(ws + WS_QH), (bf16_t*)(ws + WS_G16), (bf16_t*)(ws + WS_V), (bf16_t*)(ws + WS_OG), (bf16_t*)(ws + WS_SA), (bf16_t*)(ws + WS_SB), (bf16_t*)(ws + WS_CQ), (bf16_t*)(ws + WS_CKV), (bf16_t*)(ws + WS_KR),
                     (const float*)(ws + WS_LB), (const float*)(ws + WS_ROPE), (float*)(ws + WS_SSQ), (float*)(ws + WS_SSKV)};
        pg8::gemm_phase<pg8::EpiIn, pg8::StaticOrder, true, true>(lds, g, So, E);
#if PROBE_DUP == 102
        pg8::gemm_phase<pg8::EpiIn, pg8::StaticOrder, true, true>(lds, g, So, E);
#endif
    }
    BAR_AFTER(2);
    if (IN(3)) {
        { pg8::Gemm g{(const bf16_t*)(ws + WS_CQ), (const bf16_t*)(ws + WS_WUQ), S, UQ_W, QL}; pg8::StaticOrder So; So.init(S, UQ_W, G, bx);
          pg8::EpiUq E{(bf16_t*)(ws + WS_QN), (bf16_t*)(ws + WS_QR), (const float*)(ws + WS_SSQ), (const float*)(ws + WS_ROPE), QSCALE, EPS};
          pg8::gemm_phase<pg8::EpiUq, pg8::StaticOrder, true, true>(lds, g, So, E); }
        { pg8::Gemm g{(const bf16_t*)(ws + WS_CKV), (const bf16_t*)(ws + WS_WUKV), S, UKV_W, KVL}; pg8::StaticOrder So; So.init(S, UKV_W, G, bx);
          pg8::EpiUkv E{(bf16_t*)(ws + WS_KN), (bf16_t*)a.out, (const float*)(ws + WS_SSKV), EPS};
          pg8::gemm_phase<pg8::EpiUkv, pg8::StaticOrder, true, true>(lds, g, So, E); }
        hg::phase<false>((char*)lds_raw, lds, hp, vcu, G);
#if PROBE_DUP == 103
        hg::phase<false>((char*)lds_raw, lds, hp, vcu, G);
#endif
    }
    BAR_AFTER(3);
    if (IN(4)) hg::scan_phase((float*)(ws + WS_U), (const float*)(ws + WS_DG), vcu * NTHREADS + tid, G * NTHREADS);
    BAR_AFTER(4);
    if (IN(5)) {
#if PROBE_DUP == 105
        att::phase((char*)lds_raw, lds, (bf16_t*)(ws + WS_QN), (const bf16_t*)(ws + WS_QR), (const bf16_t*)(ws + WS_KN), (const bf16_t*)(ws + WS_KR), (const bf16_t*)a.out, (bf16_t*)((unsigned char*)a.out + 32 * MiB), vcu, G);
#endif
        att::phase((char*)lds_raw, lds, (bf16_t*)(ws + WS_QN), (const bf16_t*)(ws + WS_QR), (const bf16_t*)(ws + WS_KN), (const bf16_t*)(ws + WS_KR), (const bf16_t*)a.out, (bf16_t*)(ws + WS_QN), vcu, G);
#if PROBE_DUP == 106
        { hg::Ptrs hp2 = hp; hp2.og_out = (bf16_t*)((unsigned char*)a.out + 32 * MiB); hg::phase<true>((char*)lds_raw, lds, hp2, vcu, G); }
#endif
        hg::phase<true>((char*)lds_raw, lds, hp, vcu, G);
    }
    BAR_AFTER(5);
    if (IN(6)) {
        { pg8::Gemm g{(const bf16_t*)(ws + WS_OG), (const bf16_t*)(ws + WS_WOHG), S, D, D}; pg8::StaticOrder So; So.init(S, D, G, bx);
          pg8::EpiYa E{(float*)(ws + WS_YAS), (const bf16_t*)(ws + WS_SA)};
          pg8::gemm_phase<pg8::EpiYa, pg8::StaticOrder, true, true>(lds, g, So, E); }
        { pg8::Gemm g{(const bf16_t*)(ws + WS_QN), (const bf16_t*)(ws + WS_WOMLA), S, D, D}; pg8::StaticOrder So; So.init(S, D, G, bx);
          pg8::EpiYb E{(const float*)(ws + WS_YAS), (const bf16_t*)(ws + WS_SB), (bf16_t*)(ws + WS_MERGED)};
          pg8::gemm_phase<pg8::EpiYb, pg8::StaticOrder, true, true>(lds, g, So, E); }
    }
    BAR_AFTER(6);
    if (IN(7)) {
        pg8::Gemm g{(const bf16_t*)(ws + WS_MERGED), (const bf16_t*)(ws + WS_WOUT), S, D, D}; pg8::StaticOrder So; So.init(S, D, G, bx);
        pg8::EpiF32SS E{(float*)(ws + WS_Y), (float*)(ws + WS_SSY)};
        pg8::gemm_phase<pg8::EpiF32SS, pg8::StaticOrder, true, true>(lds, g, So, E);
    }
    BAR_AFTER(7);
    if (IN(8)) p9_rows_mid(a, gw, NGW, lane);
    BAR_AFTER(8);
    if (IN(9)) {
        pg8::Gemm g{(const bf16_t*)(ws + WS_H), (const bf16_t*)(ws + WS_WGU), S, GU_W, D}; pg8::StaticOrder So; So.init(S, GU_W, G, bx);
        pg8::EpiGu E{(bf16_t*)(ws + WS_ACT), DFF};
        pg8::gemm_phase<pg8::EpiGu, pg8::StaticOrder, true, true>(lds, g, So, E);
#if PROBE_DUP == 109
        pg8::gemm_phase<pg8::EpiGu, pg8::StaticOrder, true, true>(lds, g, So, E);
#endif
    }
    BAR_AFTER(9);
    if (IN(10)) {
        pg8::Gemm g{(const bf16_t*)(ws + WS_ACT), (const bf16_t*)(ws + WS_WDN), S, D, DFF}; pg8::StaticOrder So; So.init(S, D, G, bx);
        pg8::EpiF32SS E{(float*)(ws + WS_Y2), (float*)(ws + WS_SSY2)};
        pg8::gemm_phase<pg8::EpiF32SS, pg8::StaticOrder, true, true>(lds, g, So, E);
    }
    BAR_AFTER(10);
    if (IN(11)) p12_rows_final(a, gw, NGW, lane);
#undef IN
#undef BAR_AFTER
}
extern "C" void kernel_launch(void* const* d_in, const int* in_sizes, int n_in, void* d_out, int out_size, void* d_ws, size_t ws_size, hipStream_t stream) {
    static int grid = 0;
    if (grid == 0) {
        if (n_in != 21 || out_size != S * D || ws_size < WS_END) { fprintf(stderr, "kernel_launch: unexpected shapes (n_in %d out %d ws %zu)\n", n_in, out_size, ws_size); grid = -1; return; }
        int dev = 0, cus = 0;
        if (hipGetDevice(&dev) != hipSuccess || hipDeviceGetAttribute(&cus, hipDeviceAttributeMultiprocessorCount, dev) != hipSuccess) { grid = -1; return; }
        if (hipFuncSetAttribute((const void*)fwd, hipFuncAttributeMaxDynamicSharedMemorySize, LDS_BYTES) != hipSuccess) { fprintf(stderr, "kernel_launch: hipFuncSetAttribute failed\n"); grid = -1; return; }
        int per_cu = 0;
        if (hipOccupancyMaxActiveBlocksPerMultiprocessor(&per_cu, (const void*)fwd, NTHREADS, LDS_BYTES) != hipSuccess || per_cu < 1) { fprintf(stderr, "kernel_launch: occupancy query failed (%d)\n", per_cu); (void)hipGetLastError(); per_cu = 1; }
        grid = cus;
    }
    if (grid < 0) return;
    Args a{};
    for (int i = 0; i < 21; ++i) a.in[i] = d_in[i];
    a.out = (float*)d_out; a.ws = (unsigned char*)d_ws;
    auto run = [&](int lo, int hi) { a.ph_lo = lo; a.ph_hi = hi; hipLaunchKernelGGL(fwd, dim3(grid), dim3(NTHREADS), LDS_BYTES, stream, a); };
    if (hipMemsetAsync((char*)d_ws + WS_CTL, 0, 65536, stream) != hipSuccess) { fprintf(stderr, "kernel_launch: hipMemsetAsync failed\n"); return; }
    run(0, 12);
}
```

```cpp
#ifndef PROBE_DUP
#define PROBE_DUP 0
#endif
#include <hip/hip_runtime.h>
#include <hip/hip_bf16.h>
#include <hip/hip_fp16.h>
#include <cstdio>
#include <cstdint>

typedef unsigned short bf16_t;
typedef unsigned short f16_t;

constexpr int S = 8192, D = 2048, H = 16, HK = 128, HV = 128;
constexpr int QL = 512, KVL = 512, NOPE = 128, ROPE = 64, VD = 128, QKD = 192;
constexpr int DFF = 5632, NMOD = 6;
constexpr int IN_W = 13376, IN_WP = 13568;
constexpr int UQ_W = 3072, UKV_W = 4096, GU_W = 11264;
constexpr float EPS = 1e-6f;
constexpr float QSCALE = 0.07216878364870322f * 1.4426950408889634f;

constexpr size_t MiB = 1u << 20;
constexpr size_t WS_CTL = 0;
constexpr size_t WS_MOD = 1 * MiB;
constexpr size_t WS_LB = 1 * MiB + 64 * 1024;
constexpr size_t WS_DG = 1 * MiB + 128 * 1024;
constexpr size_t WS_ROPE = 2 * MiB;
constexpr size_t WS_SSQ = 4 * MiB;
constexpr size_t WS_SSKV = 5 * MiB;
constexpr size_t WS_SSY = 6 * MiB;
constexpr size_t WS_SSY2 = 7 * MiB;
constexpr size_t WS_WIN = 8 * MiB;
constexpr size_t WS_QN = 8 * MiB;
constexpr size_t WS_QR = 40 * MiB;
constexpr size_t WS_WOHG = 61 * MiB;
constexpr size_t WS_WUQ = 69 * MiB;
constexpr size_t WS_WUKV = 72 * MiB;
constexpr size_t WS_WOMLA = 76 * MiB;
constexpr size_t WS_WOUT = 84 * MiB;
constexpr size_t WS_WGU = 92 * MiB;
constexpr size_t WS_WDN = 136 * MiB;
constexpr size_t WS_QH = 158 * MiB;
constexpr size_t WS_G16 = 190 * MiB;
constexpr size_t WS_V = 222 * MiB;
constexpr size_t WS_OG = 254 * MiB;
constexpr size_t WS_SA = 286 * MiB;
constexpr size_t WS_SB = 318 * MiB;
constexpr size_t WS_CQ = 350 * MiB;
constexpr size_t WS_CKV = 358 * MiB;
constexpr size_t WS_KR = 366 * MiB;
constexpr size_t WS_H = 368 * MiB;
constexpr size_t WS_KN = 368 * MiB;
constexpr size_t WS_U = 400 * MiB;
constexpr size_t WS_YAS = 158 * MiB;
constexpr size_t WS_MERGED = 222 * MiB;
constexpr size_t WS_Y = 254 * MiB;
constexpr size_t WS_ACT = 158 * MiB;
constexpr size_t WS_Y2 = 254 * MiB;
constexpr size_t WS_SCR2 = 318 * MiB;
constexpr size_t WS_END = 416 * MiB;

__device__ __forceinline__ float bf2f(bf16_t v) { return __uint_as_float((unsigned)v << 16); }
__device__ __forceinline__ bf16_t f2bf(float f) { unsigned u = __float_as_uint(f); return (bf16_t)((u + 0x7fffu + ((u >> 16) & 1u)) >> 16); }
__device__ __forceinline__ float h2f(f16_t v) { return __half2float(__ushort_as_half(v)); }
__device__ __forceinline__ f16_t f2h(float f) { return __half_as_ushort(__float2half_rn(f)); }
__device__ __forceinline__ float sigmoidf_(float x) { return 1.f / (1.f + __expf(-x)); }
__device__ __forceinline__ float siluf_(float x) { return x / (1.f + __expf(-x)); }

__host__ __device__ inline int src_in(int n) {
    if (n < 8192) return n;
    if (n < 10240) return n - 8192 + 9280;
    if (n < 12288) return n - 10240 + 11328;
    if (n < 12800) return n - 12288 + 8192;
    if (n < 13312) return n - 12800 + 8704;
    if (n < 13376) { const int i = n - 13312; return 9216 + 32 * (i & 1) + (i >> 1); }
    return -1;
}
__host__ __device__ inline int src_uq(int n) {
    if (n < 2048) return (n >> 7) * 192 + (n & 127);
    const int m = n - 2048, h = m >> 6, i = m & 63; return h * 192 + 128 + 32 * (i & 1) + (i >> 1);
}
__host__ __device__ inline int src_gu(int n) { const int t = n >> 8, r = n & 255; return r < 128 ? 128 * t + r : 5632 + 128 * t + (r - 128); }
__host__ __device__ inline int src_id(int n) { return n; }

namespace pg8 {
#define PG8_LAS __attribute__((address_space(3)))
typedef unsigned short bf16_t;
typedef short bf16x8 __attribute__((ext_vector_type(8)));
typedef float f32x4 __attribute__((ext_vector_type(4)));
typedef unsigned u32x4 __attribute__((ext_vector_type(4)));
constexpr int BM = 256, BK = 64, HALF = 128, HTB = HALF * BK * 2  , STAGE_BYTES = 8 * HTB, NXCD = 8, WGM = 8;

__host__ __device__ __forceinline__ int lds_byte(int r, int c) { const int st = (r >> 4) * 2 + (c >> 5), rr = r & 15, cc = c & 31, ob = rr * 64 + cc * 2; return st * 1024 + (ob ^ (((ob >> 9) & 1) << 5)); }
__host__ __device__ __forceinline__ void stage_rc(int b, int& R, int& C) { const int st = b / 1024, sb = b % 1024, swz = sb ^ (((sb >> 9) & 1) << 5); R = (st >> 1) * 16 + swz / 64; C = (st & 1) * 32 + (swz % 64) / 2; }
__host__ __device__ __forceinline__ int perm32(int rho) { const int n = rho >> 4, i = rho & 15; return 8 * (i >> 2) + 4 * n + (i & 3); }

struct Unit { int pm, pn; };
struct Gemm { const bf16_t* A; const bf16_t* Bt; int M, N, K; };

struct StaticOrder {
    int nM, nN, nwg, G, c;
    __host__ __device__ void init(int M, int N, int G_, int c_) { nM = M / BM; nN = N / BM; nwg = nM * nN; G = G_; c = c_; }
    __host__ __device__ bool next(int i, Unit& u) const {
        const long L = (long)i * G + c; if (L >= nwg) return false;
        int wgid = (int)L; { const int q = nwg / NXCD, r = nwg % NXCD, xcd = wgid % NXCD, off = wgid / NXCD; wgid = (xcd < r ? xcd * (q + 1) : r * (q + 1) + (xcd - r) * q) + off; }
        const int nig = WGM * nN, gid = wgid / nig, fm = gid * WGM, gsz = (nM - fm) < WGM ? (nM - fm) : WGM;
        u.pm = fm + ((wgid % nig) % gsz); u.pn = (wgid % nig) / gsz; return true;
    }
    __device__ __forceinline__ void a_ready(const Unit&) const {}
    __device__ __forceinline__ void done(const Unit&) const {}
};

__device__ __forceinline__ unsigned cvt_pk_bf16(float lo, float hi) { unsigned r; asm volatile("v_cvt_pk_bf16_f32 %0, %1, %2" : "=v"(r) : "v"(lo), "v"(hi)); return r; }
__device__ __forceinline__ float sigm(float x) { return __builtin_amdgcn_rcpf(1.f + __expf(-x)); }
__device__ __forceinline__ unsigned cvt_pk_f16(float lo, float hi) { typedef _Float16 h2v __attribute__((ext_vector_type(2))); h2v v = {(_Float16)lo, (_Float16)hi}; return __builtin_bit_cast(unsigned, v); }
__device__ __forceinline__ u32x4 pack_bf16x8(f32x4 a, f32x4 b) { u32x4 w; w.x = cvt_pk_bf16(a[0], a[1]); w.y = cvt_pk_bf16(a[2], a[3]); w.z = cvt_pk_bf16(b[0], b[1]); w.w = cvt_pk_bf16(b[2], b[3]); return w; }
__device__ __forceinline__ void unpack_bf16x8(u32x4 w, f32x4& a, f32x4& b) {
    a[0] = __uint_as_float(w.x << 16); a[1] = __uint_as_float(w.x & 0xffff0000u); a[2] = __uint_as_float(w.y << 16); a[3] = __uint_as_float(w.y & 0xffff0000u);
    b[0] = __uint_as_float(w.z << 16); b[1] = __uint_as_float(w.z & 0xffff0000u); b[2] = __uint_as_float(w.w << 16); b[3] = __uint_as_float(w.w & 0xffff0000u); }
__device__ __forceinline__ float sumsq8(f32x4 a, f32x4 b) { return ((a[0] * a[0] + a[1] * a[1]) + (a[2] * a[2] + a[3] * a[3])) + ((b[0] * b[0] + b[1] * b[1]) + (b[2] * b[2] + b[3] * b[3])); }

struct EpiIn {
    static constexpr bool PERM = true, AFTER_DRAIN = false;
    unsigned short *qh, *g16, *v, *og, *sa, *sb, *cq, *ckv, *kr; const float *lb, *rope; float *ssq, *sskv;
    template <int MODE> __device__ __forceinline__ void seg(const f32x4 (&acc)[2][2][4][2], unsigned short* base, int row0, int colb) const {
        f32x4 l0[2], l1[2];
        if (MODE == 3) {
#pragma unroll
            for (int bj = 0; bj < 2; ++bj) { l0[bj] = *(const f32x4*)(lb + colb + bj * HALF); l1[bj] = *(const f32x4*)(lb + colb + bj * HALF + 4); } }
#pragma unroll
        for (int ai = 0; ai < 2; ++ai)
#pragma unroll
            for (int m = 0; m < 4; ++m) { unsigned short* rowp = base + (size_t)(row0 + ai * HALF + m * 16) * 2048 + colb;
#pragma unroll
                for (int bj = 0; bj < 2; ++bj) { f32x4 a = acc[ai][bj][m][0], b = acc[ai][bj][m][1]; u32x4 w;
                    if (MODE == 1) {
#pragma unroll
                        for (int e = 0; e < 4; ++e) { a[e] = a[e] * sigm(a[e]); b[e] = b[e] * sigm(b[e]); } }
                    if (MODE == 2) {
#pragma unroll
                        for (int e = 0; e < 4; ++e) { a[e] = sigm(a[e]); b[e] = sigm(b[e]); } }
                    if (MODE == 3) {
#pragma unroll
                        for (int e = 0; e < 4; ++e) { a[e] = __logf(l0[bj][e] + (1.f - l0[bj][e]) * sigm(a[e])); b[e] = __logf(l1[bj][e] + (1.f - l1[bj][e]) * sigm(b[e])); }
                        w.x = cvt_pk_f16(a[0], a[1]); w.y = cvt_pk_f16(a[2], a[3]); w.z = cvt_pk_f16(b[0], b[1]); w.w = cvt_pk_f16(b[2], b[3]); }
                    else w = pack_bf16x8(a, b);
                    *(u32x4*)(rowp + bj * HALF) = w; } }
    }
    __device__ __forceinline__ void operator()(const f32x4 (&acc)[2][2][4][2], const Unit& u, int wr, int wc, int fr, int fq) const {
        const int row0 = u.pm * BM + wr * 64 + fr, pn = u.pn, cw = wc * 32 + 8 * fq;
        if (pn < 48) { const int sg = pn >> 3, colb = (pn & 7) * 256 + cw;
            if (sg == 0) seg<1>(acc, qh, row0, colb); else if (sg == 1) seg<3>(acc, g16, row0, colb); else if (sg == 2) seg<0>(acc, v, row0, colb);
            else if (sg == 3) seg<1>(acc, og, row0, colb); else if (sg == 4) seg<2>(acc, sa, row0, colb); else seg<2>(acc, sb, row0, colb); }
        else if (pn < 52) { unsigned short* base = pn < 50 ? cq : ckv; float* ss = pn < 50 ? ssq : sskv; const int colb = (pn & 1) * 256 + cw, slot = (pn & 1) * 4 + wc;
#pragma unroll
            for (int ai = 0; ai < 2; ++ai)
#pragma unroll
                for (int m = 0; m < 4; ++m) { const int row = row0 + ai * HALF + m * 16; unsigned short* rowp = base + (size_t)row * 512 + colb; float s = 0.f;
#pragma unroll
                    for (int bj = 0; bj < 2; ++bj) { const f32x4 a = acc[ai][bj][m][0], b = acc[ai][bj][m][1]; s += sumsq8(a, b); *(u32x4*)(rowp + bj * HALF) = pack_bf16x8(a, b); }
                    s += __shfl_xor(s, 16); s += __shfl_xor(s, 32);
                    if (fq == 0) ss[(size_t)row * 8 + slot] = s; } }
        else if (wc < 2) {
#pragma unroll
            for (int ai = 0; ai < 2; ++ai)
#pragma unroll
                for (int m = 0; m < 4; ++m) { const int row = row0 + ai * HALF + m * 16; const float* rp = rope + ((size_t)row * 32 + 16 * wc + 4 * fq) * 2;
                    const f32x4 c0 = *(const f32x4*)rp, c1 = *(const f32x4*)(rp + 4); const f32x4 a = acc[ai][0][m][0], b = acc[ai][0][m][1]; f32x4 oa, ob;
                    oa[0] = a[0] * c0[0] - a[1] * c0[1]; oa[1] = a[1] * c0[0] + a[0] * c0[1]; oa[2] = a[2] * c0[2] - a[3] * c0[3]; oa[3] = a[3] * c0[2] + a[2] * c0[3];
                    ob[0] = b[0] * c1[0] - b[1] * c1[1]; ob[1] = b[1] * c1[0] + b[0] * c1[1]; ob[2] = b[2] * c1[2] - b[3] * c1[3]; ob[3] = b[3] * c1[2] + b[2] * c1[3];
                    *(u32x4*)(kr + (size_t)row * 64 + cw) = pack_bf16x8(oa, ob); } }
    }
};
struct EpiUq {
    static constexpr bool PERM = true, AFTER_DRAIN = false;
    unsigned short *qn, *qr; const float *ssq, *rope; float qscale, eps;
    __device__ __forceinline__ void operator()(const f32x4 (&acc)[2][2][4][2], const Unit& u, int wr, int wc, int fr, int fq) const {
        const int row0 = u.pm * BM + wr * 64 + fr, pn = u.pn, cw = wc * 32 + 8 * fq;
#pragma unroll
        for (int ai = 0; ai < 2; ++ai)
#pragma unroll
            for (int m = 0; m < 4; ++m) { const int row = row0 + ai * HALF + m * 16;
                const f32x4 p0 = *(const f32x4*)(ssq + (size_t)row * 8), p1 = *(const f32x4*)(ssq + (size_t)row * 8 + 4);
                const float rs = __builtin_amdgcn_rsqf((((p0[0] + p0[1]) + (p0[2] + p0[3])) + ((p1[0] + p1[1]) + (p1[2] + p1[3]))) * (1.f / 512.f) + eps) * qscale;
                if (pn < 8) { unsigned short* rowp = qn + (size_t)row * 2048 + pn * 256 + cw;
#pragma unroll
                    for (int bj = 0; bj < 2; ++bj) *(u32x4*)(rowp + bj * HALF) = pack_bf16x8(acc[ai][bj][m][0] * rs, acc[ai][bj][m][1] * rs); }
                else { unsigned short* rowp = qr + (size_t)row * 1024 + (pn - 8) * 256 + cw; const float* rp = rope + ((size_t)row * 32 + 16 * (wc & 1) + 4 * fq) * 2;
                    const f32x4 c0 = *(const f32x4*)rp, c1 = *(const f32x4*)(rp + 4);
#pragma unroll
                    for (int bj = 0; bj < 2; ++bj) { const f32x4 a = acc[ai][bj][m][0] * rs, b = acc[ai][bj][m][1] * rs; f32x4 oa, ob;
                        oa[0] = a[0] * c0[0] - a[1] * c0[1]; oa[1] = a[1] * c0[0] + a[0] * c0[1]; oa[2] = a[2] * c0[2] - a[3] * c0[3]; oa[3] = a[3] * c0[2] + a[2] * c0[3];
                        ob[0] = b[0] * c1[0] - b[1] * c1[1]; ob[1] = b[1] * c1[0] + b[0] * c1[1]; ob[2] = b[2] * c1[2] - b[3] * c1[3]; ob[3] = b[3] * c1[2] + b[2] * c1[3];
                        *(u32x4*)(rowp + bj * HALF) = pack_bf16x8(oa, ob); } } }
    }
};
struct EpiUkv {
    static constexpr bool PERM = true, AFTER_DRAIN = false;
    unsigned short *kn, *vm; const float* sskv; float eps;
    __device__ __forceinline__ void operator()(const f32x4 (&acc)[2][2][4][2], const Unit& u, int wr, int wc, int fr, int fq) const {
        const int row0 = u.pm * BM + wr * 64 + fr, colb = u.pn * 128 + wc * 32 + 8 * fq;
#pragma unroll
        for (int ai = 0; ai < 2; ++ai)
#pragma unroll
            for (int m = 0; m < 4; ++m) { const int row = row0 + ai * HALF + m * 16;
                const f32x4 p0 = *(const f32x4*)(sskv + (size_t)row * 8), p1 = *(const f32x4*)(sskv + (size_t)row * 8 + 4);
                const float rs = __builtin_amdgcn_rsqf((((p0[0] + p0[1]) + (p0[2] + p0[3])) + ((p1[0] + p1[1]) + (p1[2] + p1[3]))) * (1.f / 512.f) + eps);
                *(u32x4*)(kn + (size_t)row * 2048 + colb) = pack_bf16x8(acc[ai][0][m][0] * rs, acc[ai][0][m][1] * rs);
                *(u32x4*)(vm + (size_t)row * 2048 + colb) = pack_bf16x8(acc[ai][1][m][0] * rs, acc[ai][1][m][1] * rs); }
    }
};
struct EpiYa {
    static constexpr bool PERM = true, AFTER_DRAIN = false;
    float* yas; const unsigned short* sa;
    __device__ __forceinline__ void operator()(const f32x4 (&acc)[2][2][4][2], const Unit& u, int wr, int wc, int fr, int fq) const {
        const int row0 = u.pm * BM + wr * 64 + fr, colb = u.pn * 256 + wc * 32 + 8 * fq;
#pragma unroll
        for (int ai = 0; ai < 2; ++ai)
#pragma unroll
            for (int m = 0; m < 4; ++m) { const size_t off = (size_t)(row0 + ai * HALF + m * 16) * 2048 + colb;
#pragma unroll
                for (int bj = 0; bj < 2; ++bj) { f32x4 ga, gb; unpack_bf16x8(*(const u32x4*)(sa + off + bj * HALF), ga, gb);
                    *(f32x4*)(yas + off + bj * HALF) = acc[ai][bj][m][0] * ga; *(f32x4*)(yas + off + bj * HALF + 4) = acc[ai][bj][m][1] * gb; } }
    }
};
struct EpiYb {
    static constexpr bool PERM = true, AFTER_DRAIN = false;
    const float* yas; const unsigned short* sb; unsigned short* merged;
    __device__ __forceinline__ void operator()(const f32x4 (&acc)[2][2][4][2], const Unit& u, int wr, int wc, int fr, int fq) const {
        const int row0 = u.pm * BM + wr * 64 + fr, colb = u.pn * 256 + wc * 32 + 8 * fq;
#pragma unroll
        for (int ai = 0; ai < 2; ++ai)
#pragma unroll
            for (int m = 0; m < 4; ++m) { const size_t off = (size_t)(row0 + ai * HALF + m * 16) * 2048 + colb;
#pragma unroll
                for (int bj = 0; bj < 2; ++bj) { f32x4 ga, gb; unpack_bf16x8(*(const u32x4*)(sb + off + bj * HALF), ga, gb);
                    const f32x4 y0 = *(const f32x4*)(yas + off + bj * HALF), y1 = *(const f32x4*)(yas + off + bj * HALF + 4);
                    *(u32x4*)(merged + off + bj * HALF) = pack_bf16x8(y0 + acc[ai][bj][m][0] * ga, y1 + acc[ai][bj][m][1] * gb); } }
    }
};
struct EpiF32SS {
    static constexpr bool PERM = true, AFTER_DRAIN = false;
    float* y; float* ss;
    __device__ __forceinline__ void operator()(const f32x4 (&acc)[2][2][4][2], const Unit& u, int wr, int wc, int fr, int fq) const {
        const int row0 = u.pm * BM + wr * 64 + fr, colb = u.pn * 256 + wc * 32 + 8 * fq, slot = u.pn * 4 + wc;
#pragma unroll
        for (int ai = 0; ai < 2; ++ai)
#pragma unroll
            for (int m = 0; m < 4; ++m) { const int row = row0 + ai * HALF + m * 16; const size_t off = (size_t)row * 2048 + colb; float s = 0.f;
#pragma unroll
                for (int bj = 0; bj < 2; ++bj) { const f32x4 a = acc[ai][bj][m][0], b = acc[ai][bj][m][1]; s += sumsq8(a, b);
                    *(f32x4*)(y + off + bj * HALF) = a; *(f32x4*)(y + off + bj * HALF + 4) = b; }
                s += __shfl_xor(s, 16); s += __shfl_xor(s, 32);
                if (fq == 0) ss[(size_t)row * 32 + slot] = s; }
    }
};
struct EpiGu {
    static constexpr bool PERM = true, AFTER_DRAIN = false;
    unsigned short* act; int ldc;
    __device__ __forceinline__ void operator()(const f32x4 (&acc)[2][2][4][2], const Unit& u, int wr, int wc, int fr, int fq) const {
        const int row0 = u.pm * BM + wr * 64 + fr, colb = u.pn * 128 + wc * 32 + 8 * fq;
#pragma unroll
        for (int ai = 0; ai < 2; ++ai)
#pragma unroll
            for (int m = 0; m < 4; ++m) { f32x4 a = acc[ai][0][m][0], b = acc[ai][0][m][1];
#pragma unroll
                for (int e = 0; e < 4; ++e) { a[e] = a[e] * sigm(a[e]) * acc[ai][1][m][0][e]; b[e] = b[e] * sigm(b[e]) * acc[ai][1][m][1][e]; }
                *(u32x4*)(act + (size_t)(row0 + ai * HALF + m * 16) * ldc + colb) = pack_bf16x8(a, b); }
    }
};
template <class Epi, class Sched, bool ALIGN_EPI = false, bool SP2 = false>
__device__ __forceinline__ void gemm_phase(PG8_LAS unsigned char* lds, const Gemm g, const Sched& S, const Epi& E) {
    const int tid = threadIdx.x, wid = __builtin_amdgcn_readfirstlane(tid >> 6), lane = tid & 63, wr = wid >> 2, wc = wid & 3, fr = lane & 15, fq = lane >> 4;
    const int K = g.K, nt = K / BK;
    unsigned voffA[2], voffB[2];
#pragma unroll
    for (int i = 0; i < 2; ++i) { int R, C; stage_rc(tid * 16 + i * 8192, R, C); const int Rb = Epi::PERM ? ((R & ~31) + perm32(R & 31)) : R;
        voffA[i] = (unsigned)(R * K + C) * 2u; voffB[i] = (unsigned)(Rb * K + C) * 2u; }
    const size_t kstep = (size_t)(BK * 2);
    const size_t hstep = (size_t)HALF * K * 2;
    const size_t tstep = 2 * hstep;
    const unsigned ldsw = (unsigned)wid * 1024u;
    const int aoff = lds_byte(wr * 64 + fr, fq * 8), boff = lds_byte(wc * 32 + fr, fq * 8);
#define PG8_SA(b, h) (((b) * 2 + (h)) * HTB)
#define PG8_SB(b, h) ((4 + (b) * 2 + (h)) * HTB)
#define PG8_STAGE(bufoff, gbase, voff) do { _Pragma("unroll") for (int _i = 0; _i < 2; ++_i) \
        __builtin_amdgcn_global_load_lds((const unsigned*)((const char*)(gbase) + (voff)[_i]), (PG8_LAS unsigned*)(lds + (bufoff) + ldsw + _i * 8192), 16, 0, 0); } while (0)
#define PG8_LDA(dst, b, h) do { _Pragma("unroll") for (int m = 0; m < 4; ++m) _Pragma("unroll") for (int k = 0; k < 2; ++k) dst[m][k] = *(const PG8_LAS bf16x8*)(lds + PG8_SA(b, h) + aoff + m * 2048 + k * 1024); } while (0)
#define PG8_LDB(dst, b, h) do { _Pragma("unroll") for (int n = 0; n < 2; ++n) _Pragma("unroll") for (int k = 0; k < 2; ++k) dst[n][k] = *(const PG8_LAS bf16x8*)(lds + PG8_SB(b, h) + boff + n * 2048 + k * 1024); } while (0)
#define PG8_MMA(ai, bj, At, Bt) do { __builtin_amdgcn_s_setprio(1); _Pragma("unroll") for (int m = 0; m < 4; ++m) _Pragma("unroll") for (int n = 0; n < 2; ++n) _Pragma("unroll") for (int k = 0; k < 2; ++k) \
        acc[ai][bj][m][n] = __builtin_amdgcn_mfma_f32_16x16x32_bf16(Bt[n][k], At[m][k], acc[ai][bj][m][n], 0, 0, 0); __builtin_amdgcn_s_setprio(0); } while (0)
#define PG8_WAIT_V(n) asm volatile("s_waitcnt vmcnt(" #n ")" ::: "memory")
#define PG8_WAIT_L(n) asm volatile("s_waitcnt lgkmcnt(" #n ")" ::: "memory")
#define PG8_BAR __builtin_amdgcn_s_barrier()
#define PG8_SCHED __builtin_amdgcn_sched_barrier(0)
    Unit cur, nxt; int ui = 0;
    if (!S.next(0, cur)) return;
    f32x4 acc[2][2][4][2];
#pragma unroll
    for (int a = 0; a < 2; ++a)
#pragma unroll
        for (int b = 0; b < 2; ++b)
#pragma unroll
            for (int m = 0; m < 4; ++m)
#pragma unroll
                for (int n = 0; n < 2; ++n) acc[a][b][m][n] = (f32x4){0.f, 0.f, 0.f, 0.f};
    bf16x8 At[4][2], B0[2][2], B1[2][2];
    const char* cA = (const char*)g.A + (size_t)cur.pm * tstep; const char* cB = (const char*)g.Bt + (size_t)cur.pn * tstep;
    S.a_ready(cur);
    if constexpr (SP2) {
        PG8_STAGE(PG8_SB(0, 0), cB, voffB); PG8_STAGE(PG8_SB(0, 1), cB + hstep, voffB); PG8_STAGE(PG8_SA(0, 0), cA, voffA); PG8_STAGE(PG8_SA(0, 1), cA + hstep, voffA);
        if (wr == 1) PG8_BAR;
        PG8_WAIT_V(2); PG8_BAR;
        PG8_STAGE(PG8_SB(1, 0), cB + kstep, voffB); PG8_STAGE(PG8_SA(1, 0), cA + kstep, voffA); PG8_STAGE(PG8_SB(1, 1), cB + hstep + kstep, voffB);
        PG8_WAIT_V(6); PG8_BAR;
    } else {
        PG8_STAGE(PG8_SB(0, 0), cB, voffB); PG8_STAGE(PG8_SA(0, 0), cA, voffA); PG8_STAGE(PG8_SB(0, 1), cB + hstep, voffB); PG8_STAGE(PG8_SA(0, 1), cA + hstep, voffA);
        if (wr == 1) PG8_BAR;
        PG8_WAIT_V(4); PG8_BAR;
        PG8_STAGE(PG8_SB(1, 0), cB + kstep, voffB); PG8_STAGE(PG8_SA(1, 0), cA + kstep, voffA); PG8_STAGE(PG8_SB(1, 1), cB + hstep + kstep, voffB);
        PG8_WAIT_V(6); PG8_BAR;
    }
    for (;;) {
        const bool has_next = S.next(ui + 1, nxt);
        const char* nA = has_next ? (const char*)g.A + (size_t)nxt.pm * tstep : cA; const char* nB = has_next ? (const char*)g.Bt + (size_t)nxt.pn * tstep : cB;
        for (int t = 0; t < nt; t += 2) {
            const bool last = (t == nt - 2);
            const char* a1 = cA + (size_t)(t + 1) * kstep;
            const char* a2 = last ? nA : cA + (size_t)(t + 2) * kstep; const char* b2 = last ? nB : cB + (size_t)(t + 2) * kstep;
            const char* a3 = a2 + kstep; const char* b3 = b2 + kstep;
            if (last && has_next) S.a_ready(nxt);
            if constexpr (SP2) {
            PG8_LDB(B0, 0, 0); PG8_LDB(B1, 0, 1); PG8_SCHED; PG8_LDA(At, 0, 0); PG8_STAGE(PG8_SA(1, 1), a1 + hstep, voffA);
            PG8_WAIT_V(8); PG8_WAIT_L(0); PG8_BAR; PG8_MMA(0, 0, At, B0); PG8_MMA(0, 1, At, B1); PG8_BAR; PG8_SCHED;
            PG8_LDA(At, 0, 1); PG8_STAGE(PG8_SB(0, 0), b2, voffB); PG8_STAGE(PG8_SB(0, 1), b2 + hstep, voffB); PG8_STAGE(PG8_SA(0, 0), a2, voffA);
            PG8_WAIT_V(8); PG8_WAIT_L(0); PG8_BAR; PG8_MMA(1, 0, At, B0); PG8_MMA(1, 1, At, B1); PG8_BAR; PG8_SCHED;
            PG8_LDB(B0, 1, 0); PG8_LDB(B1, 1, 1); PG8_SCHED; PG8_LDA(At, 1, 0); PG8_STAGE(PG8_SA(0, 1), a2 + hstep, voffA);
            PG8_WAIT_V(8); PG8_WAIT_L(0); PG8_BAR; PG8_MMA(0, 0, At, B0); PG8_MMA(0, 1, At, B1); PG8_BAR; PG8_SCHED;
            PG8_LDA(At, 1, 1); PG8_STAGE(PG8_SB(1, 0), b3, voffB); PG8_STAGE(PG8_SB(1, 1), b3 + hstep, voffB); PG8_STAGE(PG8_SA(1, 0), a3, voffA);
            PG8_WAIT_V(8); PG8_WAIT_L(0); PG8_BAR; PG8_MMA(1, 0, At, B0); PG8_MMA(1, 1, At, B1); PG8_BAR; PG8_SCHED;
            } else {
            PG8_LDB(B0, 0, 0); PG8_SCHED; PG8_LDA(At, 0, 0); PG8_STAGE(PG8_SA(1, 1), a1 + hstep, voffA);
            PG8_WAIT_L(8); PG8_BAR; PG8_WAIT_L(0); PG8_MMA(0, 0, At, B0); PG8_BAR; PG8_SCHED;
            PG8_LDB(B1, 0, 1); PG8_STAGE(PG8_SB(0, 0), b2, voffB);
            PG8_BAR; PG8_WAIT_L(0); PG8_MMA(0, 1, At, B1); PG8_BAR;
            PG8_LDA(At, 0, 1); PG8_STAGE(PG8_SA(0, 0), a2, voffA);
            PG8_BAR; PG8_WAIT_L(0); PG8_MMA(1, 0, At, B0); PG8_BAR; PG8_SCHED;
            PG8_STAGE(PG8_SB(0, 1), b2 + hstep, voffB);
            PG8_WAIT_V(6); PG8_BAR; PG8_MMA(1, 1, At, B1); PG8_BAR;
            PG8_LDB(B0, 1, 0); PG8_SCHED; PG8_LDA(At, 1, 0); PG8_STAGE(PG8_SA(0, 1), a2 + hstep, voffA);
            PG8_WAIT_L(8); PG8_BAR; PG8_WAIT_L(0); PG8_MMA(0, 0, At, B0); PG8_BAR; PG8_SCHED;
            PG8_LDB(B1, 1, 1); PG8_STAGE(PG8_SB(1, 0), b3, voffB);
            PG8_BAR; PG8_WAIT_L(0); PG8_MMA(0, 1, At, B1); PG8_BAR;
            PG8_LDA(At, 1, 1); PG8_STAGE(PG8_SA(1, 0), a3, voffA);
            PG8_BAR; PG8_WAIT_L(0); PG8_MMA(1, 0, At, B0); PG8_BAR; PG8_SCHED;
            PG8_STAGE(PG8_SB(1, 1), b3 + hstep, voffB);
            PG8_WAIT_V(6); PG8_BAR; PG8_MMA(1, 1, At, B1); PG8_BAR;
            }
        }
        if constexpr (ALIGN_EPI) { if (wr == 0) PG8_BAR; }
        if constexpr (!Epi::AFTER_DRAIN) { E(acc, cur, wr, wc, fr, fq); S.done(cur); }
        if (!has_next) break;
#pragma unroll
        for (int a = 0; a < 2; ++a)
#pragma unroll
            for (int b = 0; b < 2; ++b)
#pragma unroll
                for (int m = 0; m < 4; ++m)
#pragma unroll
                    for (int n = 0; n < 2; ++n) acc[a][b][m][n] = (f32x4){0.f, 0.f, 0.f, 0.f};
        cur = nxt; cA = nA; cB = nB; ++ui;
        if constexpr (ALIGN_EPI) { if (wr == 1) PG8_BAR; }
    }
    PG8_WAIT_V(0);
    if constexpr (!ALIGN_EPI) { if (wr == 0) PG8_BAR; }
    PG8_BAR;
    if constexpr (Epi::AFTER_DRAIN) { E.fused(acc, cur, wr, wc, fr, fq, lds, wid, lane); S.done(cur); }
#undef PG8_SA
#undef PG8_SB
#undef PG8_STAGE
#undef PG8_LDA
#undef PG8_LDB
#undef PG8_MMA
#undef PG8_WAIT_V
#undef PG8_WAIT_L
#undef PG8_BAR
#undef PG8_SCHED
}
}
namespace att {
typedef short bf16x8 __attribute__((ext_vector_type(8)));
typedef short s16x4 __attribute__((ext_vector_type(4)));
typedef float f32x16 __attribute__((ext_vector_type(16)));
typedef unsigned u32x4 __attribute__((ext_vector_type(4)));
constexpr int NW = 8, QBLK = 32, KVBLK = 64, QB = NW * QBLK;
constexpr int SHM_V = KVBLK * 128 * 2, SHM_K = KVBLK * 128 * 2, SHM_R = KVBLK * 64 * 2;
constexpr int OFF_V = 0, OFF_K = 2 * SHM_V, OFF_R = OFF_K + 2 * SHM_K, OFF_WS = OFF_R + 2 * SHM_R, OFF_QR = OFF_WS + NW * 64 * 4, LDS_BYTES = OFF_QR + NW * 4096;
constexpr float THR2 = 11.5f;
constexpr int LDQ = 2048, LDR = 1024, LDK = 2048, LDKR = 64;
#define LAS3 __attribute__((address_space(3)))
#define KSWZ(row, colB) ((row) * 256 + ((colB) ^ (((row) & 7) << 4)))
#define SBAR() __builtin_amdgcn_sched_barrier(0)
__device__ __forceinline__ int v_st(int k, int c) { const int kk = (k & ~0xC) | ((k & 4) << 1) | ((k & 8) >> 1); return ((kk >> 3) * 4 + (c >> 5)) * 512 + ((kk & 7) * 32 + (c & 31)) * 2; }
__device__ __forceinline__ int v_rd_base(int lane) { return ((lane & 3) << 3) | (((lane >> 2) & 3) << 6) | (((lane >> 4) & 1) << 5) | (((lane >> 5) & 1) << 8); }
constexpr int v_rd_off(int d0, int ks, int half) { return d0 * 512 + ks * 4096 + half * 2048; }
__device__ __forceinline__ int crow(int r, int hi) { return (r & 3) + 8 * (r >> 2) + 4 * hi; }
__device__ __forceinline__ unsigned cvtpk(float lo, float hi) { unsigned r; asm volatile("v_cvt_pk_bf16_f32 %0, %1, %2" : "=v"(r) : "v"(lo), "v"(hi)); return r; }
__device__ __forceinline__ bf16x8 ld8(const bf16_t* p) { return *reinterpret_cast<const bf16x8*>(p); }
__device__ __forceinline__ void mask_tile(f32x16& p0, f32x16& p1, int dq) {
    const float NEG = -__builtin_inff();
#pragma unroll
    for (int r = 0; r < 16; ++r) { const int c = (r & 3) + 8 * (r >> 2); if (dq - c < 0) p0[r] = NEG; if (dq - c - 32 < 0) p1[r] = NEG; }
}
__device__ __forceinline__ void partialSM(f32x16& p0, f32x16& p1, float& m_reg, float& mn, float& alpha) {
    float pmax = p0[0]; for (int r = 1; r < 16; ++r) pmax = fmaxf(pmax, p0[r]); for (int r = 0; r < 16; ++r) pmax = fmaxf(pmax, p1[r]);
    { auto rr = __builtin_amdgcn_permlane32_swap(__float_as_uint(pmax), __float_as_uint(pmax), false, false); pmax = fmaxf(__uint_as_float(rr[0]), __uint_as_float(rr[1])); }
    if (__builtin_expect(__all((pmax - m_reg) <= THR2), 1)) { mn = m_reg; alpha = 1.f; }
    else { mn = fmaxf(m_reg, pmax); alpha = __builtin_amdgcn_exp2f(m_reg - mn); m_reg = mn; }
    for (int r = 0; r < 16; ++r) p0[r] = p0[r] - mn; for (int r = 0; r < 16; ++r) p1[r] = p1[r] - mn;
    for (int r = 0; r < 16; ++r) p0[r] = __builtin_amdgcn_exp2f(p0[r]);
}
__device__ __forceinline__ void finishSM(f32x16& p0, f32x16& p1, float alpha, float& l_reg, bf16x8& pa0, bf16x8& pa1, bf16x8& pa2, bf16x8& pa3) {
    for (int r = 0; r < 16; ++r) p1[r] = __builtin_amdgcn_exp2f(p1[r]);
    float ps = 0; for (int r = 0; r < 16; ++r) ps += p0[r]; for (int r = 0; r < 16; ++r) ps += p1[r];
    { auto rr = __builtin_amdgcn_permlane32_swap(__float_as_uint(ps), __float_as_uint(ps), false, false); ps = __uint_as_float(rr[0]) + __uint_as_float(rr[1]); }
    l_reg = l_reg * alpha + ps;
#define PK4(P, B_, OUT) do { unsigned a0 = cvtpk(P[B_+0], P[B_+1]), a1 = cvtpk(P[B_+2], P[B_+3]); unsigned b0 = cvtpk(P[B_+4], P[B_+5]), b1 = cvtpk(P[B_+6], P[B_+7]); \
        auto r0 = __builtin_amdgcn_permlane32_swap(a0, b0, false, false); auto r1 = __builtin_amdgcn_permlane32_swap(a1, b1, false, false); \
        u32x4 w = {r0[0], r1[0], r0[1], r1[1]}; OUT = *reinterpret_cast<bf16x8*>(&w); } while (0)
    PK4(p0, 0, pa0); PK4(p0, 8, pa1); PK4(p1, 0, pa2); PK4(p1, 8, pa3);
#undef PK4
}
template <int KB> __device__ __forceinline__ void qkt(f32x16& p0, f32x16& p1, const char* lds, int r32, int hi, const bf16x8* qr, const char* qrl) {
    p0 = f32x16{}; p1 = f32x16{};
    const char* kb[4];
#pragma unroll
    for (int dd = 0; dd < 4; ++dd) kb[dd] = lds + OFF_K + KB * SHM_K + KSWZ(r32, (dd * 16 + hi * 8) * 2);
#pragma unroll
    for (int d0 = 0; d0 < 8; ++d0) { const char* a = kb[d0 & 3] + (d0 >> 2) * 128;
        bf16x8 b0 = *reinterpret_cast<const bf16x8*>(a); bf16x8 b1 = *reinterpret_cast<const bf16x8*>(a + 32 * 256);
        p0 = __builtin_amdgcn_mfma_f32_32x32x16_bf16(b0, qr[d0], p0, 0, 0, 0); p1 = __builtin_amdgcn_mfma_f32_32x32x16_bf16(b1, qr[d0], p1, 0, 0, 0);
        if (d0 == 3 || d0 == 7) SBAR(); }
#pragma unroll
    for (int d0 = 0; d0 < 4; ++d0) { const char* a = lds + OFF_R + KB * SHM_R + d0 * 2048 + r32 * 32 + hi * 16;
        bf16x8 b0 = *reinterpret_cast<const bf16x8*>(a); bf16x8 b1 = *reinterpret_cast<const bf16x8*>(a + 1024);
        const bf16x8 qf = *reinterpret_cast<const bf16x8*>(qrl + d0 * 1024);
        p0 = __builtin_amdgcn_mfma_f32_32x32x16_bf16(b0, qf, p0, 0, 0, 0); p1 = __builtin_amdgcn_mfma_f32_32x32x16_bf16(b1, qf, p1, 0, 0, 0); }
}
template <int VB> __device__ __forceinline__ void pv_tile(f32x16* o, int vb0, bf16x8 pa0, bf16x8 pa1, bf16x8 pa2, bf16x8 pa3) {
#define TRRD(dst, off) asm volatile("ds_read_b64_tr_b16 %0, %1 offset:%2" : "=&v"(dst) : "v"(vb0), "i"(off) : "memory")
#define PV_D0(d0) do { s16x4 l0, l1, l2, l3, h0, h1, h2, h3; constexpr int b_ = OFF_V + VB * SHM_V + v_rd_off(d0, 0, 0); \
        TRRD(l0, b_); TRRD(h0, b_ + 2048); TRRD(l1, b_ + 4096); TRRD(h1, b_ + 6144); TRRD(l2, b_ + 8192); TRRD(h2, b_ + 10240); TRRD(l3, b_ + 12288); TRRD(h3, b_ + 14336); \
        asm volatile("s_waitcnt lgkmcnt(0)" ::: "memory"); SBAR(); \
        o[d0] = __builtin_amdgcn_mfma_f32_32x32x16_bf16(pa0, (bf16x8){l0[0], l0[1], l0[2], l0[3], h0[0], h0[1], h0[2], h0[3]}, o[d0], 0, 0, 0); \
        o[d0] = __builtin_amdgcn_mfma_f32_32x32x16_bf16(pa1, (bf16x8){l1[0], l1[1], l1[2], l1[3], h1[0], h1[1], h1[2], h1[3]}, o[d0], 0, 0, 0); \
        o[d0] = __builtin_amdgcn_mfma_f32_32x32x16_bf16(pa2, (bf16x8){l2[0], l2[1], l2[2], l2[3], h2[0], h2[1], h2[2], h2[3]}, o[d0], 0, 0, 0); \
        o[d0] = __builtin_amdgcn_mfma_f32_32x32x16_bf16(pa3, (bf16x8){l3[0], l3[1], l3[2], l3[3], h3[0], h3[1], h3[2], h3[3]}, o[d0], 0, 0, 0); } while (0)
    PV_D0(0); PV_D0(1); PV_D0(2); PV_D0(3);
#undef PV_D0
#undef TRRD
}
struct BlockRef { const bf16_t* Qn; const bf16_t* Qr; const bf16_t* K; const bf16_t* V; bf16_t* O; int P0; };
#define DMA16(src, dstoff) __builtin_amdgcn_global_load_lds((const unsigned*)(src), (LAS3 unsigned*)(lds3 + (dstoff)), 16, 0, 0)
#define DMA_K(t, bf) do { const bf16_t* s_ = Kh + (size_t)(t) * (KVBLK * LDK); DMA16(s_ + koff0, OFF_K + (bf) * SHM_K + wid * 2048); DMA16(s_ + koff1, OFF_K + (bf) * SHM_K + wid * 2048 + 1024); } while (0)
#define DMA_V(t, bf) do { const bf16_t* s_ = Vh + (size_t)(t) * (KVBLK * LDK); DMA16(s_ + voff0, OFF_V + (bf) * SHM_V + wid * 2048); DMA16(s_ + voff0 + 64, OFF_V + (bf) * SHM_V + wid * 2048 + 1024); } while (0)
#define DMA_R(t, bf) DMA16(KR + (size_t)(t) * (KVBLK * LDKR) + roff, OFF_R + (bf) * SHM_R + wid * 1024)
#define WAIT_BAR() asm volatile("s_waitcnt vmcnt(0) lgkmcnt(0)\n\ts_barrier" ::: "memory")
__device__ __forceinline__ void block(const BlockRef& cur, const bf16_t* KR, char* lds, LAS3 unsigned char* lds3) {
    const int tid = threadIdx.x, wid = __builtin_amdgcn_readfirstlane(tid >> 6), lane = tid & 63, r32 = lane & 31, hi = lane >> 5;
    const int NT = (cur.P0 + QB) / KVBLK;
    const int qlo = cur.P0 + wid * QBLK, qm = qlo + r32 - 4 * hi;
    float* ws = (float*)(lds + OFF_WS) + wid * 64; float* li_l = ws, * al_l = ws + 32;
    float m_reg = -1e30f, l_reg = 0; f32x16 o[4] = {};
    const int vb0 = (int)(uintptr_t)lds + v_rd_base(lane);
    char* qrl = lds + OFF_QR + wid * 4096 + lane * 16;
    const bf16_t* Kh = cur.K; const bf16_t* Vh = cur.V;
    const int kr0 = lane >> 4, kr1 = 4 + (lane >> 4);
    const int koff0 = (wid * 8 + kr0) * LDK + (((lane & 15) ^ kr0) << 3), koff1 = (wid * 8 + kr1) * LDK + (((lane & 15) ^ kr1) << 3);
    const int vkk = wid * 8 + ((lane & 31) >> 2), vk = (vkk & ~0xC) | ((vkk & 4) << 1) | ((vkk & 8) >> 1);
    const int voff0 = vk * LDK + (lane >> 5) * 32 + (lane & 3) * 8;
    const int roff = ((wid & 1) * 32 + (lane >> 1)) * LDKR + (wid >> 1) * 16 + (lane & 1) * 8;
    bf16x8 qr[8];
#define RESC(a) do { if (__any((a) < 1.f)) { if (hi == 0) al_l[r32] = (a); asm volatile("s_waitcnt lgkmcnt(0)" ::: "memory"); \
                     for (int d_ = 0; d_ < 4; ++d_) for (int r = 0; r < 16; ++r) o[d_][r] *= al_l[crow(r, hi)]; } } while (0)
#define KBASE(t) ((t) * KVBLK)
#define MASKT(P0_, P1_, t) do { const int kb_ = KBASE(t); if (kb_ + KVBLK - 1 > qlo) mask_tile(P0_, P1_, qm - kb_); } while (0)
    f32x16 pA0, pA1, pB0, pB1; float mnA, mnB, alA, alB; bf16x8 pa0, pa1, pa2, pa3;
    DMA_K(0, 0); DMA_R(0, 0);
#pragma unroll
    for (int d0 = 0; d0 < 8; ++d0) qr[d0] = ld8(cur.Qn + (size_t)(wid * QBLK + r32) * LDQ + d0 * 16 + hi * 8);
    { bf16x8 t_[4];
#pragma unroll
      for (int d0 = 0; d0 < 4; ++d0) t_[d0] = ld8(cur.Qr + (size_t)(wid * QBLK + r32) * LDR + d0 * 16 + hi * 8);
#pragma unroll
      for (int d0 = 0; d0 < 4; ++d0) *(bf16x8*)(qrl + d0 * 1024) = t_[d0]; }
    WAIT_BAR();
    DMA_K(1, 1); DMA_R(1, 1); DMA_V(0, 0);
    SBAR(); qkt<0>(pA0, pA1, lds, r32, hi, qr, qrl);
    MASKT(pA0, pA1, 0); partialSM(pA0, pA1, m_reg, mnA, alA);
    WAIT_BAR();
#define STEP(PX0, PX1, mnX, alX, PY0, PY1, alY, t, KB, VB) do { \
        if ((t) + 1 < NT) { DMA_K((t) + 1, VB); DMA_R((t) + 1, VB); } DMA_V((t), KB); \
        SBAR(); qkt<KB>(PX0, PX1, lds, r32, hi, qr, qrl); \
        finishSM(PY0, PY1, alY, l_reg, pa0, pa1, pa2, pa3); SBAR(); \
        pv_tile<VB>(o, vb0, pa0, pa1, pa2, pa3); MASKT(PX0, PX1, (t)); partialSM(PX0, PX1, m_reg, mnX, alX); \
        RESC(alX); WAIT_BAR(); } while (0)
    for (int t = 1; t + 1 < NT; t += 2) {
        STEP(pB0, pB1, mnB, alB, pA0, pA1, alA, t, 1, 0);
        STEP(pA0, pA1, mnA, alA, pB0, pB1, alB, t + 1, 0, 1);
    }
    STEP(pB0, pB1, mnB, alB, pA0, pA1, alA, NT - 1, 1, 0);
    finishSM(pB0, pB1, alB, l_reg, pa0, pa1, pa2, pa3); SBAR(); pv_tile<1>(o, vb0, pa0, pa1, pa2, pa3);
    if (hi == 0) li_l[r32] = l_reg; asm volatile("s_waitcnt lgkmcnt(0)" ::: "memory");
    float rli[16];
#pragma unroll
    for (int r = 0; r < 16; ++r) rli[r] = __builtin_amdgcn_rcpf(li_l[crow(r, hi)]);
    bf16_t* Ow = cur.O + (size_t)(wid * QBLK) * LDQ;
#pragma unroll
    for (int r = 0; r < 16; ++r) { const int orow = crow(r, hi);
#pragma unroll
        for (int d0 = 0; d0 < 4; ++d0) { const float v = o[d0][r] * rli[r]; const float vn = __shfl_xor(v, 1);
            if ((r32 & 1) == 0) *(unsigned*)(Ow + (size_t)orow * LDQ + d0 * 32 + r32) = cvtpk(v, vn); } }
    WAIT_BAR();
#undef RESC
#undef KBASE
#undef MASKT
#undef STEP
}
#undef DMA16
#undef DMA_K
#undef DMA_V
#undef DMA_R
#undef WAIT_BAR
__device__ __forceinline__ BlockRef make_ref(int h, int qb, const bf16_t* qn, const bf16_t* qr, const bf16_t* kn, const bf16_t* vm, bf16_t* ob) {
    BlockRef r; r.Qn = qn + (size_t)qb * QB * LDQ + h * 128; r.Qr = qr + (size_t)qb * QB * LDR + h * 64; r.K = kn + h * 128; r.V = vm + h * 128; r.O = ob + (size_t)qb * QB * LDQ + h * 128; r.P0 = qb * QB; return r;
}
__device__ __forceinline__ void phase(char* lds, LAS3 unsigned char* lds3, const bf16_t* qn, const bf16_t* qr, const bf16_t* kn, const bf16_t* kr, const bf16_t* vm, bf16_t* ob, int vcu, int G) {
    constexpr int NITEMS = H * 16;
    for (int L = vcu; L < NITEMS; L += G) {
        const int h = L >> 4, x = L & 15;
        block(make_ref(h, x, qn, qr, kn, vm, ob), kr, lds, lds3);
        block(make_ref(h, 31 - x, qn, qr, kn, vm, ob), kr, lds, lds3);
    }
}
#undef KSWZ
#undef LAS3
#undef SBAR
}
namespace hg {
typedef short bf16x8 __attribute__((ext_vector_type(8)));
typedef short s16x4 __attribute__((ext_vector_type(4)));
typedef float f32x16 __attribute__((ext_vector_type(16)));
typedef float f32x4 __attribute__((ext_vector_type(4)));
typedef unsigned u32x4 __attribute__((ext_vector_type(4)));
typedef unsigned u32x2 __attribute__((ext_vector_type(2)));
typedef _Float16 f16x8 __attribute__((ext_vector_type(8)));
#define LAS3 __attribute__((address_space(3)))
#define KSWZ(row, colB) ((row) * 256 + ((colB) ^ (((row) & 7) << 4)))
#define SBAR() __builtin_amdgcn_sched_barrier(0)
constexpr int O_QES = 0, O_KES = 16384, O_KET = 32768, O_V = 49152, O_ST = 65536, O_BL = 98304, O_SEG = 131072, O_DL = 133120, O_END = 133632;
constexpr int LD = 2048;
__device__ __forceinline__ int crow(int r, int hi) { return (r & 3) + 8 * (r >> 2) + 4 * hi; }
__device__ __forceinline__ unsigned cvtpk(float lo, float hi) { unsigned r; asm volatile("v_cvt_pk_bf16_f32 %0, %1, %2" : "=v"(r) : "v"(lo), "v"(hi)); return r; }
__device__ __forceinline__ int v_rd_base(int lane) { return ((lane & 3) << 3) | (((lane >> 2) & 3) << 6) | (((lane >> 4) & 1) << 5) | (((lane >> 5) & 1) << 8); }

struct Ptrs { const bf16_t* qh; const f16_t* g16; const bf16_t* v; const bf16_t* og; bf16_t* og_out; const float* ghg; float* U; float* Dg; };

template <bool OUT>
__device__ __forceinline__ void unit(char* lds, LAS3 unsigned char* lds3, const Ptrs& P, int h, int grp) {
    const int tid = threadIdx.x, wid = __builtin_amdgcn_readfirstlane(tid >> 6), lane = tid & 63, r32 = lane & 31, hi = lane >> 5;
    const int tb = wid & 1, vq = wid >> 1;
    const size_t colh = (size_t)h * 128;
    const int vkk = wid * 8 + ((lane & 31) >> 2), vk = (vkk & ~0xC) | ((vkk & 4) << 1) | ((vkk & 8) >> 1);
    const int voff0 = vk * LD + (lane >> 5) * 32 + (lane & 3) * 8;
    const int vb = (int)(uintptr_t)lds + O_V + v_rd_base(lane) + vq * 512;
    f32x16 Sf[2];
    float gsum[16];
#pragma unroll
    for (int j = 0; j < 16; ++j) gsum[j] = 0.f;
    if (OUT) {
        const float* Sin = P.U + ((size_t)(grp * 16 + h) * 128) * 128;
#pragma unroll
        for (int i = 0; i < 2; ++i)
#pragma unroll
            for (int r = 0; r < 16; ++r) Sf[i][r] = Sin[(size_t)(32 * (2 * tb + i) + crow(r, hi)) * 128 + 32 * vq + r32];
    } else { Sf[0] = f32x16{}; Sf[1] = f32x16{}; }
#define WRITE_ST() do { _Pragma("unroll") for (int i = 0; i < 2; ++i) _Pragma("unroll") for (int g = 0; g < 4; ++g) { const int row = 32 * vq + r32, ch = 4 * (2 * tb + i) + g; \
        u32x2 w; w.x = cvtpk(Sf[i][4 * g], Sf[i][4 * g + 1]); w.y = cvtpk(Sf[i][4 * g + 2], Sf[i][4 * g + 3]); \
        *(u32x2*)(lds + O_ST + row * 256 + ((ch * 16) ^ ((row & 7) << 4)) + 8 * hi) = w; } } while (0)
    if (OUT) WRITE_ST();
#define BAR_L() asm volatile("s_waitcnt lgkmcnt(0)\n\ts_barrier" ::: "memory")
#define BAR_VL() asm volatile("s_waitcnt vmcnt(0) lgkmcnt(0)\n\ts_barrier" ::: "memory")
#define DMA_V(tok) do { const bf16_t* s_ = P.v + (size_t)(tok) * LD + colh; \
        __builtin_amdgcn_global_load_lds((const unsigned*)(s_ + voff0), (LAS3 unsigned*)(lds3 + O_V + wid * 2048), 16, 0, 0); \
        __builtin_amdgcn_global_load_lds((const unsigned*)(s_ + voff0 + 64), (LAS3 unsigned*)(lds3 + O_V + wid * 2048 + 1024), 16, 0, 0); } while (0)
    const int t = tid >> 3, kc = (tid & 7) * 16, tl = lane >> 3;
    const size_t grow = ((size_t)grp * 512 + t) * LD + colh + kc;
    f16x8 g0 = *(const f16x8*)(P.g16 + grow), g1 = *(const f16x8*)(P.g16 + grow + 8);
    bf16x8 q0 = {}, q1 = {};
    if (OUT) { q0 = *(const bf16x8*)(P.qh + grow); q1 = *(const bf16x8*)(P.qh + grow + 8); }
    DMA_V((size_t)grp * 512);
    for (int c = 0; c < 8; ++c) {
        const size_t tok0 = (size_t)grp * 512 + c * 64;
        float gl[16], b[16];
#pragma unroll
        for (int j = 0; j < 16; ++j) { gl[j] = (float)(j < 8 ? g0[j] : g1[j - 8]); b[j] = gl[j]; }
#pragma unroll
        for (int j = 0; j < 16; ++j) { float y = __shfl_up(b[j], 8); if (tl >= 1) b[j] += y; y = __shfl_up(b[j], 16); if (tl >= 2) b[j] += y; y = __shfl_up(b[j], 32); if (tl >= 4) b[j] += y; }
        if (tl == 7) { float* sg = (float*)(lds + O_SEG) + wid * 128 + kc;
#pragma unroll
            for (int j4 = 0; j4 < 4; ++j4) *(f32x4*)(sg + 4 * j4) = (f32x4){b[4 * j4], b[4 * j4 + 1], b[4 * j4 + 2], b[4 * j4 + 3]}; }
        BAR_L();
        { const float* sg = (const float*)(lds + O_SEG) + kc;
#pragma unroll
          for (int w = 0; w < 7; ++w) if (w < wid) {
#pragma unroll
              for (int j4 = 0; j4 < 4; ++j4) { const f32x4 x = *(const f32x4*)(sg + w * 128 + 4 * j4); b[4 * j4] += x[0]; b[4 * j4 + 1] += x[1]; b[4 * j4 + 2] += x[2]; b[4 * j4 + 3] += x[3]; } } }
        { float ke[16];
#pragma unroll
          for (int j = 0; j < 16; ++j) ke[j] = (1.f - __expf(gl[j])) * __expf(-b[j]);
          if (OUT) { float qe[16];
#pragma unroll
              for (int j = 0; j < 16; ++j) qe[j] = bf2f((bf16_t)(j < 8 ? q0[j] : q1[j - 8])) * __expf(b[j]);
              u32x4 w0 = {cvtpk(qe[0], qe[1]), cvtpk(qe[2], qe[3]), cvtpk(qe[4], qe[5]), cvtpk(qe[6], qe[7])}, w1 = {cvtpk(qe[8], qe[9]), cvtpk(qe[10], qe[11]), cvtpk(qe[12], qe[13]), cvtpk(qe[14], qe[15])};
              *(u32x4*)(lds + O_QES + KSWZ(t, kc * 2)) = w0; *(u32x4*)(lds + O_QES + KSWZ(t, kc * 2 + 16)) = w1;
              u32x4 k0 = {cvtpk(ke[0], ke[1]), cvtpk(ke[2], ke[3]), cvtpk(ke[4], ke[5]), cvtpk(ke[6], ke[7])}, k1 = {cvtpk(ke[8], ke[9]), cvtpk(ke[10], ke[11]), cvtpk(ke[12], ke[13]), cvtpk(ke[14], ke[15])};
              *(u32x4*)(lds + O_KES + KSWZ(t, kc * 2)) = k0; *(u32x4*)(lds + O_KES + KSWZ(t, kc * 2 + 16)) = k1; }
          { char* kt = lds + O_KET + (t >> 4) * 4096 + kc * 32 + ((t >> 3) & 1) * 16 + (t & 7) * 2;
#pragma unroll
            for (int j = 0; j < 16; ++j) *(unsigned short*)(kt + j * 32) = f2bf(ke[j]); }
          if (t == 63) {
#pragma unroll
              for (int j = 0; j < 16; ++j) { ((float*)(lds + O_DL))[kc + j] = __expf(b[j]); gsum[j] += b[j]; } } }
        BAR_VL();
        bf16x8 e0 = {}, e1 = {};
        if (OUT) { e0 = *(const bf16x8*)(P.og + grow + (size_t)c * 64 * LD); e1 = *(const bf16x8*)(P.og + grow + (size_t)c * 64 * LD + 8); }
        if (c < 7) { const size_t nx = grow + (size_t)(c + 1) * 64 * LD; g0 = *(const f16x8*)(P.g16 + nx); g1 = *(const f16x8*)(P.g16 + nx + 8);
            if (OUT) { q0 = *(const bf16x8*)(P.qh + nx); q1 = *(const bf16x8*)(P.qh + nx + 8); } }
        bf16x8 vf[4];
        { s16x4 lo[4], hh[4];
#pragma unroll
          for (int ks = 0; ks < 4; ++ks) { asm volatile("ds_read_b64_tr_b16 %0, %1 offset:%2" : "=&v"(lo[ks]) : "v"(vb), "i"(ks * 4096) : "memory"); asm volatile("ds_read_b64_tr_b16 %0, %1 offset:%2" : "=&v"(hh[ks]) : "v"(vb), "i"(ks * 4096 + 2048) : "memory"); }
          asm volatile("s_waitcnt lgkmcnt(0)" ::: "memory"); SBAR();
#pragma unroll
          for (int ks = 0; ks < 4; ++ks) vf[ks] = (bf16x8){lo[ks][0], lo[ks][1], lo[ks][2], lo[ks][3], hh[ks][0], hh[ks][1], hh[ks][2], hh[ks][3]}; }
        f32x16 o = f32x16{};
        if (OUT) {
            bf16x8 qr[8];
#pragma unroll
            for (int ks = 0; ks < 8; ++ks) qr[ks] = *(const bf16x8*)(lds + O_QES + KSWZ(32 * tb + r32, (ks * 16 + hi * 8) * 2));
            f32x16 p0 = f32x16{}, p1 = f32x16{};
#pragma unroll
            for (int ks = 0; ks < 8; ++ks) p0 = __builtin_amdgcn_mfma_f32_32x32x16_bf16(*(const bf16x8*)(lds + O_KES + KSWZ(r32, (ks * 16 + hi * 8) * 2)), qr[ks], p0, 0, 0, 0);
            if (tb == 1) {
#pragma unroll
                for (int ks = 0; ks < 8; ++ks) p1 = __builtin_amdgcn_mfma_f32_32x32x16_bf16(*(const bf16x8*)(lds + O_KES + KSWZ(32 + r32, (ks * 16 + hi * 8) * 2)), qr[ks], p1, 0, 0, 0);
#pragma unroll
                for (int r = 0; r < 16; ++r) if (crow(r, hi) > r32) p1[r] = 0.f;
            } else {
#pragma unroll
                for (int r = 0; r < 16; ++r) if (crow(r, hi) > r32) p0[r] = 0.f;
            }
            bf16x8 pa0, pa1, pa2, pa3;
#define PK4(Pv, B_, OUTF) do { unsigned a0 = cvtpk(Pv[B_+0], Pv[B_+1]), a1 = cvtpk(Pv[B_+2], Pv[B_+3]); unsigned b0 = cvtpk(Pv[B_+4], Pv[B_+5]), b1 = cvtpk(Pv[B_+6], Pv[B_+7]); \
        auto r0 = __builtin_amdgcn_permlane32_swap(a0, b0, false, false); auto r1 = __builtin_amdgcn_permlane32_swap(a1, b1, false, false); \
        u32x4 w = {r0[0], r1[0], r0[1], r1[1]}; OUTF = *reinterpret_cast<bf16x8*>(&w); } while (0)
            PK4(p0, 0, pa0); PK4(p0, 8, pa1); PK4(p1, 0, pa2); PK4(p1, 8, pa3);
#undef PK4
            o = __builtin_amdgcn_mfma_f32_32x32x16_bf16(pa0, vf[0], o, 0, 0, 0); o = __builtin_amdgcn_mfma_f32_32x32x16_bf16(pa1, vf[1], o, 0, 0, 0);
            o = __builtin_amdgcn_mfma_f32_32x32x16_bf16(pa2, vf[2], o, 0, 0, 0); o = __builtin_amdgcn_mfma_f32_32x32x16_bf16(pa3, vf[3], o, 0, 0, 0);
#pragma unroll
            for (int ks = 0; ks < 8; ++ks) o = __builtin_amdgcn_mfma_f32_32x32x16_bf16(qr[ks], *(const bf16x8*)(lds + O_ST + KSWZ(32 * vq + r32, (ks * 16 + hi * 8) * 2)), o, 0, 0, 0);
        }
#pragma unroll
        for (int i = 0; i < 2; ++i) { const int kb = 2 * tb + i; f32x16 acc = f32x16{};
#pragma unroll
            for (int ks = 0; ks < 4; ++ks) acc = __builtin_amdgcn_mfma_f32_32x32x16_bf16(*(const bf16x8*)(lds + O_KET + ks * 4096 + (32 * kb + r32) * 32 + hi * 16), vf[ks], acc, 0, 0, 0);
#pragma unroll
            for (int r = 0; r < 16; ++r) Sf[i][r] = ((const float*)(lds + O_DL))[32 * kb + crow(r, hi)] * (Sf[i][r] + acc[r]); }
        BAR_L();
        if (!OUT) { if (c < 7) DMA_V(tok0 + 64); }
        if (OUT) {
            WRITE_ST();
            { float* ot = (float*)(lds + O_BL);
#pragma unroll
              for (int r = 0; r < 16; ++r) ot[(32 * tb + crow(r, hi)) * 128 + 32 * vq + r32] = o[r]; }
            BAR_L();
            { const int vc = kc; const float* ot = (const float*)(lds + O_BL) + t * 128 + vc; float x[16]; float ss = 0.f;
#pragma unroll
              for (int j4 = 0; j4 < 4; ++j4) { const f32x4 y = *(const f32x4*)(ot + 4 * j4); x[4 * j4] = y[0]; x[4 * j4 + 1] = y[1]; x[4 * j4 + 2] = y[2]; x[4 * j4 + 3] = y[3]; ss += (y[0] * y[0] + y[1] * y[1]) + (y[2] * y[2] + y[3] * y[3]); }
              ss += __shfl_xor(ss, 1); ss += __shfl_xor(ss, 2); ss += __shfl_xor(ss, 4);
              const float rstd = rsqrtf(ss * (1.f / 128.f) + EPS);
              bf16_t* op = P.og_out + (tok0 + t) * LD + colh + vc;
#pragma unroll
              for (int j = 0; j < 16; ++j) x[j] = x[j] * rstd * P.ghg[vc + j] * bf2f((bf16_t)(j < 8 ? e0[j] : e1[j - 8]));
              if (c < 7) DMA_V(tok0 + 64);
              u32x4 w0 = {cvtpk(x[0], x[1]), cvtpk(x[2], x[3]), cvtpk(x[4], x[5]), cvtpk(x[6], x[7])}, w1 = {cvtpk(x[8], x[9]), cvtpk(x[10], x[11]), cvtpk(x[12], x[13]), cvtpk(x[14], x[15])};
              *(u32x4*)op = w0; *(u32x4*)(op + 8) = w1; }
        }
    }
    BAR_VL();
#undef BAR_L
#undef BAR_VL
#undef DMA_V
    if (!OUT) {
        float* Uo = P.U + ((size_t)(grp * 16 + h) * 128) * 128;
#pragma unroll
        for (int i = 0; i < 2; ++i)
#pragma unroll
            for (int r = 0; r < 16; ++r) Uo[(size_t)(32 * (2 * tb + i) + crow(r, hi)) * 128 + 32 * vq + r32] = Sf[i][r];
        if ((tid >> 3) == 63) { const int kc = (tid & 7) * 16;
#pragma unroll
            for (int j = 0; j < 16; ++j) P.Dg[(size_t)(grp * 16 + h) * 128 + kc + j] = __expf(gsum[j]); }
    }
#undef WRITE_ST
}
template <bool OUT> __device__ __forceinline__ void phase(char* lds, LAS3 unsigned char* lds3, const Ptrs& P, int vcu, int G) {
    for (int u = vcu; u < 256; u += G) unit<OUT>(lds, lds3, P, u >> 4, u & 15);
}
__device__ __forceinline__ void scan_phase(float* U, const float* Dg, int gt, int NGT) {
    for (int e = gt; e < 16 * 128 * 128; e += NGT) { const int hk = e >> 7; float cur = 0.f;
#pragma unroll
        for (int g = 0; g < 16; ++g) { const size_t idx = (size_t)g * (16 * 128 * 128) + e; const float u = U[idx], d = Dg[(size_t)g * (16 * 128) + hk]; U[idx] = cur; cur = d * cur + u; } }
}
#undef LAS3
#undef KSWZ
#undef SBAR
}
#define GAS __attribute__((address_space(1)))
#define LAS __attribute__((address_space(3)))
typedef float f32x4 __attribute__((ext_vector_type(4)));
typedef unsigned v4u __attribute__((ext_vector_type(4)));
typedef unsigned v2u __attribute__((ext_vector_type(2)));
constexpr int NWAVES = 8, NTHREADS = 512;
constexpr int RING_BYTES = 131072, LDS_BYTES = 147456;
constexpr int MISC_OFF = LDS_BYTES - 256, CW_BAR = 4096;
#define LDS_WAIT() asm volatile("s_waitcnt lgkmcnt(0)" ::: "memory")
__device__ __forceinline__ unsigned pk2(float lo, float hi) { return (unsigned)f2bf(lo) | ((unsigned)f2bf(hi) << 16); }
__device__ __forceinline__ float wave_sum(float v) {
#pragma unroll
    for (int o = 1; o < 64; o <<= 1) v += __shfl_xor(v, o);
    return v;
}
#define XB_TMO      128
#define XB_XCNT(j)  (256  + 64 * (j))
#define XB_XSUB(j)  (1280 + 64 * (j))
#define XB_XGEN(j)  (2304 + 64 * (j))
#define XB_TOP      3328
#define XB_TOPGEN   3392
#define XCD_BAR_WORDS 3456
#define XB_SPIN_CAP (1u << 18)

__device__ __forceinline__ unsigned xb_ld(unsigned* p)              { return __hip_atomic_load(p, __ATOMIC_RELAXED, __HIP_MEMORY_SCOPE_AGENT); }
__device__ __forceinline__ unsigned xb_add(unsigned* p, unsigned v) { return __hip_atomic_fetch_add(p, v, __ATOMIC_RELAXED, __HIP_MEMORY_SCOPE_AGENT); }
__device__ __forceinline__ unsigned xb_xcc_id() { return (unsigned)__builtin_amdgcn_s_getreg((3 << 11) | 20) & 0xFu; }
#define XB_SPIN(cond, bar) do { unsigned _sp = 0; while (cond) { __builtin_amdgcn_s_sleep(1); \
    if ((++_sp & 255u) == 0u) { if (xb_ld(&(bar)[XB_TMO])) break; if (_sp > XB_SPIN_CAP) { atomicAdd(&(bar)[XB_TMO], 1u); break; } } } } while (0)

struct XcdBarrier {
    unsigned* bar; unsigned x;
    volatile LAS unsigned* st;
};

__device__ __forceinline__ XcdBarrier xcd_barrier_post(unsigned* bar, volatile LAS unsigned* st) {
    XcdBarrier b; b.bar = bar; b.x = xb_xcc_id(); b.st = st;
    if (threadIdx.x == 0) (void)xb_add(&bar[XB_XCNT(b.x)], 1u);
    return b;
}
__device__ __forceinline__ void xcd_barrier_complete(unsigned* bar, unsigned x, unsigned& nloc, unsigned& nx) {
    const unsigned G = gridDim.x * gridDim.y * gridDim.z;
    unsigned sum, cnt, mine, sp = 0u;
    for (;;) {
        sum = 0u; cnt = 0u; mine = 0u;
#pragma unroll
        for (unsigned j = 0; j < 16; ++j) { const unsigned c = xb_ld(&bar[XB_XCNT(j)]); sum += c; cnt += (c > 0u) ? 1u : 0u; mine = (j == x) ? c : mine; }
        if (sum == G) break;
        __builtin_amdgcn_s_sleep(1);
        if ((++sp & 255u) == 0u) { if (xb_ld(&bar[XB_TMO])) break; if (sp > XB_SPIN_CAP) { atomicAdd(&bar[XB_TMO], 1u); break; } }
    }
    nloc = mine > 0u ? mine : 1u; nx = cnt > 0u ? cnt : 1u;
}

__device__ __forceinline__ void xcd_barrier(const XcdBarrier& b) {
    asm volatile("s_waitcnt vmcnt(0)" ::: "memory");
    __syncthreads();
    if (threadIdx.x == 0) {
        unsigned* bar = b.bar;
        __builtin_amdgcn_s_waitcnt(0);
        unsigned nloc = b.st[0], nx = b.st[1];
        if (nloc == 0u) { xcd_barrier_complete(bar, b.x, nloc, nx); b.st[0] = nloc; b.st[1] = nx; }
        const unsigned old = xb_add(&bar[XB_XSUB(b.x)], 1u);
        const unsigned gen = old / nloc;
        if (old + 1u == (gen + 1u) * nloc) {
            __builtin_amdgcn_fence(__ATOMIC_RELEASE, "agent");
            asm volatile("s_waitcnt vmcnt(0)" ::: "memory");
            const unsigned og = xb_add(&bar[XB_TOP], 1u);
            const unsigned tg = og / nx;
            if (og + 1u == (tg + 1u) * nx) xb_add(&bar[XB_TOPGEN], 1u);
            else XB_SPIN(xb_ld(&bar[XB_TOPGEN]) == tg, bar);
            __builtin_amdgcn_fence(__ATOMIC_ACQUIRE, "agent");
            xb_add(&bar[XB_XGEN(b.x)], 1u);
            asm volatile("s_waitcnt vmcnt(0)" ::: "memory");
        } else {
            XB_SPIN(xb_ld(&bar[XB_XGEN(b.x)]) == gen, bar);
            __builtin_amdgcn_fence(__ATOMIC_ACQUIRE, "agent");
            asm volatile("s_waitcnt vmcnt(0)" ::: "memory");
        }
    }
    __syncthreads();
}

struct Args { const void* in[21]; float* out; unsigned char* ws; int ph_lo, ph_hi; };

template <int MAP> __device__ __forceinline__ int src_map(int n) { return MAP == 0 ? src_in(n) : MAP == 1 ? src_uq(n) : MAP == 2 ? src_gu(n) : n; }
template <int MAP> __device__ __forceinline__ void p0_transpose_item(const float* W, int K, int N, int NP, const float* scale, bf16_t* WT, LAS float* scr, int item, int lane) {
    const int nblk = NP / 64, kb = item / nblk, nb = item % nblk, k0 = 64 * kb, n0 = 64 * nb;
    const int nq = (lane & 15) * 4, kr = lane >> 4;
    const int s0 = src_map<MAP>(n0 + nq), s1 = src_map<MAP>(n0 + nq + 1), s2 = src_map<MAP>(n0 + nq + 2), s3 = src_map<MAP>(n0 + nq + 3);
    f32x4 v[16];
    if (__all(s0 >= 0 && s1 == s0 + 1 && s2 == s0 + 2 && s3 == s0 + 3)) {
#pragma unroll
        for (int i = 0; i < 16; ++i) v[i] = *(const f32x4*)(W + (size_t)(k0 + 4 * i + kr) * N + s0);
    } else {
#pragma unroll
        for (int i = 0; i < 16; ++i) { const float* wr = W + (size_t)(k0 + 4 * i + kr) * N; v[i][0] = s0 >= 0 ? wr[s0] : 0.f; v[i][1] = s1 >= 0 ? wr[s1] : 0.f; v[i][2] = s2 >= 0 ? wr[s2] : 0.f; v[i][3] = s3 >= 0 ? wr[s3] : 0.f; }
    }
    if (scale) {
#pragma unroll
        for (int i = 0; i < 16; ++i) v[i] *= scale[k0 + 4 * i + kr]; }
#pragma unroll
    for (int i = 0; i < 16; ++i)
#pragma unroll
        for (int q = 0; q < 4; ++q) scr[(nq + q) * 65 + 4 * i + kr] = v[i][q];
    LDS_WAIT(); asm volatile("" ::: "memory");
    const int c = lane & 7;
#pragma unroll
    for (int j = 0; j < 8; ++j) { const int n = (lane >> 3) + 8 * j; const LAS float* s = scr + n * 65 + 8 * c;
        v4u o; o.x = pk2(s[0], s[1]); o.y = pk2(s[2], s[3]); o.z = pk2(s[4], s[5]); o.w = pk2(s[6], s[7]);
        *(GAS v4u*)(WT + (size_t)(n0 + n) * K + k0 + 8 * c) = o; }
    LDS_WAIT(); asm volatile("" ::: "memory");
}
__device__ __forceinline__ void p0_prologue(const Args& a, LAS unsigned char* lds, int vcu, int G, int wave, int lane, int tid) {
    unsigned char* ws = a.ws;
    { LAS float* scr = (LAS float*)(lds + wave * 16640);
      const int gw = vcu * NWAVES + wave, NGW = G * NWAVES;
      constexpr int I_IN = (D / 64) * (IN_WP / 64), I_SQ = (D / 64) * (D / 64), I_UQ = (QL / 64) * (UQ_W / 64), I_UKV = (KVL / 64) * (UKV_W / 64);
      constexpr int NITEMS = I_IN + 3 * I_SQ + I_UQ + I_UKV;
      for (int it = gw; it < NITEMS; it += NGW) { int r = it;
          if (r < I_IN) { p0_transpose_item<0>((const float*)a.in[6], D, IN_W, IN_WP, nullptr, (bf16_t*)(ws + WS_WIN), scr, r, lane); continue; } r -= I_IN;
          if (r < I_SQ) { p0_transpose_item<3>((const float*)a.in[9], D, D, D, nullptr, (bf16_t*)(ws + WS_WOHG), scr, r, lane); continue; } r -= I_SQ;
          if (r < I_SQ) { p0_transpose_item<3>((const float*)a.in[14], D, D, D, nullptr, (bf16_t*)(ws + WS_WOMLA), scr, r, lane); continue; } r -= I_SQ;
          if (r < I_SQ) { p0_transpose_item<3>((const float*)a.in[15], D, D, D, nullptr, (bf16_t*)(ws + WS_WOUT), scr, r, lane); continue; } r -= I_SQ;
          if (r < I_UQ) { p0_transpose_item<1>((const float*)a.in[11], QL, UQ_W, UQ_W, (const float*)a.in[10], (bf16_t*)(ws + WS_WUQ), scr, r, lane); continue; } r -= I_UQ;
          p0_transpose_item<3>((const float*)a.in[13], KVL, UKV_W, UKV_W, (const float*)a.in[12], (bf16_t*)(ws + WS_WUKV), scr, r, lane);
      } }
    __syncthreads();
    { const int gt = vcu * NTHREADS + tid, NGT = G * NTHREADS; const int* pos = (const int*)a.in[2]; float* rope = (float*)(ws + WS_ROPE);
      const int j = gt & 31; const float inv = (float)pow(10000.0, -(double)(2 * j) / 64.0);
      for (int i = gt; i < S * 32; i += NGT) { const int t = i >> 5; const float ang = (float)pos[t] * inv; double sn, cs; sincos((double)ang, &sn, &cs);
          rope[2 * i] = (float)cs; rope[2 * i + 1] = (float)sn; }
      if (gt < 2048) { const float* ll = (const float*)a.in[7]; const float x0 = ll[gt], x1 = ll[2048 + gt], m = fmaxf(x0, x1); const float e0 = expf(x0 - m), e1 = expf(x1 - m); ((float*)(ws + WS_LB))[gt] = e0 / (e0 + e1); } }
    { LAS float* sc = (LAS float*)lds; LAS float* part = (LAS float*)(lds + 8192);
      const float* c = (const float*)a.in[1]; const float* w_ada = (const float*)a.in[3]; const float* b_ada = (const float*)a.in[4];
      for (int i = tid; i < D; i += NTHREADS) { const float cv = c[i]; sc[i] = cv / (1.f + expf(-cv)); }
      __syncthreads();
      for (int cb = vcu; cb < (NMOD * D) / 48; cb += G) {
          const int rg = tid / 12, cg = tid % 12; f32x4 acc = {0.f, 0.f, 0.f, 0.f};
          if (rg < 42) { const float* wp = w_ada + (size_t)cb * 48 + cg * 4;
              for (int r0 = rg; r0 < D; r0 += 42 * 7) { f32x4 w[7];
#pragma unroll
                  for (int u = 0; u < 7; ++u) { const int r = r0 + 42 * u; w[u] = r < D ? *(const f32x4*)(wp + (size_t)r * (NMOD * D)) : (f32x4){0.f, 0.f, 0.f, 0.f}; }
#pragma unroll
                  for (int u = 0; u < 7; ++u) { const int r = r0 + 42 * u; if (r < D) acc += w[u] * sc[r]; } }
              *(LAS f32x4*)(part + rg * 48 + cg * 4) = acc; }
          __syncthreads();
          if (tid < 48) { float s = 0.f; for (int r = 0; r < 42; ++r) s += part[r * 48 + tid]; ((float*)(ws + WS_MOD))[cb * 48 + tid] = s + b_ada[cb * 48 + tid]; }
          __syncthreads();
      } }
}
template <int MAP> __device__ __forceinline__ void tail_convert(const float* W, int K, int N, int NP, bf16_t* WT, LAS unsigned char* lds, int nwg, int G, int c, int wave, int lane) {
    const int rounds = (nwg + G - 1) / G, nlast = nwg - (rounds - 1) * G;
    if (c < nlast || nlast == G) { if (nlast != G) return; }
    const int nworkers = nlast == G ? G : G - nlast, w = nlast == G ? c : c - nlast;
    LAS float* scr = (LAS float*)(lds + wave * 16640);
    const int nitems = (K / 64) * (NP / 64);
    for (int it = w * NWAVES + wave; it < nitems; it += nworkers * NWAVES) p0_transpose_item<MAP>(W, K, N, NP, nullptr, WT, scr, it, lane);
}
__device__ __forceinline__ void p1_rows_h(const Args& a, int gw, int NGW, int lane) {
    const float* x = (const float*)a.in[0]; const float* g = (const float*)a.in[5]; const float* mod = (const float*)(a.ws + WS_MOD); bf16_t* h = (bf16_t*)(a.ws + WS_H);
    for (int row = gw; row < S; row += NGW) {
        const f32x4* xr = (const f32x4*)(x + (size_t)row * D) + lane; f32x4 v[8]; float ss = 0.f;
#pragma unroll
        for (int j = 0; j < 8; ++j) { v[j] = xr[64 * j]; ss += (v[j][0] * v[j][0] + v[j][1] * v[j][1]) + (v[j][2] * v[j][2] + v[j][3] * v[j][3]); }
        const float rstd = rsqrtf(wave_sum(ss) * (1.f / D) + EPS);
        v2u* o = (v2u*)(h + (size_t)row * D) + lane;
#pragma unroll
        for (int j = 0; j < 8; ++j) { const int cidx = 64 * j + lane; const f32x4 gg = ((const f32x4*)g)[cidx], sh = ((const f32x4*)mod)[cidx], sc = ((const f32x4*)(mod + 2048))[cidx];
            const f32x4 r = v[j] * rstd * gg * (sc + 1.f) + sh; v2u w; w.x = pk2(r[0], r[1]); w.y = pk2(r[2], r[3]); o[64 * j] = w; }
    }
}
__device__ __forceinline__ void p9_rows_mid(const Args& a, int gw, int NGW, int lane) {
    const float* x = (const float*)a.in[0]; const float* y = (const float*)(a.ws + WS_Y); const float* ssy = (const float*)(a.ws + WS_SSY); const float* mod = (const float*)(a.ws + WS_MOD);
    const float* gpost = (const float*)a.in[16]; const float* gpre = (const float*)a.in[17]; bf16_t* h2 = (bf16_t*)(a.ws + WS_H);
    for (int row = gw; row < S; row += NGW) {
        const float rstd = rsqrtf(wave_sum(lane < 32 ? ssy[(size_t)row * 32 + lane] : 0.f) * (1.f / D) + EPS);
        const f32x4* xr = (const f32x4*)(x + (size_t)row * D) + lane; const f32x4* yr = (const f32x4*)(y + (size_t)row * D) + lane; f32x4* orow = (f32x4*)(a.out + (size_t)row * D) + lane;
        f32x4 v[8]; float ss = 0.f;
#pragma unroll
        for (int j = 0; j < 8; ++j) { const int cidx = 64 * j + lane; const f32x4 ga = ((const f32x4*)(mod + 4096))[cidx], gp = ((const f32x4*)gpost)[cidx];
            v[j] = xr[64 * j] + ga * (yr[64 * j] * rstd * gp); orow[64 * j] = v[j]; ss += (v[j][0] * v[j][0] + v[j][1] * v[j][1]) + (v[j][2] * v[j][2] + v[j][3] * v[j][3]); }
        const float r2 = rsqrtf(wave_sum(ss) * (1.f / D) + EPS);
        v2u* o = (v2u*)(h2 + (size_t)row * D) + lane;
#pragma unroll
        for (int j = 0; j < 8; ++j) { const int cidx = 64 * j + lane; const f32x4 gg = ((const f32x4*)gpre)[cidx], sh = ((const f32x4*)(mod + 6144))[cidx], sc = ((const f32x4*)(mod + 8192))[cidx];
            const f32x4 r = v[j] * r2 * gg * (sc + 1.f) + sh; v2u w; w.x = pk2(r[0], r[1]); w.y = pk2(r[2], r[3]); o[64 * j] = w; }
    }
}
__device__ __forceinline__ void p12_rows_final(const Args& a, int gw, int NGW, int lane) {
    const float* y2 = (const float*)(a.ws + WS_Y2); const float* ss2 = (const float*)(a.ws + WS_SSY2); const float* mod = (const float*)(a.ws + WS_MOD); const float* gpost = (const float*)a.in[20];
    for (int row = gw; row < S; row += NGW) {
        const float rstd = rsqrtf(wave_sum(lane < 32 ? ss2[(size_t)row * 32 + lane] : 0.f) * (1.f / D) + EPS);
        const f32x4* yr = (const f32x4*)(y2 + (size_t)row * D) + lane; f32x4* orow = (f32x4*)(a.out + (size_t)row * D) + lane;
#pragma unroll
        for (int j = 0; j < 8; ++j) { const int cidx = 64 * j + lane; const f32x4 ga = ((const f32x4*)(mod + 10240))[cidx], gp = ((const f32x4*)gpost)[cidx];
            orow[64 * j] = orow[64 * j] + ga * (yr[64 * j] * rstd * gp); }
    }
}

__global__ void __launch_bounds__(NTHREADS, 2) fwd(Args a) {
    extern __shared__ __attribute__((aligned(16))) unsigned char lds_raw[];
    LAS unsigned char* lds = (LAS unsigned char*)lds_raw;
    const int tid = threadIdx.x, lane = tid & 63, wave = __builtin_amdgcn_readfirstlane(tid >> 6);
    const int G = gridDim.x, bx = blockIdx.x, vcu = (G % 8 == 0) ? (bx % 8) * (G / 8) + bx / 8 : bx;
    const int gw = vcu * NWAVES + wave, NGW = G * NWAVES;
    unsigned char* ws = a.ws;
    const int lo = a.ph_lo, hi = a.ph_hi;
    volatile LAS unsigned* MISC = (volatile LAS unsigned*)(lds + MISC_OFF);
    if (tid < 16) MISC[tid] = 0u;
    __syncthreads();
    XcdBarrier bar = xcd_barrier_post((unsigned*)(ws + WS_CTL) + CW_BAR, MISC + 8);
#define IN(k) (lo <= (k) && (k) < hi)
#define BAR_AFTER(k) do { if (IN(k) && IN((k) + 1)) xcd_barrier(bar); } while (0)
    const hg::Ptrs hp{(const bf16_t*)(ws + WS_QH), (const f16_t*)(ws + WS_G16), (const bf16_t*)(ws + WS_V), (const bf16_t*)(ws + WS_OG), (bf16_t*)(ws + WS_OG), (const float*)a.in[8], (float*)(ws + WS_U), (float*)(ws + WS_DG)};
    if (IN(0)) p0_prologue(a, lds, vcu, G, wave, lane, tid);
#if PROBE_DUP == 100
    if (IN(0)) { __syncthreads(); p0_prologue(a, lds, vcu, G, wave, lane, tid); }
#endif
    BAR_AFTER(0);
    if (IN(1)) p1_rows_h(a, gw, NGW, lane);
    BAR_AFTER(1);
    if (IN(2)) {
        pg8::Gemm g{(const bf16_t*)(ws + WS_H), (const bf16_t*)(ws + WS_WIN), S, IN_WP, D}; pg8::StaticOrder So; So.init(S, IN_WP, G, bx);
        pg8::EpiIn E{(bf16_t*)(ws + WS_QH), (bf16_t*)(ws + WS_G16), (bf16_t*)(ws + WS_V), (bf16_t*)(ws + WS_OG), (bf16_t*)(ws + WS_SA), (bf16_t*)(ws + WS_SB), (bf16_t*)(ws + WS_CQ), (bf16_t*)(ws + WS_CKV), (bf16_t*)(ws + WS_KR),
                     (const float*)(ws + WS_LB), (const float*)(ws + WS_ROPE), (float*)(ws + WS_SSQ), (float*)(ws + WS_SSKV)};
        pg8::gemm_phase<pg8::EpiIn, pg8::StaticOrder, true, true>(lds, g, So, E);
        tail_convert<2>((const float*)a.in[18], D, GU_W, GU_W, (bf16_t*)(ws + WS_WGU), lds, (S / 256) * (IN_WP / 256), G, bx, wave, lane);
#if PROBE_DUP == 102
        pg8::gemm_phase<pg8::EpiIn, pg8::StaticOrder, true, true>(lds, g, So, E);
#endif
    }
    BAR_AFTER(2);
    if (IN(3)) {
        { pg8::Gemm g{(const bf16_t*)(ws + WS_CQ), (const bf16_t*)(ws + WS_WUQ), S, UQ_W, QL}; pg8::StaticOrder So; So.init(S, UQ_W, G, bx);
          pg8::EpiUq E{(bf16_t*)(ws + WS_QN), (bf16_t*)(ws + WS_QR), (const float*)(ws + WS_SSQ), (const float*)(ws + WS_ROPE), QSCALE, EPS};
          pg8::gemm_phase<pg8::EpiUq, pg8::StaticOrder, true, true>(lds, g, So, E); }
        { pg8::Gemm g{(const bf16_t*)(ws + WS_CKV), (const bf16_t*)(ws + WS_WUKV), S, UKV_W, KVL}; pg8::StaticOrder So; So.init(S, UKV_W, G, bx);
          pg8::EpiUkv E{(bf16_t*)(ws + WS_KN), (bf16_t*)a.out, (const float*)(ws + WS_SSKV), EPS};
          pg8::gemm_phase<pg8::EpiUkv, pg8::StaticOrder, true, true>(lds, g, So, E); }
        hg::phase<false>((char*)lds_raw, lds, hp, vcu, G);
#if PROBE_DUP == 103
        hg::phase<false>((char*)lds_raw, lds, hp, vcu, G);
#endif
    }
    BAR_AFTER(3);
    if (IN(4)) hg::scan_phase((float*)(ws + WS_U), (const float*)(ws + WS_DG), vcu * NTHREADS + tid, G * NTHREADS);
    BAR_AFTER(4);
    if (IN(5)) {
#if PROBE_DUP == 105
        att::phase((char*)lds_raw, lds, (bf16_t*)(ws + WS_QN), (const bf16_t*)(ws + WS_QR), (const bf16_t*)(ws + WS_KN), (const bf16_t*)(ws + WS_KR), (const bf16_t*)a.out, (bf16_t*)((unsigned char*)a.out + 32 * MiB), vcu, G);
#endif
        att::phase((char*)lds_raw, lds, (bf16_t*)(ws + WS_QN), (const bf16_t*)(ws + WS_QR), (const bf16_t*)(ws + WS_KN), (const bf16_t*)(ws + WS_KR), (const bf16_t*)a.out, (bf16_t*)(ws + WS_QN), vcu, G);
#if PROBE_DUP == 106
        { hg::Ptrs hp2 = hp; hp2.og_out = (bf16_t*)((unsigned char*)a.out + 32 * MiB); hg::phase<true>((char*)lds_raw, lds, hp2, vcu, G); }
#endif
        hg::phase<true>((char*)lds_raw, lds, hp, vcu, G);
    }
    BAR_AFTER(5);
    if (IN(6)) {
        { pg8::Gemm g{(const bf16_t*)(ws + WS_OG), (const bf16_t*)(ws + WS_WOHG), S, D, D}; pg8::StaticOrder So; So.init(S, D, G, bx);
          pg8::EpiYa E{(float*)(ws + WS_YAS), (const bf16_t*)(ws + WS_SA)};
          pg8::gemm_phase<pg8::EpiYa, pg8::StaticOrder, true, true>(lds, g, So, E); }
        { pg8::Gemm g{(const bf16_t*)(ws + WS_QN), (const bf16_t*)(ws + WS_WOMLA), S, D, D}; pg8::StaticOrder So; So.init(S, D, G, bx);
          pg8::EpiYb E{(const float*)(ws + WS_YAS), (const bf16_t*)(ws + WS_SB), (bf16_t*)(ws + WS_MERGED)};
          pg8::gemm_phase<pg8::EpiYb, pg8::StaticOrder, true, true>(lds, g, So, E); }
    }
    BAR_AFTER(6);
    if (IN(7)) {
        pg8::Gemm g{(const bf16_t*)(ws + WS_MERGED), (const bf16_t*)(ws + WS_WOUT), S, D, D}; pg8::StaticOrder So; So.init(S, D, G, bx);
        pg8::EpiF32SS E{(float*)(ws + WS_Y), (float*)(ws + WS_SSY)};
        pg8::gemm_phase<pg8::EpiF32SS, pg8::StaticOrder, true, true>(lds, g, So, E);
    }
    BAR_AFTER(7);
    if (IN(8)) p9_rows_mid(a, gw, NGW, lane);
    BAR_AFTER(8);
    if (IN(9)) {
        pg8::Gemm g{(const bf16_t*)(ws + WS_H), (const bf16_t*)(ws + WS_WGU), S, GU_W, D}; pg8::StaticOrder So; So.init(S, GU_W, G, bx);
        pg8::EpiGu E{(bf16_t*)(ws + WS_ACT), DFF};
        pg8::gemm_phase<pg8::EpiGu, pg8::StaticOrder, true, true>(lds, g, So, E);
        tail_convert<3>((const float*)a.in[19], DFF, D, D, (bf16_t*)(ws + WS_WDN), lds, (S / 256) * (GU_W / 256), G, bx, wave, lane);
#if PROBE_DUP == 109
        pg8::gemm_phase<pg8::EpiGu, pg8::StaticOrder, true, true>(lds, g, So, E);
#endif
    }
    BAR_AFTER(9);
    if (IN(10)) {
        pg8::Gemm g{(const bf16_t*)(ws + WS_ACT), (const bf16_t*)(ws + WS_WDN), S, D, DFF}; pg8::StaticOrder So; So.init(S, D, G, bx);
        pg8::EpiF32SS E{(float*)(ws + WS_Y2), (float*)(ws + WS_SSY2)};
        pg8::gemm_phase<pg8::EpiF32SS, pg8::StaticOrder, true, true>(lds, g, So, E);
    }
    BAR_AFTER(10);
    if (IN(11)) p12_rows_final(a, gw, NGW, lane);
#undef IN
#undef BAR_AFTER
}
extern "C" void kernel_launch(void* const* d_in, const int* in_sizes, int n_in, void* d_out, int out_size, void* d_ws, size_t ws_size, hipStream_t stream) {
    static int grid = 0;
    if (grid == 0) {
        if (n_in != 21 || out_size != S * D || ws_size < WS_END) { fprintf(stderr, "kernel_launch: unexpected shapes (n_in %d out %d ws %zu)\n", n_in, out_size, ws_size); grid = -1; return; }
        int dev = 0, cus = 0;
        if (hipGetDevice(&dev) != hipSuccess || hipDeviceGetAttribute(&cus, hipDeviceAttributeMultiprocessorCount, dev) != hipSuccess) { grid = -1; return; }
        if (hipFuncSetAttribute((const void*)fwd, hipFuncAttributeMaxDynamicSharedMemorySize, LDS_BYTES) != hipSuccess) { fprintf(stderr, "kernel_launch: hipFuncSetAttribute failed\n"); grid = -1; return; }
        int per_cu = 0;
        if (hipOccupancyMaxActiveBlocksPerMultiprocessor(&per_cu, (const void*)fwd, NTHREADS, LDS_BYTES) != hipSuccess || per_cu < 1) { fprintf(stderr, "kernel_launch: occupancy query failed (%d)\n", per_cu); (void)hipGetLastError(); per_cu = 1; }
        grid = cus;
    }
    if (grid < 0) return;
    Args a{};
    for (int i = 0; i < 21; ++i) a.in[i] = d_in[i];
    a.out = (float*)d_out; a.ws = (unsigned char*)d_ws;
    auto run = [&](int lo, int hi) { a.ph_lo = lo; a.ph_hi = hi; hipLaunchKernelGGL(fwd, dim3(grid), dim3(NTHREADS), LDS_BYTES, stream, a); };
    if (hipMemsetAsync((char*)d_ws + WS_CTL, 0, 65536, stream) != hipSuccess) { fprintf(stderr, "kernel_launch: hipMemsetAsync failed\n"); return; }
    run(0, 12);
}
```

```cpp
#ifndef PG8_SP2V
#define PG8_SP2V true
#endif
#ifndef PROBE_DUP
#define PROBE_DUP 0
#endif
#include <hip/hip_runtime.h>
#include <hip/hip_bf16.h>
#include <hip/hip_fp16.h>
#include <cstdio>
#include <cstdint>

typedef unsigned short bf16_t;
typedef unsigned short f16_t;

constexpr int S = 8192, D = 2048, H = 16, HK = 128, HV = 128;
constexpr int QL = 512, KVL = 512, NOPE = 128, ROPE = 64, VD = 128, QKD = 192;
constexpr int DFF = 5632, NMOD = 6;
constexpr int IN_W = 13376, IN_WP = 13568;
constexpr int UQ_W = 3072, UKV_W = 4096, GU_W = 11264;
constexpr float EPS = 1e-6f;
constexpr float QSCALE = 0.07216878364870322f * 1.4426950408889634f;

constexpr size_t MiB = 1u << 20;
constexpr size_t WS_CTL = 0;
constexpr size_t WS_MOD = 1 * MiB;
constexpr size_t WS_LB = 1 * MiB + 64 * 1024;
constexpr size_t WS_DG = 1 * MiB + 128 * 1024;
constexpr size_t WS_ROPE = 2 * MiB;
constexpr size_t WS_SSQ = 4 * MiB;
constexpr size_t WS_SSKV = 5 * MiB;
constexpr size_t WS_SSY = 6 * MiB;
constexpr size_t WS_SSY2 = 7 * MiB;
constexpr size_t WS_SSX1 = 367 * MiB;
constexpr size_t WS_WIN = 8 * MiB;
constexpr size_t WS_QN = 8 * MiB;
constexpr size_t WS_QR = 40 * MiB;
constexpr size_t WS_WOHG = 61 * MiB;
constexpr size_t WS_WUQ = 69 * MiB;
constexpr size_t WS_WUKV = 72 * MiB;
constexpr size_t WS_WOMLA = 76 * MiB;
constexpr size_t WS_WOUT = 84 * MiB;
constexpr size_t WS_WGU = 92 * MiB;
constexpr size_t WS_WDN = 136 * MiB;
constexpr size_t WS_QH = 158 * MiB;
constexpr size_t WS_G16 = 190 * MiB;
constexpr size_t WS_V = 222 * MiB;
constexpr size_t WS_OG = 254 * MiB;
constexpr size_t WS_SA = 286 * MiB;
constexpr size_t WS_SB = 318 * MiB;
constexpr size_t WS_CQ = 350 * MiB;
constexpr size_t WS_CKV = 358 * MiB;
constexpr size_t WS_KR = 366 * MiB;
constexpr size_t WS_H = 368 * MiB;
constexpr size_t WS_KN = 368 * MiB;
constexpr size_t WS_U = 400 * MiB;
constexpr size_t WS_YAS = 158 * MiB;
constexpr size_t WS_MERGED = 222 * MiB;
constexpr size_t WS_Y = 254 * MiB;
constexpr size_t WS_ACT = 158 * MiB;
constexpr size_t WS_Y2 = 254 * MiB;
constexpr size_t WS_SCR2 = 318 * MiB;
constexpr size_t WS_END = 416 * MiB;

__device__ __forceinline__ float bf2f(bf16_t v) { return __uint_as_float((unsigned)v << 16); }
__device__ __forceinline__ bf16_t f2bf(float f) { unsigned u = __float_as_uint(f); return (bf16_t)((u + 0x7fffu + ((u >> 16) & 1u)) >> 16); }
__device__ __forceinline__ float h2f(f16_t v) { return __half2float(__ushort_as_half(v)); }
__device__ __forceinline__ f16_t f2h(float f) { return __half_as_ushort(__float2half_rn(f)); }
__device__ __forceinline__ float sigmoidf_(float x) { return 1.f / (1.f + __expf(-x)); }
__device__ __forceinline__ float siluf_(float x) { return x / (1.f + __expf(-x)); }

__host__ __device__ inline int src_in(int n) {
    if (n < 8192) return n;
    if (n < 10240) return n - 8192 + 9280;
    if (n < 12288) return n - 10240 + 11328;
    if (n < 12800) return n - 12288 + 8192;
    if (n < 13312) return n - 12800 + 8704;
    if (n < 13376) { const int i = n - 13312; return 9216 + 32 * (i & 1) + (i >> 1); }
    return -1;
}
__host__ __device__ inline int src_uq(int n) {
    if (n < 2048) return (n >> 7) * 192 + (n & 127);
    const int m = n - 2048, h = m >> 6, i = m & 63; return h * 192 + 128 + 32 * (i & 1) + (i >> 1);
}
__host__ __device__ inline int src_gu(int n) { const int t = n >> 8, r = n & 255; return r < 128 ? 128 * t + r : 5632 + 128 * t + (r - 128); }
__host__ __device__ inline int src_id(int n) { return n; }

namespace pg8 {
#define PG8_LAS __attribute__((address_space(3)))
typedef unsigned short bf16_t;
typedef short bf16x8 __attribute__((ext_vector_type(8)));
typedef float f32x4 __attribute__((ext_vector_type(4)));
typedef unsigned u32x4 __attribute__((ext_vector_type(4)));
constexpr int BM = 256, BK = 64, HALF = 128, HTB = HALF * BK * 2  , STAGE_BYTES = 8 * HTB, NXCD = 8, WGM = 8;

__host__ __device__ __forceinline__ int lds_byte(int r, int c) { const int st = (r >> 4) * 2 + (c >> 5), rr = r & 15, cc = c & 31, ob = rr * 64 + cc * 2; return st * 1024 + (ob ^ (((ob >> 9) & 1) << 5)); }
__host__ __device__ __forceinline__ void stage_rc(int b, int& R, int& C) { const int st = b / 1024, sb = b % 1024, swz = sb ^ (((sb >> 9) & 1) << 5); R = (st >> 1) * 16 + swz / 64; C = (st & 1) * 32 + (swz % 64) / 2; }
__host__ __device__ __forceinline__ int perm32(int rho) { const int n = rho >> 4, i = rho & 15; return 8 * (i >> 2) + 4 * n + (i & 3); }

struct Unit { int pm, pn; };
struct Gemm { const bf16_t* A; const bf16_t* Bt; int M, N, K; };

struct StaticOrder {
    int nM, nN, nwg, G, c;
    __host__ __device__ void init(int M, int N, int G_, int c_) { nM = M / BM; nN = N / BM; nwg = nM * nN; G = G_; c = c_; }
    __host__ __device__ bool next(int i, Unit& u) const {
        const long L = (long)i * G + c; if (L >= nwg) return false;
        int wgid = (int)L; { const int q = nwg / NXCD, r = nwg % NXCD, xcd = wgid % NXCD, off = wgid / NXCD; wgid = (xcd < r ? xcd * (q + 1) : r * (q + 1) + (xcd - r) * q) + off; }
        const int nig = WGM * nN, gid = wgid / nig, fm = gid * WGM, gsz = (nM - fm) < WGM ? (nM - fm) : WGM;
        u.pm = fm + ((wgid % nig) % gsz); u.pn = (wgid % nig) / gsz; return true;
    }
    __device__ __forceinline__ void a_ready(const Unit&) const {}
    __device__ __forceinline__ void done(const Unit&) const {}
};

__device__ __forceinline__ unsigned cvt_pk_bf16(float lo, float hi) { unsigned r; asm volatile("v_cvt_pk_bf16_f32 %0, %1, %2" : "=v"(r) : "v"(lo), "v"(hi)); return r; }
__device__ __forceinline__ float sigm(float x) { return __builtin_amdgcn_rcpf(1.f + __expf(-x)); }
__device__ __forceinline__ unsigned cvt_pk_f16(float lo, float hi) { typedef _Float16 h2v __attribute__((ext_vector_type(2))); h2v v = {(_Float16)lo, (_Float16)hi}; return __builtin_bit_cast(unsigned, v); }
__device__ __forceinline__ u32x4 pack_bf16x8(f32x4 a, f32x4 b) { u32x4 w; w.x = cvt_pk_bf16(a[0], a[1]); w.y = cvt_pk_bf16(a[2], a[3]); w.z = cvt_pk_bf16(b[0], b[1]); w.w = cvt_pk_bf16(b[2], b[3]); return w; }
__device__ __forceinline__ void unpack_bf16x8(u32x4 w, f32x4& a, f32x4& b) {
    a[0] = __uint_as_float(w.x << 16); a[1] = __uint_as_float(w.x & 0xffff0000u); a[2] = __uint_as_float(w.y << 16); a[3] = __uint_as_float(w.y & 0xffff0000u);
    b[0] = __uint_as_float(w.z << 16); b[1] = __uint_as_float(w.z & 0xffff0000u); b[2] = __uint_as_float(w.w << 16); b[3] = __uint_as_float(w.w & 0xffff0000u); }
__device__ __forceinline__ float sumsq8(f32x4 a, f32x4 b) { return ((a[0] * a[0] + a[1] * a[1]) + (a[2] * a[2] + a[3] * a[3])) + ((b[0] * b[0] + b[1] * b[1]) + (b[2] * b[2] + b[3] * b[3])); }

struct EpiIn {
    static constexpr bool PERM = true, AFTER_DRAIN = false;
    unsigned short *qh, *g16, *v, *og, *sa, *sb, *cq, *ckv, *kr; const float *lb, *rope; float *ssq, *sskv;
    template <int MODE> __device__ __forceinline__ void seg(const f32x4 (&acc)[2][2][4][2], unsigned short* base, int row0, int colb) const {
        f32x4 l0[2], l1[2];
        if (MODE == 3) {
#pragma unroll
            for (int bj = 0; bj < 2; ++bj) { l0[bj] = *(const f32x4*)(lb + colb + bj * HALF); l1[bj] = *(const f32x4*)(lb + colb + bj * HALF + 4); } }
#pragma unroll
        for (int ai = 0; ai < 2; ++ai)
#pragma unroll
            for (int m = 0; m < 4; ++m) { unsigned short* rowp = base + (size_t)(row0 + ai * HALF + m * 16) * 2048 + colb;
#pragma unroll
                for (int bj = 0; bj < 2; ++bj) { f32x4 a = acc[ai][bj][m][0], b = acc[ai][bj][m][1]; u32x4 w;
                    if (MODE == 1) {
#pragma unroll
                        for (int e = 0; e < 4; ++e) { a[e] = a[e] * sigm(a[e]); b[e] = b[e] * sigm(b[e]); } }
                    if (MODE == 2) {
#pragma unroll
                        for (int e = 0; e < 4; ++e) { a[e] = sigm(a[e]); b[e] = sigm(b[e]); } }
                    if (MODE == 3) {
#pragma unroll
                        for (int e = 0; e < 4; ++e) { a[e] = __logf(l0[bj][e] + (1.f - l0[bj][e]) * sigm(a[e])); b[e] = __logf(l1[bj][e] + (1.f - l1[bj][e]) * sigm(b[e])); }
                        w.x = cvt_pk_f16(a[0], a[1]); w.y = cvt_pk_f16(a[2], a[3]); w.z = cvt_pk_f16(b[0], b[1]); w.w = cvt_pk_f16(b[2], b[3]); }
                    else w = pack_bf16x8(a, b);
                    *(u32x4*)(rowp + bj * HALF) = w; } }
    }
    __device__ __forceinline__ void operator()(const f32x4 (&acc)[2][2][4][2], const Unit& u, int wr, int wc, int fr, int fq) const {
        const int row0 = u.pm * BM + wr * 64 + fr, pn = u.pn, cw = wc * 32 + 8 * fq;
        if (pn < 48) { const int sg = pn >> 3, colb = (pn & 7) * 256 + cw;
            if (sg == 0) seg<1>(acc, qh, row0, colb); else if (sg == 1) seg<3>(acc, g16, row0, colb); else if (sg == 2) seg<0>(acc, v, row0, colb);
            else if (sg == 3) seg<1>(acc, og, row0, colb); else if (sg == 4) seg<2>(acc, sa, row0, colb); else seg<2>(acc, sb, row0, colb); }
        else if (pn < 52) { unsigned short* base = pn < 50 ? cq : ckv; float* ss = pn < 50 ? ssq : sskv; const int colb = (pn & 1) * 256 + cw, slot = (pn & 1) * 4 + wc;
#pragma unroll
            for (int ai = 0; ai < 2; ++ai)
#pragma unroll
                for (int m = 0; m < 4; ++m) { const int row = row0 + ai * HALF + m * 16; unsigned short* rowp = base + (size_t)row * 512 + colb; float s = 0.f;
#pragma unroll
                    for (int bj = 0; bj < 2; ++bj) { const f32x4 a = acc[ai][bj][m][0], b = acc[ai][bj][m][1]; s += sumsq8(a, b); *(u32x4*)(rowp + bj * HALF) = pack_bf16x8(a, b); }
                    s += __shfl_xor(s, 16); s += __shfl_xor(s, 32);
                    if (fq == 0) ss[(size_t)row * 8 + slot] = s; } }
        else if (wc < 2) {
#pragma unroll
            for (int ai = 0; ai < 2; ++ai)
#pragma unroll
                for (int m = 0; m < 4; ++m) { const int row = row0 + ai * HALF + m * 16; const float* rp = rope + ((size_t)row * 32 + 16 * wc + 4 * fq) * 2;
                    const f32x4 c0 = *(const f32x4*)rp, c1 = *(const f32x4*)(rp + 4); const f32x4 a = acc[ai][0][m][0], b = acc[ai][0][m][1]; f32x4 oa, ob;
                    oa[0] = a[0] * c0[0] - a[1] * c0[1]; oa[1] = a[1] * c0[0] + a[0] * c0[1]; oa[2] = a[2] * c0[2] - a[3] * c0[3]; oa[3] = a[3] * c0[2] + a[2] * c0[3];
                    ob[0] = b[0] * c1[0] - b[1] * c1[1]; ob[1] = b[1] * c1[0] + b[0] * c1[1]; ob[2] = b[2] * c1[2] - b[3] * c1[3]; ob[3] = b[3] * c1[2] + b[2] * c1[3];
                    *(u32x4*)(kr + (size_t)row * 64 + cw) = pack_bf16x8(oa, ob); } }
    }
};
struct EpiUq {
    static constexpr bool PERM = true, AFTER_DRAIN = false;
    unsigned short *qn, *qr; const float *ssq, *rope; float qscale, eps;
    __device__ __forceinline__ void operator()(const f32x4 (&acc)[2][2][4][2], const Unit& u, int wr, int wc, int fr, int fq) const {
        const int row0 = u.pm * BM + wr * 64 + fr, pn = u.pn, cw = wc * 32 + 8 * fq;
#pragma unroll
        for (int ai = 0; ai < 2; ++ai)
#pragma unroll
            for (int m = 0; m < 4; ++m) { const int row = row0 + ai * HALF + m * 16;
                const f32x4 p0 = *(const f32x4*)(ssq + (size_t)row * 8), p1 = *(const f32x4*)(ssq + (size_t)row * 8 + 4);
                const float rs = __builtin_amdgcn_rsqf((((p0[0] + p0[1]) + (p0[2] + p0[3])) + ((p1[0] + p1[1]) + (p1[2] + p1[3]))) * (1.f / 512.f) + eps) * qscale;
                if (pn < 8) { unsigned short* rowp = qn + (size_t)row * 2048 + pn * 256 + cw;
#pragma unroll
                    for (int bj = 0; bj < 2; ++bj) *(u32x4*)(rowp + bj * HALF) = pack_bf16x8(acc[ai][bj][m][0] * rs, acc[ai][bj][m][1] * rs); }
                else { unsigned short* rowp = qr + (size_t)row * 1024 + (pn - 8) * 256 + cw; const float* rp = rope + ((size_t)row * 32 + 16 * (wc & 1) + 4 * fq) * 2;
                    const f32x4 c0 = *(const f32x4*)rp, c1 = *(const f32x4*)(rp + 4);
#pragma unroll
                    for (int bj = 0; bj < 2; ++bj) { const f32x4 a = acc[ai][bj][m][0] * rs, b = acc[ai][bj][m][1] * rs; f32x4 oa, ob;
                        oa[0] = a[0] * c0[0] - a[1] * c0[1]; oa[1] = a[1] * c0[0] + a[0] * c0[1]; oa[2] = a[2] * c0[2] - a[3] * c0[3]; oa[3] = a[3] * c0[2] + a[2] * c0[3];
                        ob[0] = b[0] * c1[0] - b[1] * c1[1]; ob[1] = b[1] * c1[0] + b[0] * c1[1]; ob[2] = b[2] * c1[2] - b[3] * c1[3]; ob[3] = b[3] * c1[2] + b[2] * c1[3];
                        *(u32x4*)(rowp + bj * HALF) = pack_bf16x8(oa, ob); } } }
    }
};
struct EpiUkv {
    static constexpr bool PERM = true, AFTER_DRAIN = false;
    unsigned short *kn, *vm; const float* sskv; float eps;
    __device__ __forceinline__ void operator()(const f32x4 (&acc)[2][2][4][2], const Unit& u, int wr, int wc, int fr, int fq) const {
        const int row0 = u.pm * BM + wr * 64 + fr, colb = u.pn * 128 + wc * 32 + 8 * fq;
#pragma unroll
        for (int ai = 0; ai < 2; ++ai)
#pragma unroll
            for (int m = 0; m < 4; ++m) { const int row = row0 + ai * HALF + m * 16;
                const f32x4 p0 = *(const f32x4*)(sskv + (size_t)row * 8), p1 = *(const f32x4*)(sskv + (size_t)row * 8 + 4);
                const float rs = __builtin_amdgcn_rsqf((((p0[0] + p0[1]) + (p0[2] + p0[3])) + ((p1[0] + p1[1]) + (p1[2] + p1[3]))) * (1.f / 512.f) + eps);
                *(u32x4*)(kn + (size_t)row * 2048 + colb) = pack_bf16x8(acc[ai][0][m][0] * rs, acc[ai][0][m][1] * rs);
                *(u32x4*)(vm + (size_t)row * 2048 + colb) = pack_bf16x8(acc[ai][1][m][0] * rs, acc[ai][1][m][1] * rs); }
    }
};
struct EpiYa {
    static constexpr bool PERM = true, AFTER_DRAIN = false;
    unsigned short* yas; const unsigned short* sa;
    __device__ __forceinline__ void operator()(const f32x4 (&acc)[2][2][4][2], const Unit& u, int wr, int wc, int fr, int fq) const {
        const int row0 = u.pm * BM + wr * 64 + fr, colb = u.pn * 256 + wc * 32 + 8 * fq;
#pragma unroll
        for (int ai = 0; ai < 2; ++ai)
#pragma unroll
            for (int m = 0; m < 4; ++m) { const size_t off = (size_t)(row0 + ai * HALF + m * 16) * 2048 + colb;
#pragma unroll
                for (int bj = 0; bj < 2; ++bj) { f32x4 ga, gb; unpack_bf16x8(*(const u32x4*)(sa + off + bj * HALF), ga, gb);
                    *(u32x4*)(yas + off + bj * HALF) = pack_bf16x8(acc[ai][bj][m][0] * ga, acc[ai][bj][m][1] * gb); } }
    }
};
struct EpiYb {
    static constexpr bool PERM = true, AFTER_DRAIN = false;
    const unsigned short* yas; const unsigned short* sb; unsigned short* merged;
    __device__ __forceinline__ void operator()(const f32x4 (&acc)[2][2][4][2], const Unit& u, int wr, int wc, int fr, int fq) const {
        const int row0 = u.pm * BM + wr * 64 + fr, colb = u.pn * 256 + wc * 32 + 8 * fq;
#pragma unroll
        for (int ai = 0; ai < 2; ++ai)
#pragma unroll
            for (int m = 0; m < 4; ++m) { const size_t off = (size_t)(row0 + ai * HALF + m * 16) * 2048 + colb;
#pragma unroll
                for (int bj = 0; bj < 2; ++bj) { f32x4 ga, gb, y0, y1; unpack_bf16x8(*(const u32x4*)(sb + off + bj * HALF), ga, gb); unpack_bf16x8(*(const u32x4*)(yas + off + bj * HALF), y0, y1);
                    *(u32x4*)(merged + off + bj * HALF) = pack_bf16x8(y0 + acc[ai][bj][m][0] * ga, y1 + acc[ai][bj][m][1] * gb); } }
    }
};
struct EpiF32SS {
    static constexpr bool PERM = true, AFTER_DRAIN = false;
    unsigned short* y; float* ss;
    __device__ __forceinline__ void operator()(const f32x4 (&acc)[2][2][4][2], const Unit& u, int wr, int wc, int fr, int fq) const {
        const int row0 = u.pm * BM + wr * 64 + fr, colb = u.pn * 256 + wc * 32 + 8 * fq, slot = u.pn * 4 + wc;
#pragma unroll
        for (int ai = 0; ai < 2; ++ai)
#pragma unroll
            for (int m = 0; m < 4; ++m) { const int row = row0 + ai * HALF + m * 16; const size_t off = (size_t)row * 2048 + colb; float s = 0.f;
#pragma unroll
                for (int bj = 0; bj < 2; ++bj) { const f32x4 a = acc[ai][bj][m][0], b = acc[ai][bj][m][1]; s += sumsq8(a, b); *(u32x4*)(y + off + bj * HALF) = pack_bf16x8(a, b); }
                s += __shfl_xor(s, 16); s += __shfl_xor(s, 32);
                if (fq == 0) ss[(size_t)row * 32 + slot] = s; }
    }
};
struct EpiGu {
    static constexpr bool PERM = true, AFTER_DRAIN = false;
    unsigned short* act; int ldc;
    __device__ __forceinline__ void operator()(const f32x4 (&acc)[2][2][4][2], const Unit& u, int wr, int wc, int fr, int fq) const {
        const int row0 = u.pm * BM + wr * 64 + fr, colb = u.pn * 128 + wc * 32 + 8 * fq;
#pragma unroll
        for (int ai = 0; ai < 2; ++ai)
#pragma unroll
            for (int m = 0; m < 4; ++m) { f32x4 a = acc[ai][0][m][0], b = acc[ai][0][m][1];
#pragma unroll
                for (int e = 0; e < 4; ++e) { a[e] = a[e] * sigm(a[e]) * acc[ai][1][m][0][e]; b[e] = b[e] * sigm(b[e]) * acc[ai][1][m][1][e]; }
                *(u32x4*)(act + (size_t)(row0 + ai * HALF + m * 16) * ldc + colb) = pack_bf16x8(a, b); }
    }
};
struct RowStatX {
    float* ss; unsigned* cnt; unsigned* tmo; float inv_n, eps;
    __device__ __forceinline__ void run(const float (&s)[2][4], float (&rstd)[2][4], const Unit& u, int wr, int wc, int fr, int fq, PG8_LAS unsigned char* lds, int wid, int lane) const {
        const int row0 = u.pm * BM + wr * 64 + fr, slot = u.pn * 4 + wc;
        if (fq == 0) {
#pragma unroll
            for (int ai = 0; ai < 2; ++ai)
#pragma unroll
                for (int m = 0; m < 4; ++m) __hip_atomic_store(ss + (size_t)(row0 + ai * HALF + m * 16) * 32 + slot, s[ai][m], __ATOMIC_RELAXED, __HIP_MEMORY_SCOPE_AGENT); }
        asm volatile("s_waitcnt vmcnt(0)" ::: "memory");
        if (lane == 0) __hip_atomic_fetch_add(cnt + 64 * u.pm, 1u, __ATOMIC_RELAXED, __HIP_MEMORY_SCOPE_AGENT);
        if (wid == 0) {
            const unsigned long long t0 = __builtin_amdgcn_s_memrealtime();
            for (;;) {
                if ((unsigned)__builtin_amdgcn_readfirstlane(__hip_atomic_load(cnt + 64 * u.pm, __ATOMIC_RELAXED, __HIP_MEMORY_SCOPE_AGENT)) >= 64u) break;
                if (__builtin_amdgcn_s_memrealtime() - t0 > 2000000ull) { if (lane == 0) __hip_atomic_store(tmo, 1u, __ATOMIC_RELAXED, __HIP_MEMORY_SCOPE_AGENT); break; }
                __builtin_amdgcn_s_sleep(2);
            }
            __builtin_amdgcn_fence(__ATOMIC_ACQUIRE, "agent");
        }
        asm volatile("s_waitcnt vmcnt(0) lgkmcnt(0)" ::: "memory"); __builtin_amdgcn_s_barrier(); asm volatile("" ::: "memory");
#pragma unroll
        for (int ai = 0; ai < 2; ++ai)
#pragma unroll
            for (int m = 0; m < 4; ++m) { const float* p = ss + (size_t)(row0 + ai * HALF + m * 16) * 32; float t = 0.f;
#pragma unroll
                for (int q = 0; q < 8; ++q) { const f32x4 x = *(const f32x4*)(p + 4 * q); t += (x[0] + x[1]) + (x[2] + x[3]); }
                rstd[ai][m] = __builtin_amdgcn_rsqf(t * inv_n + eps); }
    }
};
__device__ __forceinline__ void row_partials(const f32x4 (&acc)[2][2][4][2], float (&s)[2][4]) {
#pragma unroll
    for (int ai = 0; ai < 2; ++ai)
#pragma unroll
        for (int m = 0; m < 4; ++m) { float t = sumsq8(acc[ai][0][m][0], acc[ai][0][m][1]) + sumsq8(acc[ai][1][m][0], acc[ai][1][m][1]); t += __shfl_xor(t, 16); t += __shfl_xor(t, 32); s[ai][m] = t; }
}
struct EpiRmsResOut {
    static constexpr bool PERM = true, AFTER_DRAIN = true;
    float* out; const float* ga; const float* g; RowStatX st;
    __device__ __forceinline__ void fused(f32x4 (&acc)[2][2][4][2], const Unit& u, int wr, int wc, int fr, int fq, PG8_LAS unsigned char* lds, int wid, int lane) const {
        float s[2][4], rstd[2][4]; row_partials(acc, s);
        st.run(s, rstd, u, wr, wc, fr, fq, lds, wid, lane);
        const int row0 = u.pm * BM + wr * 64 + fr, colb = u.pn * 256 + wc * 32 + 8 * fq;
        f32x4 cv[2][2];
#pragma unroll
        for (int bj = 0; bj < 2; ++bj)
#pragma unroll
            for (int n = 0; n < 2; ++n) cv[bj][n] = *(const f32x4*)(ga + colb + bj * HALF + 4 * n) * *(const f32x4*)(g + colb + bj * HALF + 4 * n);
#pragma unroll
        for (int ai = 0; ai < 2; ++ai)
#pragma unroll
            for (int m = 0; m < 4; ++m) { float* rowp = out + (size_t)(row0 + ai * HALF + m * 16) * 2048 + colb;
#pragma unroll
                for (int bj = 0; bj < 2; ++bj)
#pragma unroll
                    for (int n = 0; n < 2; ++n) { f32x4* p = (f32x4*)(rowp + bj * HALF + 4 * n); *p = *p + cv[bj][n] * (acc[ai][bj][m][n] * rstd[ai][m]); }
                if (m & 1) asm volatile("" ::: "memory"); }
    }
};
struct EpiRmsResRms {
    static constexpr bool PERM = true, AFTER_DRAIN = true;
    const float* x; float* out; unsigned short* h2; const float *ga, *g1, *g2, *sc, *sh; RowStatX st1, st2;
    __device__ __forceinline__ void fused(f32x4 (&acc)[2][2][4][2], const Unit& u, int wr, int wc, int fr, int fq, PG8_LAS unsigned char* lds, int wid, int lane) const {
        float s[2][4], rstd[2][4]; row_partials(acc, s);
        st1.run(s, rstd, u, wr, wc, fr, fq, lds, wid, lane);
        const int row0 = u.pm * BM + wr * 64 + fr, colb = u.pn * 256 + wc * 32 + 8 * fq;
        { f32x4 cv[2][2];
#pragma unroll
          for (int bj = 0; bj < 2; ++bj)
#pragma unroll
              for (int n = 0; n < 2; ++n) cv[bj][n] = *(const f32x4*)(ga + colb + bj * HALF + 4 * n) * *(const f32x4*)(g1 + colb + bj * HALF + 4 * n);
#pragma unroll
          for (int ai = 0; ai < 2; ++ai)
#pragma unroll
              for (int m = 0; m < 4; ++m) { const size_t off = (size_t)(row0 + ai * HALF + m * 16) * 2048 + colb;
#pragma unroll
                  for (int bj = 0; bj < 2; ++bj)
#pragma unroll
                      for (int n = 0; n < 2; ++n) { const f32x4 xv = *(const f32x4*)(x + off + bj * HALF + 4 * n); const f32x4 r = xv + cv[bj][n] * (acc[ai][bj][m][n] * rstd[ai][m]);
                          acc[ai][bj][m][n] = r; *(f32x4*)(out + off + bj * HALF + 4 * n) = r; }
                  asm volatile("" : "+v"(acc[ai][0][m][0]), "+v"(acc[ai][0][m][1]), "+v"(acc[ai][1][m][0]), "+v"(acc[ai][1][m][1]));
                  if (m & 1) asm volatile("" ::: "memory"); } }
        row_partials(acc, s);
        st2.run(s, rstd, u, wr, wc, fr, fq, lds, wid, lane);
        f32x4 c2[2][2], sv[2][2];
#pragma unroll
        for (int bj = 0; bj < 2; ++bj)
#pragma unroll
            for (int n = 0; n < 2; ++n) { c2[bj][n] = *(const f32x4*)(g2 + colb + bj * HALF + 4 * n) * (*(const f32x4*)(sc + colb + bj * HALF + 4 * n) + 1.f); sv[bj][n] = *(const f32x4*)(sh + colb + bj * HALF + 4 * n); }
#pragma unroll
        for (int ai = 0; ai < 2; ++ai)
#pragma unroll
            for (int m = 0; m < 4; ++m) { unsigned short* rowp = h2 + (size_t)(row0 + ai * HALF + m * 16) * 2048 + colb;
#pragma unroll
                for (int bj = 0; bj < 2; ++bj) *(u32x4*)(rowp + bj * HALF) = pack_bf16x8(acc[ai][bj][m][0] * rstd[ai][m] * c2[bj][0] + sv[bj][0], acc[ai][bj][m][1] * rstd[ai][m] * c2[bj][1] + sv[bj][1]); }
    }
};
template <class Epi, class Sched, bool ALIGN_EPI = false, bool SP2 = false>
__device__ __forceinline__ void gemm_phase(PG8_LAS unsigned char* lds, const Gemm g, const Sched& S, const Epi& E) {
    const int tid = threadIdx.x, wid = __builtin_amdgcn_readfirstlane(tid >> 6), lane = tid & 63, wr = wid >> 2, wc = wid & 3, fr = lane & 15, fq = lane >> 4;
    const int K = g.K, nt = K / BK;
    unsigned voffA[2], voffB[2];
#pragma unroll
    for (int i = 0; i < 2; ++i) { int R, C; stage_rc(tid * 16 + i * 8192, R, C); const int Rb = Epi::PERM ? ((R & ~31) + perm32(R & 31)) : R;
        voffA[i] = (unsigned)(R * K + C) * 2u; voffB[i] = (unsigned)(Rb * K + C) * 2u; }
    const size_t kstep = (size_t)(BK * 2);
    const size_t hstep = (size_t)HALF * K * 2;
    const size_t tstep = 2 * hstep;
    const unsigned ldsw = (unsigned)wid * 1024u;
    const int aoff = lds_byte(wr * 64 + fr, fq * 8), boff = lds_byte(wc * 32 + fr, fq * 8);
#define PG8_SA(b, h) (((b) * 2 + (h)) * HTB)
#define PG8_SB(b, h) ((4 + (b) * 2 + (h)) * HTB)
#define PG8_STAGE(bufoff, gbase, voff) do { _Pragma("unroll") for (int _i = 0; _i < 2; ++_i) \
        __builtin_amdgcn_global_load_lds((const unsigned*)((const char*)(gbase) + (voff)[_i]), (PG8_LAS unsigned*)(lds + (bufoff) + ldsw + _i * 8192), 16, 0, 0); } while (0)
#define PG8_LDA(dst, b, h) do { _Pragma("unroll") for (int m = 0; m < 4; ++m) _Pragma("unroll") for (int k = 0; k < 2; ++k) dst[m][k] = *(const PG8_LAS bf16x8*)(lds + PG8_SA(b, h) + aoff + m * 2048 + k * 1024); } while (0)
#define PG8_LDB(dst, b, h) do { _Pragma("unroll") for (int n = 0; n < 2; ++n) _Pragma("unroll") for (int k = 0; k < 2; ++k) dst[n][k] = *(const PG8_LAS bf16x8*)(lds + PG8_SB(b, h) + boff + n * 2048 + k * 1024); } while (0)
#define PG8_MMA(ai, bj, At, Bt) do { __builtin_amdgcn_s_setprio(1); _Pragma("unroll") for (int m = 0; m < 4; ++m) _Pragma("unroll") for (int n = 0; n < 2; ++n) _Pragma("unroll") for (int k = 0; k < 2; ++k) \
        acc[ai][bj][m][n] = __builtin_amdgcn_mfma_f32_16x16x32_bf16(Bt[n][k], At[m][k], acc[ai][bj][m][n], 0, 0, 0); __builtin_amdgcn_s_setprio(0); } while (0)
#define PG8_WAIT_V(n) asm volatile("s_waitcnt vmcnt(" #n ")" ::: "memory")
#define PG8_WAIT_L(n) asm volatile("s_waitcnt lgkmcnt(" #n ")" ::: "memory")
#define PG8_BAR __builtin_amdgcn_s_barrier()
#define PG8_SCHED __builtin_amdgcn_sched_barrier(0)
    Unit cur, nxt; int ui = 0;
    if (!S.next(0, cur)) return;
    f32x4 acc[2][2][4][2];
#pragma unroll
    for (int a = 0; a < 2; ++a)
#pragma unroll
        for (int b = 0; b < 2; ++b)
#pragma unroll
            for (int m = 0; m < 4; ++m)
#pragma unroll
                for (int n = 0; n < 2; ++n) acc[a][b][m][n] = (f32x4){0.f, 0.f, 0.f, 0.f};
    bf16x8 At[4][2], B0[2][2], B1[2][2];
    const char* cA = (const char*)g.A + (size_t)cur.pm * tstep; const char* cB = (const char*)g.Bt + (size_t)cur.pn * tstep;
    S.a_ready(cur);
    if constexpr (SP2) {
        PG8_STAGE(PG8_SB(0, 0), cB, voffB); PG8_STAGE(PG8_SB(0, 1), cB + hstep, voffB); PG8_STAGE(PG8_SA(0, 0), cA, voffA); PG8_STAGE(PG8_SA(0, 1), cA + hstep, voffA);
        if (wr == 1) PG8_BAR;
        PG8_WAIT_V(2); PG8_BAR;
        PG8_STAGE(PG8_SB(1, 0), cB + kstep, voffB); PG8_STAGE(PG8_SA(1, 0), cA + kstep, voffA); PG8_STAGE(PG8_SB(1, 1), cB + hstep + kstep, voffB);
        PG8_WAIT_V(6); PG8_BAR;
    } else {
        PG8_STAGE(PG8_SB(0, 0), cB, voffB); PG8_STAGE(PG8_SA(0, 0), cA, voffA); PG8_STAGE(PG8_SB(0, 1), cB + hstep, voffB); PG8_STAGE(PG8_SA(0, 1), cA + hstep, voffA);
        if (wr == 1) PG8_BAR;
        PG8_WAIT_V(4); PG8_BAR;
        PG8_STAGE(PG8_SB(1, 0), cB + kstep, voffB); PG8_STAGE(PG8_SA(1, 0), cA + kstep, voffA); PG8_STAGE(PG8_SB(1, 1), cB + hstep + kstep, voffB);
        PG8_WAIT_V(6); PG8_BAR;
    }
    for (;;) {
        const bool has_next = S.next(ui + 1, nxt);
        const char* nA = has_next ? (const char*)g.A + (size_t)nxt.pm * tstep : cA; const char* nB = has_next ? (const char*)g.Bt + (size_t)nxt.pn * tstep : cB;
        for (int t = 0; t < nt; t += 2) {
            const bool last = (t == nt - 2);
            const char* a1 = cA + (size_t)(t + 1) * kstep;
            const char* a2 = last ? nA : cA + (size_t)(t + 2) * kstep; const char* b2 = last ? nB : cB + (size_t)(t + 2) * kstep;
            const char* a3 = a2 + kstep; const char* b3 = b2 + kstep;
            if (last && has_next) S.a_ready(nxt);
            if constexpr (SP2) {
            PG8_LDB(B0, 0, 0); PG8_LDB(B1, 0, 1); PG8_SCHED; PG8_LDA(At, 0, 0); PG8_STAGE(PG8_SA(1, 1), a1 + hstep, voffA);
            PG8_WAIT_V(8); PG8_WAIT_L(0); PG8_BAR; PG8_MMA(0, 0, At, B0); PG8_MMA(0, 1, At, B1); PG8_BAR; PG8_SCHED;
            PG8_LDA(At, 0, 1); PG8_STAGE(PG8_SB(0, 0), b2, voffB); PG8_STAGE(PG8_SB(0, 1), b2 + hstep, voffB); PG8_STAGE(PG8_SA(0, 0), a2, voffA);
            PG8_WAIT_V(8); PG8_WAIT_L(0); PG8_BAR; PG8_MMA(1, 0, At, B0); PG8_MMA(1, 1, At, B1); PG8_BAR; PG8_SCHED;
            PG8_LDB(B0, 1, 0); PG8_LDB(B1, 1, 1); PG8_SCHED; PG8_LDA(At, 1, 0); PG8_STAGE(PG8_SA(0, 1), a2 + hstep, voffA);
            PG8_WAIT_V(8); PG8_WAIT_L(0); PG8_BAR; PG8_MMA(0, 0, At, B0); PG8_MMA(0, 1, At, B1); PG8_BAR; PG8_SCHED;
            PG8_LDA(At, 1, 1); PG8_STAGE(PG8_SB(1, 0), b3, voffB); PG8_STAGE(PG8_SB(1, 1), b3 + hstep, voffB); PG8_STAGE(PG8_SA(1, 0), a3, voffA);
            PG8_WAIT_V(8); PG8_WAIT_L(0); PG8_BAR; PG8_MMA(1, 0, At, B0); PG8_MMA(1, 1, At, B1); PG8_BAR; PG8_SCHED;
            } else {
            PG8_LDB(B0, 0, 0); PG8_SCHED; PG8_LDA(At, 0, 0); PG8_STAGE(PG8_SA(1, 1), a1 + hstep, voffA);
            PG8_WAIT_L(8); PG8_BAR; PG8_WAIT_L(0); PG8_MMA(0, 0, At, B0); PG8_BAR; PG8_SCHED;
            PG8_LDB(B1, 0, 1); PG8_STAGE(PG8_SB(0, 0), b2, voffB);
            PG8_BAR; PG8_WAIT_L(0); PG8_MMA(0, 1, At, B1); PG8_BAR;
            PG8_LDA(At, 0, 1); PG8_STAGE(PG8_SA(0, 0), a2, voffA);
            PG8_BAR; PG8_WAIT_L(0); PG8_MMA(1, 0, At, B0); PG8_BAR; PG8_SCHED;
            PG8_STAGE(PG8_SB(0, 1), b2 + hstep, voffB);
            PG8_WAIT_V(6); PG8_BAR; PG8_MMA(1, 1, At, B1); PG8_BAR;
            PG8_LDB(B0, 1, 0); PG8_SCHED; PG8_LDA(At, 1, 0); PG8_STAGE(PG8_SA(0, 1), a2 + hstep, voffA);
            PG8_WAIT_L(8); PG8_BAR; PG8_WAIT_L(0); PG8_MMA(0, 0, At, B0); PG8_BAR; PG8_SCHED;
            PG8_LDB(B1, 1, 1); PG8_STAGE(PG8_SB(1, 0), b3, voffB);
            PG8_BAR; PG8_WAIT_L(0); PG8_MMA(0, 1, At, B1); PG8_BAR;
            PG8_LDA(At, 1, 1); PG8_STAGE(PG8_SA(1, 0), a3, voffA);
            PG8_BAR; PG8_WAIT_L(0); PG8_MMA(1, 0, At, B0); PG8_BAR; PG8_SCHED;
            PG8_STAGE(PG8_SB(1, 1), b3 + hstep, voffB);
            PG8_WAIT_V(6); PG8_BAR; PG8_MMA(1, 1, At, B1); PG8_BAR;
            }
        }
        if constexpr (ALIGN_EPI) { if (wr == 0) PG8_BAR; }
        if constexpr (!Epi::AFTER_DRAIN) { E(acc, cur, wr, wc, fr, fq); S.done(cur); }
        if (!has_next) break;
#pragma unroll
        for (int a = 0; a < 2; ++a)
#pragma unroll
            for (int b = 0; b < 2; ++b)
#pragma unroll
                for (int m = 0; m < 4; ++m)
#pragma unroll
                    for (int n = 0; n < 2; ++n) acc[a][b][m][n] = (f32x4){0.f, 0.f, 0.f, 0.f};
        cur = nxt; cA = nA; cB = nB; ++ui;
        if constexpr (ALIGN_EPI) { if (wr == 1) PG8_BAR; }
    }
    PG8_WAIT_V(0);
    if constexpr (!ALIGN_EPI) { if (wr == 0) PG8_BAR; }
    PG8_BAR;
    if constexpr (Epi::AFTER_DRAIN) { E.fused(acc, cur, wr, wc, fr, fq, lds, wid, lane); S.done(cur); }
#undef PG8_SA
#undef PG8_SB
#undef PG8_STAGE
#undef PG8_LDA
#undef PG8_LDB
#undef PG8_MMA
#undef PG8_WAIT_V
#undef PG8_WAIT_L
#undef PG8_BAR
#undef PG8_SCHED
}
}
namespace att {
typedef short bf16x8 __attribute__((ext_vector_type(8)));
typedef short s16x4 __attribute__((ext_vector_type(4)));
typedef float f32x16 __attribute__((ext_vector_type(16)));
typedef unsigned u32x4 __attribute__((ext_vector_type(4)));
constexpr int NW = 8, QBLK = 32, KVBLK = 64, QB = NW * QBLK;
constexpr int SHM_V = KVBLK * 128 * 2, SHM_K = KVBLK * 128 * 2, SHM_R = KVBLK * 64 * 2;
constexpr int OFF_V = 0, OFF_K = 2 * SHM_V, OFF_R = OFF_K + 2 * SHM_K, OFF_WS = OFF_R + 2 * SHM_R, OFF_QR = OFF_WS + NW * 64 * 4, LDS_BYTES = OFF_QR + NW * 4096;
constexpr float THR2 = 11.5f;
constexpr int LDQ = 2048, LDR = 1024, LDK = 2048, LDKR = 64;
#define LAS3 __attribute__((address_space(3)))
#define KSWZ(row, colB) ((row) * 256 + ((colB) ^ (((row) & 15) << 4)))
#define SBAR() __builtin_amdgcn_sched_barrier(0)
__device__ __forceinline__ int v_st(int k, int c) { const int kk = (k & ~0xC) | ((k & 4) << 1) | ((k & 8) >> 1); return ((kk >> 3) * 4 + (c >> 5)) * 512 + ((kk & 7) * 32 + (c & 31)) * 2; }
__device__ __forceinline__ int v_rd_base(int lane) { return ((lane & 3) << 3) | (((lane >> 2) & 3) << 6) | (((lane >> 4) & 1) << 5) | (((lane >> 5) & 1) << 8); }
constexpr int v_rd_off(int d0, int ks, int half) { return d0 * 512 + ks * 4096 + half * 2048; }
__device__ __forceinline__ int crow(int r, int hi) { return (r & 3) + 8 * (r >> 2) + 4 * hi; }
__device__ __forceinline__ unsigned cvtpk(float lo, float hi) { unsigned r; asm volatile("v_cvt_pk_bf16_f32 %0, %1, %2" : "=v"(r) : "v"(lo), "v"(hi)); return r; }
__device__ __forceinline__ bf16x8 ld8(const bf16_t* p) { return *reinterpret_cast<const bf16x8*>(p); }
__device__ __forceinline__ void mask_tile(f32x16& p0, f32x16& p1, int dq) {
    const float NEG = -__builtin_inff();
#pragma unroll
    for (int r = 0; r < 16; ++r) { const int c = (r & 3) + 8 * (r >> 2); if (dq - c < 0) p0[r] = NEG; if (dq - c - 32 < 0) p1[r] = NEG; }
}
__device__ __forceinline__ void partialSM(f32x16& p0, f32x16& p1, float& m_reg, float& mn, float& alpha) {
    float pmax = p0[0]; for (int r = 1; r < 16; ++r) pmax = fmaxf(pmax, p0[r]); for (int r = 0; r < 16; ++r) pmax = fmaxf(pmax, p1[r]);
    { auto rr = __builtin_amdgcn_permlane32_swap(__float_as_uint(pmax), __float_as_uint(pmax), false, false); pmax = fmaxf(__uint_as_float(rr[0]), __uint_as_float(rr[1])); }
    if (__builtin_expect(__all((pmax - m_reg) <= THR2), 1)) { mn = m_reg; alpha = 1.f; }
    else { mn = fmaxf(m_reg, pmax); alpha = __builtin_amdgcn_exp2f(m_reg - mn); m_reg = mn; }
    for (int r = 0; r < 16; ++r) p0[r] = p0[r] - mn; for (int r = 0; r < 16; ++r) p1[r] = p1[r] - mn;
    for (int r = 0; r < 16; ++r) p0[r] = __builtin_amdgcn_exp2f(p0[r]);
}
__device__ __forceinline__ void finishSM(f32x16& p0, f32x16& p1, float alpha, float& l_reg, bf16x8& pa0, bf16x8& pa1, bf16x8& pa2, bf16x8& pa3) {
    for (int r = 0; r < 16; ++r) p1[r] = __builtin_amdgcn_exp2f(p1[r]);
    float ps = 0; for (int r = 0; r < 16; ++r) ps += p0[r]; for (int r = 0; r < 16; ++r) ps += p1[r];
    { auto rr = __builtin_amdgcn_permlane32_swap(__float_as_uint(ps), __float_as_uint(ps), false, false); ps = __uint_as_float(rr[0]) + __uint_as_float(rr[1]); }
    l_reg = l_reg * alpha + ps;
#define PK4(P, B_, OUT) do { unsigned a0 = cvtpk(P[B_+0], P[B_+1]), a1 = cvtpk(P[B_+2], P[B_+3]); unsigned b0 = cvtpk(P[B_+4], P[B_+5]), b1 = cvtpk(P[B_+6], P[B_+7]); \
        auto r0 = __builtin_amdgcn_permlane32_swap(a0, b0, false, false); auto r1 = __builtin_amdgcn_permlane32_swap(a1, b1, false, false); \
        u32x4 w = {r0[0], r1[0], r0[1], r1[1]}; OUT = *reinterpret_cast<bf16x8*>(&w); } while (0)
    PK4(p0, 0, pa0); PK4(p0, 8, pa1); PK4(p1, 0, pa2); PK4(p1, 8, pa3);
#undef PK4
}
template <int KB> __device__ __forceinline__ void qkt(f32x16& p0, f32x16& p1, const char* lds, int r32, int hi, const bf16x8* qr, const char* qrl) {
    p0 = f32x16{}; p1 = f32x16{};
#pragma unroll
    for (int d0 = 0; d0 < 8; ++d0) { const char* a = lds + OFF_K + KB * SHM_K + KSWZ(r32, (d0 * 16 + hi * 8) * 2);
        bf16x8 b0 = *reinterpret_cast<const bf16x8*>(a); bf16x8 b1 = *reinterpret_cast<const bf16x8*>(a + 32 * 256);
        p0 = __builtin_amdgcn_mfma_f32_32x32x16_bf16(b0, qr[d0], p0, 0, 0, 0); p1 = __builtin_amdgcn_mfma_f32_32x32x16_bf16(b1, qr[d0], p1, 0, 0, 0);
        if (d0 == 3 || d0 == 7) SBAR(); }
#pragma unroll
    for (int d0 = 0; d0 < 4; ++d0) { const char* a = lds + OFF_R + KB * SHM_R + d0 * 2048 + r32 * 32 + hi * 16;
        bf16x8 b0 = *reinterpret_cast<const bf16x8*>(a); bf16x8 b1 = *reinterpret_cast<const bf16x8*>(a + 1024);
        const bf16x8 qf = *reinterpret_cast<const bf16x8*>(qrl + d0 * 1024);
        p0 = __builtin_amdgcn_mfma_f32_32x32x16_bf16(b0, qf, p0, 0, 0, 0); p1 = __builtin_amdgcn_mfma_f32_32x32x16_bf16(b1, qf, p1, 0, 0, 0); }
}
template <int VB> __device__ __forceinline__ void pv_tile(f32x16* o, int vb0, bf16x8 pa0, bf16x8 pa1, bf16x8 pa2, bf16x8 pa3) {
#define TRRD(dst, off) asm volatile("ds_read_b64_tr_b16 %0, %1 offset:%2" : "=&v"(dst) : "v"(vb0), "i"(off) : "memory")
#define PV_D0(d0) do { s16x4 l0, l1, l2, l3, h0, h1, h2, h3; constexpr int b_ = OFF_V + VB * SHM_V + v_rd_off(d0, 0, 0); \
        TRRD(l0, b_); TRRD(h0, b_ + 2048); TRRD(l1, b_ + 4096); TRRD(h1, b_ + 6144); TRRD(l2, b_ + 8192); TRRD(h2, b_ + 10240); TRRD(l3, b_ + 12288); TRRD(h3, b_ + 14336); \
        asm volatile("s_waitcnt lgkmcnt(0)" ::: "memory"); SBAR(); \
        o[d0] = __builtin_amdgcn_mfma_f32_32x32x16_bf16(pa0, (bf16x8){l0[0], l0[1], l0[2], l0[3], h0[0], h0[1], h0[2], h0[3]}, o[d0], 0, 0, 0); \
        o[d0] = __builtin_amdgcn_mfma_f32_32x32x16_bf16(pa1, (bf16x8){l1[0], l1[1], l1[2], l1[3], h1[0], h1[1], h1[2], h1[3]}, o[d0], 0, 0, 0); \
        o[d0] = __builtin_amdgcn_mfma_f32_32x32x16_bf16(pa2, (bf16x8){l2[0], l2[1], l2[2], l2[3], h2[0], h2[1], h2[2], h2[3]}, o[d0], 0, 0, 0); \
        o[d0] = __builtin_amdgcn_mfma_f32_32x32x16_bf16(pa3, (bf16x8){l3[0], l3[1], l3[2], l3[3], h3[0], h3[1], h3[2], h3[3]}, o[d0], 0, 0, 0); } while (0)
    PV_D0(0); PV_D0(1); PV_D0(2); PV_D0(3);
#undef PV_D0
#undef TRRD
}
struct BlockRef { const bf16_t* Qn; const bf16_t* Qr; const bf16_t* K; const bf16_t* V; bf16_t* O; int P0; };
#define DMA16(src, dstoff) __builtin_amdgcn_global_load_lds((const unsigned*)(src), (LAS3 unsigned*)(lds3 + (dstoff)), 16, 0, 0)
#define DMA_K(t, bf) do { const bf16_t* s_ = Kh + (size_t)(t) * (KVBLK * LDK); DMA16(s_ + koff0, OFF_K + (bf) * SHM_K + wid * 2048); DMA16(s_ + koff1, OFF_K + (bf) * SHM_K + wid * 2048 + 1024); } while (0)
#define DMA_V(t, bf) do { const bf16_t* s_ = Vh + (size_t)(t) * (KVBLK * LDK); DMA16(s_ + voff0, OFF_V + (bf) * SHM_V + wid * 2048); DMA16(s_ + voff0 + 64, OFF_V + (bf) * SHM_V + wid * 2048 + 1024); } while (0)
#define DMA_R(t, bf) DMA16(KR + (size_t)(t) * (KVBLK * LDKR) + roff, OFF_R + (bf) * SHM_R + wid * 1024)
#define WAIT_BAR() asm volatile("s_waitcnt vmcnt(0) lgkmcnt(0)\n\ts_barrier" ::: "memory")
__device__ __forceinline__ void block(const BlockRef& cur, const bf16_t* KR, char* lds, LAS3 unsigned char* lds3) {
    const int tid = threadIdx.x, wid = __builtin_amdgcn_readfirstlane(tid >> 6), lane = tid & 63, r32 = lane & 31, hi = lane >> 5;
    const int NT = (cur.P0 + QB) / KVBLK;
    const int qlo = cur.P0 + wid * QBLK, qm = qlo + r32 - 4 * hi;
    float* ws = (float*)(lds + OFF_WS) + wid * 64; float* li_l = ws, * al_l = ws + 32;
    float m_reg = -1e30f, l_reg = 0; f32x16 o[4] = {};
    const int vb0 = (int)(uintptr_t)lds + v_rd_base(lane);
    char* qrl = lds + OFF_QR + wid * 4096 + lane * 16;
    const bf16_t* Kh = cur.K; const bf16_t* Vh = cur.V;
    const int kr0 = (wid & 1) * 8 + (lane >> 4), kr1 = kr0 + 4;
    const int koff0 = (wid * 8 + (lane >> 4)) * LDK + (((lane & 15) ^ kr0) << 3), koff1 = (wid * 8 + 4 + (lane >> 4)) * LDK + (((lane & 15) ^ kr1) << 3);
    const int vkk = wid * 8 + ((lane & 31) >> 2), vk = (vkk & ~0xC) | ((vkk & 4) << 1) | ((vkk & 8) >> 1);
    const int voff0 = vk * LDK + (lane >> 5) * 32 + (lane & 3) * 8;
    const int roff = ((wid & 1) * 32 + (lane >> 1)) * LDKR + (wid >> 1) * 16 + (lane & 1) * 8;
    bf16x8 qr[8];
#define RESC(a) do { if (__any((a) < 1.f)) { if (hi == 0) al_l[r32] = (a); asm volatile("s_waitcnt lgkmcnt(0)" ::: "memory"); \
                     for (int d_ = 0; d_ < 4; ++d_) for (int r = 0; r < 16; ++r) o[d_][r] *= al_l[crow(r, hi)]; } } while (0)
#define KBASE(t) ((t) * KVBLK)
#define MASKT(P0_, P1_, t) do { const int kb_ = KBASE(t); if (kb_ + KVBLK - 1 > qlo) mask_tile(P0_, P1_, qm - kb_); } while (0)
    f32x16 pA0, pA1, pB0 = {}, pB1 = {}; float mnA, mnB, alA, alB = 1.f; bf16x8 pa0, pa1, pa2, pa3;
    DMA_K(0, 0); DMA_R(0, 0);
#pragma unroll
    for (int d0 = 0; d0 < 8; ++d0) qr[d0] = ld8(cur.Qn + (size_t)(wid * QBLK + r32) * LDQ + d0 * 16 + hi * 8);
    { bf16x8 t_[4];
#pragma unroll
      for (int d0 = 0; d0 < 4; ++d0) t_[d0] = ld8(cur.Qr + (size_t)(wid * QBLK + r32) * LDR + d0 * 16 + hi * 8);
#pragma unroll
      for (int d0 = 0; d0 < 4; ++d0) *(bf16x8*)(qrl + d0 * 1024) = t_[d0]; }
    WAIT_BAR();
    const int ldsa = (int)(uintptr_t)lds;
    const int kbase = ldsa + OFF_K + r32 * 256, hs4 = ((hi ^ (r32 & 15)) << 4), rb = ldsa + OFF_R + r32 * 32 + hi * 16, qb = ldsa + OFF_QR + wid * 4096 + lane * 16;
    bf16x8 kfa0, kfb0, qf0, kfa1, kfb1, qf1;
#define DSR128(dst, addr, off) asm volatile("ds_read_b128 %0, %1 offset:%2" : "=v"(dst) : "v"(addr), "i"(off) : "memory")
#define LGKM(n) asm volatile("s_waitcnt lgkmcnt(%0)" :: "i"(n) : "memory")
#define KREAD(S_, d0, KB) do { if ((d0) < 8) { const int ka_ = kbase + (hs4 ^ ((d0) << 5)); DSR128(kfa##S_, ka_, (KB) * SHM_K); DSR128(kfb##S_, ka_, (KB) * SHM_K + 8192); } \
        else if ((d0) < 12) { DSR128(kfa##S_, rb, (KB) * SHM_R + ((d0) - 8) * 2048); DSR128(kfb##S_, rb, (KB) * SHM_R + ((d0) - 8) * 2048 + 1024); DSR128(qf##S_, qb, ((d0) - 8) * 1024); } } while (0)
#define NRD(d0) ((d0) < 8 ? 2 : (d0) < 12 ? 3 : 0)
#define MF(S_, d0, PX0, PX1) do { const bf16x8 q_ = (d0) < 8 ? qr[(d0) < 8 ? (d0) : 0] : qf##S_; \
        PX0 = __builtin_amdgcn_mfma_f32_32x32x16_bf16(kfa##S_, q_, (d0) == 0 ? f32x16{} : PX0, 0, 0, 0); PX1 = __builtin_amdgcn_mfma_f32_32x32x16_bf16(kfb##S_, q_, (d0) == 0 ? f32x16{} : PX1, 0, 0, 0); } while (0)
#define PK4(P, B_, OUT) do { unsigned a0 = cvtpk(P[B_+0], P[B_+1]), a1 = cvtpk(P[B_+2], P[B_+3]); unsigned b0 = cvtpk(P[B_+4], P[B_+5]), b1 = cvtpk(P[B_+6], P[B_+7]); \
        auto r0 = __builtin_amdgcn_permlane32_swap(a0, b0, false, false); auto r1 = __builtin_amdgcn_permlane32_swap(a1, b1, false, false); \
        u32x4 w = {r0[0], r1[0], r0[1], r1[1]}; OUT = *reinterpret_cast<bf16x8*>(&w); } while (0)
#define FSLICE(g, PY0, PY1, alY) do { \
        if ((g) < 8) { PY1[2 * (g)] = __builtin_amdgcn_exp2f(PY1[2 * (g)]); PY1[2 * (g) + 1] = __builtin_amdgcn_exp2f(PY1[2 * (g) + 1]); } \
        if ((g) < 4) { ps_ += (PY0[4 * (g)] + PY0[4 * (g) + 1]) + (PY0[4 * (g) + 2] + PY0[4 * (g) + 3]); } \
        if ((g) >= 4) { ps_ += PY1[2 * ((g) - 4)] + PY1[2 * ((g) - 4) + 1]; } \
        if ((g) == 1) PK4(PY0, 0, pa0); if ((g) == 3) PK4(PY0, 8, pa1); if ((g) == 8) PK4(PY1, 0, pa2); if ((g) == 10) PK4(PY1, 8, pa3); \
        if ((g) == 11) { auto rr = __builtin_amdgcn_permlane32_swap(__float_as_uint(ps_), __float_as_uint(ps_), false, false); ps_ = __uint_as_float(rr[0]) + __uint_as_float(rr[1]); l_reg = l_reg * (alY) + ps_; } } while (0)
#define QSTEP(S_, S2_, d0, KB, FIN, PX0, PX1, PY0, PY1, alY) do { LGKM(NRD((d0) + 1)); SBAR(); __builtin_amdgcn_s_setprio(1); MF(S_, d0, PX0, PX1); __builtin_amdgcn_s_setprio(0); KREAD(S2_, (d0) + 2, KB); if (FIN) FSLICE(d0, PY0, PY1, alY); SBAR(); } while (0)
#define QKT_FIN(KB, FIN, PX0, PX1, PY0, PY1, alY) do { float ps_ = 0.f; SBAR(); KREAD(0, 0, KB); KREAD(1, 1, KB); \
        QSTEP(0, 0, 0, KB, FIN, PX0, PX1, PY0, PY1, alY); QSTEP(1, 1, 1, KB, FIN, PX0, PX1, PY0, PY1, alY); QSTEP(0, 0, 2, KB, FIN, PX0, PX1, PY0, PY1, alY); \
        QSTEP(1, 1, 3, KB, FIN, PX0, PX1, PY0, PY1, alY); QSTEP(0, 0, 4, KB, FIN, PX0, PX1, PY0, PY1, alY); QSTEP(1, 1, 5, KB, FIN, PX0, PX1, PY0, PY1, alY); \
        QSTEP(0, 0, 6, KB, FIN, PX0, PX1, PY0, PY1, alY); QSTEP(1, 1, 7, KB, FIN, PX0, PX1, PY0, PY1, alY); QSTEP(0, 0, 8, KB, FIN, PX0, PX1, PY0, PY1, alY); \
        QSTEP(1, 1, 9, KB, FIN, PX0, PX1, PY0, PY1, alY); QSTEP(0, 0, 10, KB, FIN, PX0, PX1, PY0, PY1, alY); QSTEP(1, 1, 11, KB, FIN, PX0, PX1, PY0, PY1, alY); } while (0)
#define TRRD(dst, off) asm volatile("ds_read_b64_tr_b16 %0, %1 offset:%2" : "=&v"(dst) : "v"(vb0), "i"(off) : "memory")
#define TRSET(X, VB, d0) do { constexpr int b_ = OFF_V + (VB) * SHM_V + v_rd_off(d0, 0, 0); TRRD(X##l0, b_); TRRD(X##h0, b_ + 2048); TRRD(X##l1, b_ + 4096); TRRD(X##h1, b_ + 6144); TRRD(X##l2, b_ + 8192); TRRD(X##h2, b_ + 10240); TRRD(X##l3, b_ + 12288); TRRD(X##h3, b_ + 14336); } while (0)
#define PVMF(X, d0) do { \
        o[d0] = __builtin_amdgcn_mfma_f32_32x32x16_bf16(pa0, (bf16x8){X##l0[0], X##l0[1], X##l0[2], X##l0[3], X##h0[0], X##h0[1], X##h0[2], X##h0[3]}, o[d0], 0, 0, 0); \
        o[d0] = __builtin_amdgcn_mfma_f32_32x32x16_bf16(pa1, (bf16x8){X##l1[0], X##l1[1], X##l1[2], X##l1[3], X##h1[0], X##h1[1], X##h1[2], X##h1[3]}, o[d0], 0, 0, 0); \
        o[d0] = __builtin_amdgcn_mfma_f32_32x32x16_bf16(pa2, (bf16x8){X##l2[0], X##l2[1], X##l2[2], X##l2[3], X##h2[0], X##h2[1], X##h2[2], X##h2[3]}, o[d0], 0, 0, 0); \
        o[d0] = __builtin_amdgcn_mfma_f32_32x32x16_bf16(pa3, (bf16x8){X##l3[0], X##l3[1], X##l3[2], X##l3[3], X##h3[0], X##h3[1], X##h3[2], X##h3[3]}, o[d0], 0, 0, 0); } while (0)
#define PV_PIPE(VB) do { s16x4 Al0, Al1, Al2, Al3, Ah0, Ah1, Ah2, Ah3, Bl0, Bl1, Bl2, Bl3, Bh0, Bh1, Bh2, Bh3; SBAR(); \
        TRSET(A, VB, 0); TRSET(B, VB, 1); LGKM(8); SBAR(); PVMF(A, 0); SBAR(); \
        TRSET(A, VB, 2); LGKM(8); SBAR(); PVMF(B, 1); SBAR(); \
        TRSET(B, VB, 3); LGKM(8); SBAR(); PVMF(A, 2); SBAR(); \
        LGKM(0); SBAR(); PVMF(B, 3); SBAR(); } while (0)
#define STEP(PX0, PX1, mnX, alX, PY0, PY1, alY, t, KB, VB) do { \
        if ((t) + 1 < NT) { DMA_K((t) + 1, VB); DMA_R((t) + 1, VB); } DMA_V((t), KB); \
        QKT_FIN(KB, true, PX0, PX1, PY0, PY1, alY); \
        PV_PIPE(VB); MASKT(PX0, PX1, (t)); partialSM(PX0, PX1, m_reg, mnX, alX); \
        RESC(alX); WAIT_BAR(); } while (0)
    DMA_K(1, 1); DMA_R(1, 1); DMA_V(0, 0);
    QKT_FIN(0, false, pA0, pA1, pB0, pB1, alB);
    MASKT(pA0, pA1, 0); partialSM(pA0, pA1, m_reg, mnA, alA);
    WAIT_BAR();
    for (int t = 1; t + 1 < NT; t += 2) {
        STEP(pB0, pB1, mnB, alB, pA0, pA1, alA, t, 1, 0);
        STEP(pA0, pA1, mnA, alA, pB0, pB1, alB, t + 1, 0, 1);
    }
    STEP(pB0, pB1, mnB, alB, pA0, pA1, alA, NT - 1, 1, 0);
    finishSM(pB0, pB1, alB, l_reg, pa0, pa1, pa2, pa3); SBAR(); PV_PIPE(1);
    if (hi == 0) li_l[r32] = l_reg; asm volatile("s_waitcnt lgkmcnt(0)" ::: "memory");
    float rli[16];
#pragma unroll
    for (int r = 0; r < 16; ++r) rli[r] = __builtin_amdgcn_rcpf(li_l[crow(r, hi)]);
    bf16_t* Ow = cur.O + (size_t)(wid * QBLK) * LDQ;
#pragma unroll
    for (int r = 0; r < 16; ++r) { const int orow = crow(r, hi);
#pragma unroll
        for (int d0 = 0; d0 < 4; ++d0) { const float v = o[d0][r] * rli[r]; const float vn = __shfl_xor(v, 1);
            if ((r32 & 1) == 0) *(unsigned*)(Ow + (size_t)orow * LDQ + d0 * 32 + r32) = cvtpk(v, vn); } }
    WAIT_BAR();
#undef RESC
#undef KBASE
#undef MASKT
#undef STEP
#undef DSR128
#undef LGKM
#undef KREAD
#undef NRD
#undef MF
#undef PK4
#undef FSLICE
#undef QSTEP
#undef QKT_FIN
#undef TRRD
#undef TRSET
#undef PVMF
#undef PV_PIPE
}
#undef DMA16
#undef DMA_K
#undef DMA_V
#undef DMA_R
#undef WAIT_BAR
__device__ __forceinline__ BlockRef make_ref(int h, int qb, const bf16_t* qn, const bf16_t* qr, const bf16_t* kn, const bf16_t* vm, bf16_t* ob) {
    BlockRef r; r.Qn = qn + (size_t)qb * QB * LDQ + h * 128; r.Qr = qr + (size_t)qb * QB * LDR + h * 64; r.K = kn + h * 128; r.V = vm + h * 128; r.O = ob + (size_t)qb * QB * LDQ + h * 128; r.P0 = qb * QB; return r;
}
__device__ __forceinline__ void phase(char* lds, LAS3 unsigned char* lds3, const bf16_t* qn, const bf16_t* qr, const bf16_t* kn, const bf16_t* kr, const bf16_t* vm, bf16_t* ob, int vcu, int G) {
    constexpr int NITEMS = H * 16;
    for (int L = vcu; L < NITEMS; L += G) {
        const int h = L >> 4, x = L & 15;
        block(make_ref(h, x, qn, qr, kn, vm, ob), kr, lds, lds3);
        block(make_ref(h, 31 - x, qn, qr, kn, vm, ob), kr, lds, lds3);
    }
}
#undef KSWZ
#undef LAS3
#undef SBAR
}
namespace hg {
typedef short bf16x8 __attribute__((ext_vector_type(8)));
typedef short s16x4 __attribute__((ext_vector_type(4)));
typedef float f32x16 __attribute__((ext_vector_type(16)));
typedef float f32x4 __attribute__((ext_vector_type(4)));
typedef unsigned u32x4 __attribute__((ext_vector_type(4)));
typedef unsigned u32x2 __attribute__((ext_vector_type(2)));
typedef _Float16 f16x8 __attribute__((ext_vector_type(8)));
#define LAS3 __attribute__((address_space(3)))
#define KSWZ(row, colB) ((row) * 256 + ((colB) ^ (((row) & 7) << 4)))
#define SBAR() __builtin_amdgcn_sched_barrier(0)
constexpr int O_QES = 0, O_KES = 16384, O_KET = 32768, O_V = 49152, O_ST = 65536, O_BL = 98304, O_SEG = 131072, O_DL = 133120, O_END = 133632;
constexpr int LD = 2048;
__device__ __forceinline__ int crow(int r, int hi) { return (r & 3) + 8 * (r >> 2) + 4 * hi; }
__device__ __forceinline__ unsigned cvtpk(float lo, float hi) { unsigned r; asm volatile("v_cvt_pk_bf16_f32 %0, %1, %2" : "=v"(r) : "v"(lo), "v"(hi)); return r; }
__device__ __forceinline__ int v_rd_base(int lane) { return ((lane & 3) << 3) | (((lane >> 2) & 3) << 6) | (((lane >> 4) & 1) << 5) | (((lane >> 5) & 1) << 8); }

struct Ptrs { const bf16_t* qh; const f16_t* g16; const bf16_t* v; const bf16_t* og; bf16_t* og_out; const float* ghg; float* U; float* Dg; };

template <bool OUT>
__device__ __forceinline__ void unit(char* lds, LAS3 unsigned char* lds3, const Ptrs& P, int h, int grp) {
    const int tid = threadIdx.x, wid = __builtin_amdgcn_readfirstlane(tid >> 6), lane = tid & 63, r32 = lane & 31, hi = lane >> 5;
    const int tb = wid & 1, vq = wid >> 1;
    const size_t colh = (size_t)h * 128;
    const int vkk = wid * 8 + ((lane & 31) >> 2), vk = (vkk & ~0xC) | ((vkk & 4) << 1) | ((vkk & 8) >> 1);
    const int voff0 = vk * LD + (lane >> 5) * 32 + (lane & 3) * 8;
    const int vb = (int)(uintptr_t)lds + O_V + v_rd_base(lane) + vq * 512;
    f32x16 Sf[2];
    float gsum[16];
#pragma unroll
    for (int j = 0; j < 16; ++j) gsum[j] = 0.f;
    if (OUT) {
        const float* Sin = P.U + ((size_t)(grp * 16 + h) * 128) * 128;
#pragma unroll
        for (int i = 0; i < 2; ++i)
#pragma unroll
            for (int r = 0; r < 16; ++r) Sf[i][r] = Sin[(size_t)(32 * (2 * tb + i) + crow(r, hi)) * 128 + 32 * vq + r32];
    } else { Sf[0] = f32x16{}; Sf[1] = f32x16{}; }
#define WRITE_ST() do { _Pragma("unroll") for (int i = 0; i < 2; ++i) _Pragma("unroll") for (int g = 0; g < 4; ++g) { const int row = 32 * vq + r32, ch = 4 * (2 * tb + i) + g; \
        u32x2 w; w.x = cvtpk(Sf[i][4 * g], Sf[i][4 * g + 1]); w.y = cvtpk(Sf[i][4 * g + 2], Sf[i][4 * g + 3]); \
        *(u32x2*)(lds + O_ST + row * 256 + ((ch * 16) ^ ((row & 7) << 4)) + 8 * hi) = w; } } while (0)
    if (OUT) WRITE_ST();
#define BAR_L() asm volatile("s_waitcnt lgkmcnt(0)\n\ts_barrier" ::: "memory")
#define BAR_VL() asm volatile("s_waitcnt vmcnt(0) lgkmcnt(0)\n\ts_barrier" ::: "memory")
#define DMA_V(tok) do { const bf16_t* s_ = P.v + (size_t)(tok) * LD + colh; \
        __builtin_amdgcn_global_load_lds((const unsigned*)(s_ + voff0), (LAS3 unsigned*)(lds3 + O_V + wid * 2048), 16, 0, 0); \
        __builtin_amdgcn_global_load_lds((const unsigned*)(s_ + voff0 + 64), (LAS3 unsigned*)(lds3 + O_V + wid * 2048 + 1024), 16, 0, 0); } while (0)
    const int t = lane, kc = wid * 16, to = tid >> 3, vc = (tid & 7) * 16;
    const size_t grow = ((size_t)grp * 512 + t) * LD + colh + kc, orow = ((size_t)grp * 512 + to) * LD + colh + vc;
    f16x8 g0 = *(const f16x8*)(P.g16 + grow), g1 = *(const f16x8*)(P.g16 + grow + 8);
    bf16x8 q0 = {}, q1 = {};
    if (OUT) { q0 = *(const bf16x8*)(P.qh + grow); q1 = *(const bf16x8*)(P.qh + grow + 8); }
    DMA_V((size_t)grp * 512);
    for (int c = 0; c < 8; ++c) {
        const size_t tok0 = (size_t)grp * 512 + c * 64;
        float gl[16], b[16];
#pragma unroll
        for (int j = 0; j < 16; ++j) { gl[j] = (float)(j < 8 ? g0[j] : g1[j - 8]); float x = gl[j];
            x += __int_as_float(__builtin_amdgcn_update_dpp(0, __float_as_int(x), 0x111, 0xF, 0xF, false));
            x += __int_as_float(__builtin_amdgcn_update_dpp(0, __float_as_int(x), 0x112, 0xF, 0xF, false));
            x += __int_as_float(__builtin_amdgcn_update_dpp(0, __float_as_int(x), 0x114, 0xF, 0xF, false));
            x += __int_as_float(__builtin_amdgcn_update_dpp(0, __float_as_int(x), 0x118, 0xF, 0xF, false));
            x += __int_as_float(__builtin_amdgcn_update_dpp(0, __float_as_int(x), 0x142, 0xA, 0xF, false));
            x += __int_as_float(__builtin_amdgcn_update_dpp(0, __float_as_int(x), 0x143, 0xC, 0xF, false));
            b[j] = x; }
        { float ke[16];
#pragma unroll
          for (int j = 0; j < 16; ++j) ke[j] = (1.f - __expf(gl[j])) * __expf(-b[j]);
          if (OUT) { float qe[16];
#pragma unroll
              for (int j = 0; j < 16; ++j) qe[j] = bf2f((bf16_t)(j < 8 ? q0[j] : q1[j - 8])) * __expf(b[j]);
              u32x4 w0 = {cvtpk(qe[0], qe[1]), cvtpk(qe[2], qe[3]), cvtpk(qe[4], qe[5]), cvtpk(qe[6], qe[7])}, w1 = {cvtpk(qe[8], qe[9]), cvtpk(qe[10], qe[11]), cvtpk(qe[12], qe[13]), cvtpk(qe[14], qe[15])};
              *(u32x4*)(lds + O_QES + KSWZ(t, kc * 2)) = w0; *(u32x4*)(lds + O_QES + KSWZ(t, kc * 2 + 16)) = w1;
              u32x4 k0 = {cvtpk(ke[0], ke[1]), cvtpk(ke[2], ke[3]), cvtpk(ke[4], ke[5]), cvtpk(ke[6], ke[7])}, k1 = {cvtpk(ke[8], ke[9]), cvtpk(ke[10], ke[11]), cvtpk(ke[12], ke[13]), cvtpk(ke[14], ke[15])};
              *(u32x4*)(lds + O_KES + KSWZ(t, kc * 2)) = k0; *(u32x4*)(lds + O_KES + KSWZ(t, kc * 2 + 16)) = k1; }
          { char* kt = lds + O_KET + (t >> 4) * 4096 + kc * 32 + ((t >> 3) & 1) * 16 + (t & 7) * 2;
#pragma unroll
            for (int j = 0; j < 16; j += 2) { const unsigned w = cvtpk(ke[j], ke[j + 1]); *(unsigned short*)(kt + j * 32) = (unsigned short)(w & 0xffffu); *(unsigned short*)(kt + (j + 1) * 32) = (unsigned short)(w >> 16); } }
          if (t == 63) {
#pragma unroll
              for (int j = 0; j < 16; ++j) { ((float*)(lds + O_DL))[kc + j] = __expf(b[j]); gsum[j] += b[j]; } } }
        BAR_VL();
        bf16x8 e0 = {}, e1 = {};
        if (OUT) { e0 = *(const bf16x8*)(P.og + orow + (size_t)c * 64 * LD); e1 = *(const bf16x8*)(P.og + orow + (size_t)c * 64 * LD + 8); }
        if (c < 7) { const size_t nx = grow + (size_t)(c + 1) * 64 * LD; g0 = *(const f16x8*)(P.g16 + nx); g1 = *(const f16x8*)(P.g16 + nx + 8);
            if (OUT) { q0 = *(const bf16x8*)(P.qh + nx); q1 = *(const bf16x8*)(P.qh + nx + 8); } }
        bf16x8 vf[4];
        { s16x4 lo[4], hh[4];
#pragma unroll
          for (int ks = 0; ks < 4; ++ks) { asm volatile("ds_read_b64_tr_b16 %0, %1 offset:%2" : "=&v"(lo[ks]) : "v"(vb), "i"(ks * 4096) : "memory"); asm volatile("ds_read_b64_tr_b16 %0, %1 offset:%2" : "=&v"(hh[ks]) : "v"(vb), "i"(ks * 4096 + 2048) : "memory"); }
          asm volatile("s_waitcnt lgkmcnt(0)" ::: "memory"); SBAR();
#pragma unroll
          for (int ks = 0; ks < 4; ++ks) vf[ks] = (bf16x8){lo[ks][0], lo[ks][1], lo[ks][2], lo[ks][3], hh[ks][0], hh[ks][1], hh[ks][2], hh[ks][3]}; }
        f32x16 o = f32x16{};
        if (OUT) {
            bf16x8 qr[8], kf[8];
#pragma unroll
            for (int ks = 0; ks < 8; ++ks) qr[ks] = *(const bf16x8*)(lds + O_QES + KSWZ(32 * tb + r32, (ks * 16 + hi * 8) * 2));
#pragma unroll
            for (int ks = 0; ks < 8; ++ks) kf[ks] = *(const bf16x8*)(lds + O_KES + KSWZ(r32, (ks * 16 + hi * 8) * 2));
            SBAR();
            f32x16 p0 = f32x16{}, p1 = f32x16{};
#pragma unroll
            for (int ks = 0; ks < 8; ++ks) p0 = __builtin_amdgcn_mfma_f32_32x32x16_bf16(kf[ks], qr[ks], p0, 0, 0, 0);
            if (tb == 1) {
#pragma unroll
                for (int ks = 0; ks < 8; ++ks) kf[ks] = *(const bf16x8*)(lds + O_KES + KSWZ(32 + r32, (ks * 16 + hi * 8) * 2));
                SBAR();
#pragma unroll
                for (int ks = 0; ks < 8; ++ks) p1 = __builtin_amdgcn_mfma_f32_32x32x16_bf16(kf[ks], qr[ks], p1, 0, 0, 0);
#pragma unroll
                for (int r = 0; r < 16; ++r) if (crow(r, hi) > r32) p1[r] = 0.f;
            } else {
#pragma unroll
                for (int r = 0; r < 16; ++r) if (crow(r, hi) > r32) p0[r] = 0.f;
            }
#pragma unroll
            for (int ks = 0; ks < 8; ++ks) kf[ks] = *(const bf16x8*)(lds + O_ST + KSWZ(32 * vq + r32, (ks * 16 + hi * 8) * 2));
            SBAR();
            bf16x8 pa0, pa1, pa2, pa3;
#define PK4(Pv, B_, OUTF) do { unsigned a0 = cvtpk(Pv[B_+0], Pv[B_+1]), a1 = cvtpk(Pv[B_+2], Pv[B_+3]); unsigned b0 = cvtpk(Pv[B_+4], Pv[B_+5]), b1 = cvtpk(Pv[B_+6], Pv[B_+7]); \
        auto r0 = __builtin_amdgcn_permlane32_swap(a0, b0, false, false); auto r1 = __builtin_amdgcn_permlane32_swap(a1, b1, false, false); \
        u32x4 w = {r0[0], r1[0], r0[1], r1[1]}; OUTF = *reinterpret_cast<bf16x8*>(&w); } while (0)
            PK4(p0, 0, pa0); PK4(p0, 8, pa1); PK4(p1, 0, pa2); PK4(p1, 8, pa3);
#undef PK4
            o = __builtin_amdgcn_mfma_f32_32x32x16_bf16(pa0, vf[0], o, 0, 0, 0); o = __builtin_amdgcn_mfma_f32_32x32x16_bf16(pa1, vf[1], o, 0, 0, 0);
            o = __builtin_amdgcn_mfma_f32_32x32x16_bf16(pa2, vf[2], o, 0, 0, 0); o = __builtin_amdgcn_mfma_f32_32x32x16_bf16(pa3, vf[3], o, 0, 0, 0);
#pragma unroll
            for (int ks = 0; ks < 8; ++ks) o = __builtin_amdgcn_mfma_f32_32x32x16_bf16(qr[ks], kf[ks], o, 0, 0, 0);
        }
        bf16x8 tf[2][4];
#pragma unroll
        for (int i = 0; i < 2; ++i)
#pragma unroll
            for (int ks = 0; ks < 4; ++ks) tf[i][ks] = *(const bf16x8*)(lds + O_KET + ks * 4096 + (32 * (2 * tb + i) + r32) * 32 + hi * 16);
        SBAR();
#pragma unroll
        for (int i = 0; i < 2; ++i) { const int kb = 2 * tb + i; f32x16 acc = f32x16{};
#pragma unroll
            for (int ks = 0; ks < 4; ++ks) acc = __builtin_amdgcn_mfma_f32_32x32x16_bf16(tf[i][ks], vf[ks], acc, 0, 0, 0);
#pragma unroll
            for (int g = 0; g < 4; ++g) { const f32x4 dv = *(const f32x4*)((const float*)(lds + O_DL) + 32 * kb + 8 * g + 4 * hi);
#pragma unroll
                for (int e = 0; e < 4; ++e) Sf[i][4 * g + e] = dv[e] * (Sf[i][4 * g + e] + acc[4 * g + e]); } }
        if (OUT) { float* ot = (float*)(lds + O_BL);
#pragma unroll
            for (int r = 0; r < 16; ++r) ot[(32 * tb + crow(r, hi)) * 128 + 32 * vq + r32] = o[r]; }
        BAR_L();
        if (c < 7) DMA_V(tok0 + 64);
        if (OUT) {
            WRITE_ST();
            { const float* ot = (const float*)(lds + O_BL) + to * 128 + vc; float x[16]; float ss = 0.f;
#pragma unroll
              for (int j4 = 0; j4 < 4; ++j4) { const f32x4 y = *(const f32x4*)(ot + 4 * j4); x[4 * j4] = y[0]; x[4 * j4 + 1] = y[1]; x[4 * j4 + 2] = y[2]; x[4 * j4 + 3] = y[3]; ss += (y[0] * y[0] + y[1] * y[1]) + (y[2] * y[2] + y[3] * y[3]); }
              ss += __shfl_xor(ss, 1); ss += __shfl_xor(ss, 2); ss += __shfl_xor(ss, 4);
              const float rstd = rsqrtf(ss * (1.f / 128.f) + EPS);
              bf16_t* op = P.og_out + (tok0 + to) * LD + colh + vc;
#pragma unroll
              for (int j4 = 0; j4 < 4; ++j4) { const f32x4 gw = *(const f32x4*)(P.ghg + vc + 4 * j4);
#pragma unroll
                  for (int e = 0; e < 4; ++e) { const int j = 4 * j4 + e; x[j] = x[j] * rstd * gw[e] * bf2f((bf16_t)(j < 8 ? e0[j] : e1[j - 8])); } }
              u32x4 w0 = {cvtpk(x[0], x[1]), cvtpk(x[2], x[3]), cvtpk(x[4], x[5]), cvtpk(x[6], x[7])}, w1 = {cvtpk(x[8], x[9]), cvtpk(x[10], x[11]), cvtpk(x[12], x[13]), cvtpk(x[14], x[15])};
              *(u32x4*)op = w0; *(u32x4*)(op + 8) = w1; }
        }
    }
    BAR_VL();
#undef BAR_L
#undef BAR_VL
#undef DMA_V
    if (!OUT) {
        float* Uo = P.U + ((size_t)(grp * 16 + h) * 128) * 128;
#pragma unroll
        for (int i = 0; i < 2; ++i)
#pragma unroll
            for (int r = 0; r < 16; ++r) Uo[(size_t)(32 * (2 * tb + i) + crow(r, hi)) * 128 + 32 * vq + r32] = Sf[i][r];
        if (lane == 63) {
#pragma unroll
            for (int j = 0; j < 16; ++j) P.Dg[(size_t)(grp * 16 + h) * 128 + kc + j] = __expf(gsum[j]); }
    }
#undef WRITE_ST
}
template <bool OUT> __device__ __forceinline__ void phase(char* lds, LAS3 unsigned char* lds3, const Ptrs& P, int vcu, int G) {
    for (int u = vcu; u < 256; u += G) unit<OUT>(lds, lds3, P, u >> 4, u & 15);
}
__device__ __forceinline__ void scan_phase(float* U, const float* Dg, int gt, int NGT) {
    for (int e = gt; e < 16 * 128 * 128; e += NGT) { const int hk = e >> 7; float cur = 0.f;
#pragma unroll
        for (int g = 0; g < 16; ++g) { const size_t idx = (size_t)g * (16 * 128 * 128) + e; const float u = U[idx], d = Dg[(size_t)g * (16 * 128) + hk]; U[idx] = cur; cur = d * cur + u; } }
}
#undef LAS3
#undef KSWZ
#undef SBAR
}
#define GAS __attribute__((address_space(1)))
#define LAS __attribute__((address_space(3)))
typedef float f32x4 __attribute__((ext_vector_type(4)));
typedef unsigned v4u __attribute__((ext_vector_type(4)));
typedef unsigned v2u __attribute__((ext_vector_type(2)));
constexpr int NWAVES = 8, NTHREADS = 512;
constexpr int RING_BYTES = 131072, LDS_BYTES = 147456;
constexpr int MISC_OFF = LDS_BYTES - 256, CW_BAR = 4096, CW_TMO = 64, CW_SEAM = 16384;
constexpr bool FUSE_NORM = false;
#define LDS_WAIT() asm volatile("s_waitcnt lgkmcnt(0)" ::: "memory")
__device__ __forceinline__ unsigned pk2(float lo, float hi) { return (unsigned)f2bf(lo) | ((unsigned)f2bf(hi) << 16); }
__device__ __forceinline__ float wave_sum(float v) {
#pragma unroll
    for (int o = 1; o < 64; o <<= 1) v += __shfl_xor(v, o);
    return v;
}
#define XB_TMO      128
#define XB_XCNT(j)  (256  + 64 * (j))
#define XB_XSUB(j)  (1280 + 64 * (j))
#define XB_XGEN(j)  (2304 + 64 * (j))
#define XB_TOP      3328
#define XB_TOPGEN   3392
#define XCD_BAR_WORDS 3456
#define XB_SPIN_CAP (1u << 18)

__device__ __forceinline__ unsigned xb_ld(unsigned* p)              { return __hip_atomic_load(p, __ATOMIC_RELAXED, __HIP_MEMORY_SCOPE_AGENT); }
__device__ __forceinline__ unsigned xb_add(unsigned* p, unsigned v) { return __hip_atomic_fetch_add(p, v, __ATOMIC_RELAXED, __HIP_MEMORY_SCOPE_AGENT); }
__device__ __forceinline__ unsigned xb_xcc_id() { return (unsigned)__builtin_amdgcn_s_getreg((3 << 11) | 20) & 0xFu; }
#define XB_SPIN(cond, bar) do { unsigned _sp = 0; while (cond) { __builtin_amdgcn_s_sleep(1); \
    if ((++_sp & 255u) == 0u) { if (xb_ld(&(bar)[XB_TMO])) break; if (_sp > XB_SPIN_CAP) { atomicAdd(&(bar)[XB_TMO], 1u); break; } } } } while (0)

struct XcdBarrier {
    unsigned* bar; unsigned x;
    volatile LAS unsigned* st;
};

__device__ __forceinline__ XcdBarrier xcd_barrier_post(unsigned* bar, volatile LAS unsigned* st) {
    XcdBarrier b; b.bar = bar; b.x = xb_xcc_id(); b.st = st;
    if (threadIdx.x == 0) (void)xb_add(&bar[XB_XCNT(b.x)], 1u);
    return b;
}
__device__ __forceinline__ void xcd_barrier_complete(unsigned* bar, unsigned x, unsigned& nloc, unsigned& nx) {
    const unsigned G = gridDim.x * gridDim.y * gridDim.z;
    unsigned sum, cnt, mine, sp = 0u;
    for (;;) {
        sum = 0u; cnt = 0u; mine = 0u;
#pragma unroll
        for (unsigned j = 0; j < 16; ++j) { const unsigned c = xb_ld(&bar[XB_XCNT(j)]); sum += c; cnt += (c > 0u) ? 1u : 0u; mine = (j == x) ? c : mine; }
        if (sum == G) break;
        __builtin_amdgcn_s_sleep(1);
        if ((++sp & 255u) == 0u) { if (xb_ld(&bar[XB_TMO])) break; if (sp > XB_SPIN_CAP) { atomicAdd(&bar[XB_TMO], 1u); break; } }
    }
    nloc = mine > 0u ? mine : 1u; nx = cnt > 0u ? cnt : 1u;
}

__device__ __forceinline__ void xcd_barrier(const XcdBarrier& b) {
    asm volatile("s_waitcnt vmcnt(0)" ::: "memory");
    __syncthreads();
    if (threadIdx.x == 0) {
        unsigned* bar = b.bar;
        __builtin_amdgcn_s_waitcnt(0);
        unsigned nloc = b.st[0], nx = b.st[1];
        if (nloc == 0u) { xcd_barrier_complete(bar, b.x, nloc, nx); b.st[0] = nloc; b.st[1] = nx; }
        const unsigned old = xb_add(&bar[XB_XSUB(b.x)], 1u);
        const unsigned gen = old / nloc;
        if (old + 1u == (gen + 1u) * nloc) {
            __builtin_amdgcn_fence(__ATOMIC_RELEASE, "agent");
            asm volatile("s_waitcnt vmcnt(0)" ::: "memory");
            const unsigned og = xb_add(&bar[XB_TOP], 1u);
            const unsigned tg = og / nx;
            if (og + 1u == (tg + 1u) * nx) xb_add(&bar[XB_TOPGEN], 1u);
            else XB_SPIN(xb_ld(&bar[XB_TOPGEN]) == tg, bar);
            __builtin_amdgcn_fence(__ATOMIC_ACQUIRE, "agent");
            xb_add(&bar[XB_XGEN(b.x)], 1u);
            asm volatile("s_waitcnt vmcnt(0)" ::: "memory");
        } else {
            XB_SPIN(xb_ld(&bar[XB_XGEN(b.x)]) == gen, bar);
            __builtin_amdgcn_fence(__ATOMIC_ACQUIRE, "agent");
            asm volatile("s_waitcnt vmcnt(0)" ::: "memory");
        }
    }
    __syncthreads();
}

struct Args { const void* in[21]; float* out; unsigned char* ws; int ph_lo, ph_hi; };

template <int MAP> __device__ __forceinline__ int src_map(int n) { return MAP == 0 ? src_in(n) : MAP == 1 ? src_uq(n) : MAP == 2 ? src_gu(n) : n; }
template <int MAP> __device__ __forceinline__ void p0_transpose_item(const float* W, int K, int N, int NP, const float* scale, bf16_t* WT, LAS float* scr, int item, int lane) {
    const int nblk = NP / 64, kb = item / nblk, nb = item % nblk, k0 = 64 * kb, n0 = 64 * nb;
    const int nq = (lane & 15) * 4, kr = lane >> 4;
    const int s0 = src_map<MAP>(n0 + nq), s1 = src_map<MAP>(n0 + nq + 1), s2 = src_map<MAP>(n0 + nq + 2), s3 = src_map<MAP>(n0 + nq + 3);
    f32x4 v[16];
    if (__all(s0 >= 0 && s1 == s0 + 1 && s2 == s0 + 2 && s3 == s0 + 3)) {
#pragma unroll
        for (int i = 0; i < 16; ++i) v[i] = *(const f32x4*)(W + (size_t)(k0 + 4 * i + kr) * N + s0);
    } else {
#pragma unroll
        for (int i = 0; i < 16; ++i) { const float* wr = W + (size_t)(k0 + 4 * i + kr) * N; v[i][0] = s0 >= 0 ? wr[s0] : 0.f; v[i][1] = s1 >= 0 ? wr[s1] : 0.f; v[i][2] = s2 >= 0 ? wr[s2] : 0.f; v[i][3] = s3 >= 0 ? wr[s3] : 0.f; }
    }
    if (scale) {
#pragma unroll
        for (int i = 0; i < 16; ++i) v[i] *= scale[k0 + 4 * i + kr]; }
#pragma unroll
    for (int i = 0; i < 16; ++i)
#pragma unroll
        for (int q = 0; q < 4; ++q) scr[(nq + q) * 65 + 4 * i + kr] = v[i][q];
    LDS_WAIT(); asm volatile("" ::: "memory");
    const int c = lane & 7;
#pragma unroll
    for (int j = 0; j < 8; ++j) { const int n = (lane >> 3) + 8 * j; const LAS float* s = scr + n * 65 + 8 * c;
        v4u o; o.x = pk2(s[0], s[1]); o.y = pk2(s[2], s[3]); o.z = pk2(s[4], s[5]); o.w = pk2(s[6], s[7]);
        *(GAS v4u*)(WT + (size_t)(n0 + n) * K + k0 + 8 * c) = o; }
    LDS_WAIT(); asm volatile("" ::: "memory");
}
__device__ __forceinline__ void p0_convert(const Args& a, LAS unsigned char* lds, int vcu, int G, int wave, int lane) {
    unsigned char* ws = a.ws;
    { LAS float* scr = (LAS float*)(lds + wave * 16640);
      const int gw = vcu * NWAVES + wave, NGW = G * NWAVES;
      constexpr int I_IN = (D / 64) * (IN_WP / 64), I_UQ = (QL / 64) * (UQ_W / 64), I_UKV = (KVL / 64) * (UKV_W / 64);
      constexpr int NITEMS = I_IN + I_UQ + I_UKV;
      for (int it = gw; it < NITEMS; it += NGW) { int r = it;
          if (r < I_IN) { p0_transpose_item<0>((const float*)a.in[6], D, IN_W, IN_WP, nullptr, (bf16_t*)(ws + WS_WIN), scr, r, lane); continue; } r -= I_IN;
          if (r < I_UQ) { p0_transpose_item<1>((const float*)a.in[11], QL, UQ_W, UQ_W, (const float*)a.in[10], (bf16_t*)(ws + WS_WUQ), scr, r, lane); continue; } r -= I_UQ;
          p0_transpose_item<3>((const float*)a.in[13], KVL, UKV_W, UKV_W, (const float*)a.in[12], (bf16_t*)(ws + WS_WUKV), scr, r, lane);
      } }
    __syncthreads();
}
__device__ __forceinline__ void p0_prologue(const Args& a, LAS unsigned char* lds, int vcu, int G, int wave, int lane, int tid) {
    unsigned char* ws = a.ws;
    { const int gt = vcu * NTHREADS + tid, NGT = G * NTHREADS; const int* pos = (const int*)a.in[2]; float* rope = (float*)(ws + WS_ROPE);
      const int j = gt & 31; const float inv = (float)pow(10000.0, -(double)(2 * j) / 64.0);
      for (int i = gt; i < S * 32; i += NGT) { const int t = i >> 5; const float ang = (float)pos[t] * inv; double sn, cs; sincos((double)ang, &sn, &cs);
          rope[2 * i] = (float)cs; rope[2 * i + 1] = (float)sn; }
      if (gt < 2048) { const float* ll = (const float*)a.in[7]; const float x0 = ll[gt], x1 = ll[2048 + gt], m = fmaxf(x0, x1); const float e0 = expf(x0 - m), e1 = expf(x1 - m); ((float*)(ws + WS_LB))[gt] = e0 / (e0 + e1); } }
    { LAS float* sc = (LAS float*)lds; LAS float* part = (LAS float*)(lds + 8192);
      const float* c = (const float*)a.in[1]; const float* w_ada = (const float*)a.in[3]; const float* b_ada = (const float*)a.in[4];
      for (int i = tid; i < D; i += NTHREADS) { const float cv = c[i]; sc[i] = cv / (1.f + expf(-cv)); }
      __syncthreads();
      for (int cb = vcu; cb < (NMOD * D) / 48; cb += G) {
          const int rg = tid / 12, cg = tid % 12; f32x4 acc = {0.f, 0.f, 0.f, 0.f};
          if (rg < 42) { const float* wp = w_ada + (size_t)cb * 48 + cg * 4;
              for (int r0 = rg; r0 < D; r0 += 42 * 7) { f32x4 w[7];
#pragma unroll
                  for (int u = 0; u < 7; ++u) { const int r = r0 + 42 * u; w[u] = r < D ? *(const f32x4*)(wp + (size_t)r * (NMOD * D)) : (f32x4){0.f, 0.f, 0.f, 0.f}; }
#pragma unroll
                  for (int u = 0; u < 7; ++u) { const int r = r0 + 42 * u; if (r < D) acc += w[u] * sc[r]; } }
              *(LAS f32x4*)(part + rg * 48 + cg * 4) = acc; }
          __syncthreads();
          if (tid < 48) { float s = 0.f; for (int r = 0; r < 42; ++r) s += part[r * 48 + tid]; ((float*)(ws + WS_MOD))[cb * 48 + tid] = s + b_ada[cb * 48 + tid]; }
          __syncthreads();
      } }
}
template <int MAP> __device__ __forceinline__ void tail_convert(const float* W, int K, int N, int NP, bf16_t* WT, LAS unsigned char* lds, int nwg, int G, int c, int wave, int lane) {
    const int rounds = (nwg + G - 1) / G, nlast = nwg - (rounds - 1) * G;
    if (c < nlast || nlast == G) { if (nlast != G) return; }
    const int nworkers = nlast == G ? G : G - nlast, w = nlast == G ? c : c - nlast;
    LAS float* scr = (LAS float*)(lds + wave * 16640);
    const int nitems = (K / 64) * (NP / 64);
    for (int it = w * NWAVES + wave; it < nitems; it += nworkers * NWAVES) p0_transpose_item<MAP>(W, K, N, NP, nullptr, WT, scr, it, lane);
    __syncthreads();
}
__device__ __forceinline__ void p1_rows_h(const Args& a, int gw, int NGW, int lane) {
    const float* x = (const float*)a.in[0]; const float* g = (const float*)a.in[5]; const float* mod = (const float*)(a.ws + WS_MOD); bf16_t* h = (bf16_t*)(a.ws + WS_H);
    for (int row = gw; row < S; row += NGW) {
        const f32x4* xr = (const f32x4*)(x + (size_t)row * D) + lane; f32x4 v[8]; float ss = 0.f;
#pragma unroll
        for (int j = 0; j < 8; ++j) { v[j] = xr[64 * j]; ss += (v[j][0] * v[j][0] + v[j][1] * v[j][1]) + (v[j][2] * v[j][2] + v[j][3] * v[j][3]); }
        const float rstd = rsqrtf(wave_sum(ss) * (1.f / D) + EPS);
        v2u* o = (v2u*)(h + (size_t)row * D) + lane;
#pragma unroll
        for (int j = 0; j < 8; ++j) { const int cidx = 64 * j + lane; const f32x4 gg = ((const f32x4*)g)[cidx], sh = ((const f32x4*)mod)[cidx], sc = ((const f32x4*)(mod + 2048))[cidx];
            const f32x4 r = v[j] * rstd * gg * (sc + 1.f) + sh; v2u w; w.x = pk2(r[0], r[1]); w.y = pk2(r[2], r[3]); o[64 * j] = w; }
    }
}
__device__ __forceinline__ void p9_rows_mid(const Args& a, int gw, int NGW, int lane) {
    const float* x = (const float*)a.in[0]; const bf16_t* y = (const bf16_t*)(a.ws + WS_Y); const float* ssy = (const float*)(a.ws + WS_SSY); const float* mod = (const float*)(a.ws + WS_MOD);
    const float* gpost = (const float*)a.in[16]; const float* gpre = (const float*)a.in[17]; bf16_t* h2 = (bf16_t*)(a.ws + WS_H);
    int row = gw; if (row >= S) return;
    f32x4 xv[8], xn[8]; v2u yw[8], yn[8]; float sv, sn = 0.f;
#define P9_LOAD(XV, YW, SV, R) do { const f32x4* xr_ = (const f32x4*)(x + (size_t)(R) * D) + lane; const v2u* yr_ = (const v2u*)(y + (size_t)(R) * D) + lane; \
        _Pragma("unroll") for (int j = 0; j < 8; ++j) { XV[j] = xr_[64 * j]; YW[j] = yr_[64 * j]; } SV = lane < 32 ? ssy[(size_t)(R) * 32 + lane] : 0.f; } while (0)
    P9_LOAD(xv, yw, sv, row);
    for (;;) {
        const int nrow = row + NGW; const bool has = nrow < S;
        if (has) P9_LOAD(xn, yn, sn, nrow);
        const float rstd = rsqrtf(wave_sum(sv) * (1.f / D) + EPS);
        f32x4* orow = (f32x4*)(a.out + (size_t)row * D) + lane; f32x4 v[8]; float ss = 0.f;
#pragma unroll
        for (int j = 0; j < 8; ++j) { const int cidx = 64 * j + lane; const f32x4 ga = ((const f32x4*)(mod + 4096))[cidx], gp = ((const f32x4*)gpost)[cidx];
            const v2u w_ = yw[j]; const f32x4 yv = {__uint_as_float(w_.x << 16), __uint_as_float(w_.x & 0xffff0000u), __uint_as_float(w_.y << 16), __uint_as_float(w_.y & 0xffff0000u)};
            v[j] = xv[j] + ga * (yv * rstd * gp); orow[64 * j] = v[j]; ss += (v[j][0] * v[j][0] + v[j][1] * v[j][1]) + (v[j][2] * v[j][2] + v[j][3] * v[j][3]); }
        const float r2 = rsqrtf(wave_sum(ss) * (1.f / D) + EPS);
        v2u* o = (v2u*)(h2 + (size_t)row * D) + lane;
#pragma unroll
        for (int j = 0; j < 8; ++j) { const int cidx = 64 * j + lane; const f32x4 gg = ((const f32x4*)gpre)[cidx], sh = ((const f32x4*)(mod + 6144))[cidx], sc = ((const f32x4*)(mod + 8192))[cidx];
            const f32x4 r = v[j] * r2 * gg * (sc + 1.f) + sh; v2u w; w.x = pk2(r[0], r[1]); w.y = pk2(r[2], r[3]); o[64 * j] = w; }
        if (!has) break;
        row = nrow; sv = sn;
#pragma unroll
        for (int j = 0; j < 8; ++j) { xv[j] = xn[j]; yw[j] = yn[j]; }
    }
#undef P9_LOAD
}
__device__ __forceinline__ void p12_rows_final(const Args& a, int gw, int NGW, int lane) {
    const bf16_t* y2 = (const bf16_t*)(a.ws + WS_Y2); const float* ss2 = (const float*)(a.ws + WS_SSY2); const float* mod = (const float*)(a.ws + WS_MOD); const float* gpost = (const float*)a.in[20];
    for (int row = gw; row < S; row += NGW) {
        const float rstd = rsqrtf(wave_sum(lane < 32 ? ss2[(size_t)row * 32 + lane] : 0.f) * (1.f / D) + EPS);
        const v2u* yr = (const v2u*)(y2 + (size_t)row * D) + lane; f32x4* orow = (f32x4*)(a.out + (size_t)row * D) + lane;
#pragma unroll
        for (int j = 0; j < 8; ++j) { const int cidx = 64 * j + lane; const f32x4 ga = ((const f32x4*)(mod + 10240))[cidx], gp = ((const f32x4*)gpost)[cidx];
            const v2u yw = yr[64 * j]; const f32x4 yv = {__uint_as_float(yw.x << 16), __uint_as_float(yw.x & 0xffff0000u), __uint_as_float(yw.y << 16), __uint_as_float(yw.y & 0xffff0000u)};
            orow[64 * j] = orow[64 * j] + ga * (yv * rstd * gp); }
    }
}

__global__ void __launch_bounds__(NTHREADS, 2) fwd(Args a) {
    extern __shared__ __attribute__((aligned(16))) unsigned char lds_raw[];
    LAS unsigned char* lds = (LAS unsigned char*)lds_raw;
    const int tid = threadIdx.x, lane = tid & 63, wave = __builtin_amdgcn_readfirstlane(tid >> 6);
    const int G = gridDim.x, bx = blockIdx.x, vcu = (G % 8 == 0) ? (bx % 8) * (G / 8) + bx / 8 : bx;
    const int gw = vcu * NWAVES + wave, NGW = G * NWAVES;
    unsigned char* ws = a.ws;
    const int lo = a.ph_lo, hi = a.ph_hi;
    volatile LAS unsigned* MISC = (volatile LAS unsigned*)(lds + MISC_OFF);
    if (tid < 16) MISC[tid] = 0u;
    __syncthreads();
    XcdBarrier bar = xcd_barrier_post((unsigned*)(ws + WS_CTL) + CW_BAR, MISC + 8);
#define IN(k) (lo <= (k) && (k) < hi)
#if PROBE_DUP == 200
#define BAR_AFTER(k) do { if (IN(k) && IN((k) + 1)) { xcd_barrier(bar); xcd_barrier(bar); } } while (0)
#else
#define BAR_AFTER(k) do { if (IN(k) && IN((k) + 1)) xcd_barrier(bar); } while (0)
#endif
    const hg::Ptrs hp{(const bf16_t*)(ws + WS_QH), (const f16_t*)(ws + WS_G16), (const bf16_t*)(ws + WS_V), (const bf16_t*)(ws + WS_OG), (bf16_t*)(ws + WS_OG), (const float*)a.in[8], (float*)(ws + WS_U), (float*)(ws + WS_DG)};
    if (IN(0)) p0_prologue(a, lds, vcu, G, wave, lane, tid);
#if PROBE_DUP == 100
    if (IN(0)) { __syncthreads(); p0_prologue(a, lds, vcu, G, wave, lane, tid); }
#endif
    BAR_AFTER(0);
    if (IN(1)) { p0_convert(a, lds, vcu, G, wave, lane); p1_rows_h(a, gw, NGW, lane); }
#if PROBE_DUP == 301
    if (IN(1)) p1_rows_h(a, gw, NGW, lane);
#endif
    BAR_AFTER(1);
    if (IN(2)) {
        pg8::Gemm g{(const bf16_t*)(ws + WS_H), (const bf16_t*)(ws + WS_WIN), S, IN_WP, D}; pg8::StaticOrder So; So.init(S, IN_WP, G, bx);
        pg8::EpiIn E{(bf16_t*)(ws + WS_QH), (bf16_t*)(ws + WS_G16), (bf16_t*)(ws + WS_V), (bf16_t*)(ws + WS_OG), (bf16_t*)(ws + WS_SA), (bf16_t*)(ws + WS_SB), (bf16_t*)(ws + WS_CQ), (bf16_t*)(ws + WS_CKV), (bf16_t*)(ws + WS_KR),
                     (const float*)(ws + WS_LB), (const float*)(ws + WS_ROPE), (float*)(ws + WS_SSQ), (float*)(ws + WS_SSKV)};
        pg8::gemm_phase<pg8::EpiIn, pg8::StaticOrder, true, PG8_SP2V>(lds, g, So, E);
        tail_convert<2>((const float*)a.in[18], D, GU_W, GU_W, (bf16_t*)(ws + WS_WGU), lds, (S / 256) * (IN_WP / 256), G, bx, wave, lane);
#if PROBE_DUP == 102
        pg8::gemm_phase<pg8::EpiIn, pg8::StaticOrder, true, PG8_SP2V>(lds, g, So, E);
#endif
    }
    BAR_AFTER(2);
    if (IN(3)) {
        { pg8::Gemm g{(const bf16_t*)(ws + WS_CQ), (const bf16_t*)(ws + WS_WUQ), S, UQ_W, QL}; pg8::StaticOrder So; So.init(S, UQ_W, G, bx);
          pg8::EpiUq E{(bf16_t*)(ws + WS_QN), (bf16_t*)(ws + WS_QR), (const float*)(ws + WS_SSQ), (const float*)(ws + WS_ROPE), QSCALE, EPS};
          pg8::gemm_phase<pg8::EpiUq, pg8::StaticOrder, true, PG8_SP2V>(lds, g, So, E); }
        tail_convert<3>((const float*)a.in[9], D, D, D, (bf16_t*)(ws + WS_WOHG), lds, (S / 256) * (UQ_W / 256), G, bx, wave, lane);
        tail_convert<3>((const float*)a.in[14], D, D, D, (bf16_t*)(ws + WS_WOMLA), lds, (S / 256) * (UQ_W / 256), G, bx, wave, lane);
        tail_convert<3>((const float*)a.in[15], D, D, D, (bf16_t*)(ws + WS_WOUT), lds, (S / 256) * (UQ_W / 256), G, bx, wave, lane);
        { pg8::Gemm g{(const bf16_t*)(ws + WS_CKV), (const bf16_t*)(ws + WS_WUKV), S, UKV_W, KVL}; pg8::StaticOrder So; So.init(S, UKV_W, G, bx);
          pg8::EpiUkv E{(bf16_t*)(ws + WS_KN), (bf16_t*)a.out, (const float*)(ws + WS_SSKV), EPS};
          pg8::gemm_phase<pg8::EpiUkv, pg8::StaticOrder, true, PG8_SP2V>(lds, g, So, E); }
#if PROBE_DUP == 303
        { pg8::Gemm g{(const bf16_t*)(ws + WS_CQ), (const bf16_t*)(ws + WS_WUQ), S, UQ_W, QL}; pg8::StaticOrder So; So.init(S, UQ_W, G, bx);
          pg8::EpiUq E{(bf16_t*)(ws + WS_QN), (bf16_t*)(ws + WS_QR), (const float*)(ws + WS_SSQ), (const float*)(ws + WS_ROPE), QSCALE, EPS};
          pg8::gemm_phase<pg8::EpiUq, pg8::StaticOrder, true, PG8_SP2V>(lds, g, So, E); }
        { pg8::Gemm g{(const bf16_t*)(ws + WS_CKV), (const bf16_t*)(ws + WS_WUKV), S, UKV_W, KVL}; pg8::StaticOrder So; So.init(S, UKV_W, G, bx);
          pg8::EpiUkv E{(bf16_t*)(ws + WS_KN), (bf16_t*)a.out, (const float*)(ws + WS_SSKV), EPS};
          pg8::gemm_phase<pg8::EpiUkv, pg8::StaticOrder, true, PG8_SP2V>(lds, g, So, E); }
#endif
        hg::phase<false>((char*)lds_raw, lds, hp, vcu, G);
#if PROBE_DUP == 103
        hg::phase<false>((char*)lds_raw, lds, hp, vcu, G);
#endif
    }
    BAR_AFTER(3);
    if (IN(4)) hg::scan_phase((float*)(ws + WS_U), (const float*)(ws + WS_DG), vcu * NTHREADS + tid, G * NTHREADS);
    BAR_AFTER(4);
    if (IN(5)) {
#if PROBE_DUP == 105
        att::phase((char*)lds_raw, lds, (bf16_t*)(ws + WS_QN), (const bf16_t*)(ws + WS_QR), (const bf16_t*)(ws + WS_KN), (const bf16_t*)(ws + WS_KR), (const bf16_t*)a.out, (bf16_t*)((unsigned char*)a.out + 32 * MiB), vcu, G);
#endif
        att::phase((char*)lds_raw, lds, (bf16_t*)(ws + WS_QN), (const bf16_t*)(ws + WS_QR), (const bf16_t*)(ws + WS_KN), (const bf16_t*)(ws + WS_KR), (const bf16_t*)a.out, (bf16_t*)(ws + WS_QN), vcu, G);
#if PROBE_DUP == 106
        { hg::Ptrs hp2 = hp; hp2.og_out = (bf16_t*)((unsigned char*)a.out + 32 * MiB); hg::phase<true>((char*)lds_raw, lds, hp2, vcu, G); }
#endif
        hg::phase<true>((char*)lds_raw, lds, hp, vcu, G);
    }
    BAR_AFTER(5);
    if (IN(6)) {
        { pg8::Gemm g{(const bf16_t*)(ws + WS_OG), (const bf16_t*)(ws + WS_WOHG), S, D, D}; pg8::StaticOrder So; So.init(S, D, G, bx);
          pg8::EpiYa E{(bf16_t*)(ws + WS_YAS), (const bf16_t*)(ws + WS_SA)};
          pg8::gemm_phase<pg8::EpiYa, pg8::StaticOrder, true, PG8_SP2V>(lds, g, So, E); }
        { pg8::Gemm g{(const bf16_t*)(ws + WS_QN), (const bf16_t*)(ws + WS_WOMLA), S, D, D}; pg8::StaticOrder So; So.init(S, D, G, bx);
          pg8::EpiYb E{(const bf16_t*)(ws + WS_YAS), (const bf16_t*)(ws + WS_SB), (bf16_t*)(ws + WS_MERGED)};
          pg8::gemm_phase<pg8::EpiYb, pg8::StaticOrder, true, PG8_SP2V>(lds, g, So, E); }
        #if PROBE_DUP == 306
        { pg8::Gemm g{(const bf16_t*)(ws + WS_OG), (const bf16_t*)(ws + WS_WOHG), S, D, D}; pg8::StaticOrder So; So.init(S, D, G, bx);
          pg8::EpiYa E{(bf16_t*)(ws + WS_YAS), (const bf16_t*)(ws + WS_SA)};
          pg8::gemm_phase<pg8::EpiYa, pg8::StaticOrder, true, PG8_SP2V>(lds, g, So, E); }
        { pg8::Gemm g{(const bf16_t*)(ws + WS_QN), (const bf16_t*)(ws + WS_WOMLA), S, D, D}; pg8::StaticOrder So; So.init(S, D, G, bx);
          pg8::EpiYb E{(const bf16_t*)(ws + WS_YAS), (const bf16_t*)(ws + WS_SB), (bf16_t*)(ws + WS_MERGED)};
          pg8::gemm_phase<pg8::EpiYb, pg8::StaticOrder, true, PG8_SP2V>(lds, g, So, E); }
        #endif

    }
    BAR_AFTER(6);
    if (IN(7)) {
        pg8::Gemm g{(const bf16_t*)(ws + WS_MERGED), (const bf16_t*)(ws + WS_WOUT), S, D, D}; pg8::StaticOrder So; So.init(S, D, G, bx);
        if (FUSE_NORM && G == 256) {
            const float* mod = (const float*)(ws + WS_MOD);
            pg8::RowStatX s1{(float*)(ws + WS_SSY), (unsigned*)(ws + WS_CTL) + CW_SEAM, (unsigned*)(ws + WS_CTL) + CW_TMO, 1.f / D, EPS}, s2{(float*)(ws + WS_SSX1), (unsigned*)(ws + WS_CTL) + CW_SEAM + 2048, (unsigned*)(ws + WS_CTL) + CW_TMO, 1.f / D, EPS};
            pg8::EpiRmsResRms E{(const float*)a.in[0], a.out, (bf16_t*)(ws + WS_H), mod + 4096, (const float*)a.in[16], (const float*)a.in[17], mod + 8192, mod + 6144, s1, s2};
            pg8::gemm_phase<pg8::EpiRmsResRms, pg8::StaticOrder, false, PG8_SP2V>(lds, g, So, E);
        } else {
        pg8::EpiF32SS E{(bf16_t*)(ws + WS_Y), (float*)(ws + WS_SSY)};
        pg8::gemm_phase<pg8::EpiF32SS, pg8::StaticOrder, true, PG8_SP2V>(lds, g, So, E);
        }
        #if PROBE_DUP == 307
        {
        pg8::Gemm g{(const bf16_t*)(ws + WS_MERGED), (const bf16_t*)(ws + WS_WOUT), S, D, D}; pg8::StaticOrder So; So.init(S, D, G, bx);
        if (FUSE_NORM && G == 256) {
            const float* mod = (const float*)(ws + WS_MOD);
            pg8::RowStatX s1{(float*)(ws + WS_SSY), (unsigned*)(ws + WS_CTL) + CW_SEAM, (unsigned*)(ws + WS_CTL) + CW_TMO, 1.f / D, EPS}, s2{(float*)(ws + WS_SSX1), (unsigned*)(ws + WS_CTL) + CW_SEAM + 2048, (unsigned*)(ws + WS_CTL) + CW_TMO, 1.f / D, EPS};
            pg8::EpiRmsResRms E{(const float*)a.in[0], a.out, (bf16_t*)(ws + WS_H), mod + 4096, (const float*)a.in[16], (const float*)a.in[17], mod + 8192, mod + 6144, s1, s2};
            pg8::gemm_phase<pg8::EpiRmsResRms, pg8::StaticOrder, false, PG8_SP2V>(lds, g, So, E);
        } else {
        pg8::EpiF32SS E{(bf16_t*)(ws + WS_Y), (float*)(ws + WS_SSY)};
        pg8::gemm_phase<pg8::EpiF32SS, pg8::StaticOrder, true, PG8_SP2V>(lds, g, So, E);
        }
                }
#endif

    }
    if (!(FUSE_NORM && G == 256)) BAR_AFTER(7);
    if (IN(8) && !(FUSE_NORM && G == 256)) p9_rows_mid(a, gw, NGW, lane);
#if PROBE_DUP == 308
    if (IN(8)) p9_rows_mid(a, gw, NGW, lane);
#endif
    BAR_AFTER(8);
    if (IN(9)) {
        pg8::Gemm g{(const bf16_t*)(ws + WS_H), (const bf16_t*)(ws + WS_WGU), S, GU_W, D}; pg8::StaticOrder So; So.init(S, GU_W, G, bx);
        pg8::EpiGu E{(bf16_t*)(ws + WS_ACT), DFF};
        pg8::gemm_phase<pg8::EpiGu, pg8::StaticOrder, true, PG8_SP2V>(lds, g, So, E);
        tail_convert<3>((const float*)a.in[19], DFF, D, D, (bf16_t*)(ws + WS_WDN), lds, (S / 256) * (GU_W / 256), G, bx, wave, lane);
#if PROBE_DUP == 109
        pg8::gemm_phase<pg8::EpiGu, pg8::StaticOrder, true, PG8_SP2V>(lds, g, So, E);
#endif
    }
    BAR_AFTER(9);
    if (IN(10)) {
        pg8::Gemm g{(const bf16_t*)(ws + WS_ACT), (const bf16_t*)(ws + WS_WDN), S, D, DFF}; pg8::StaticOrder So; So.init(S, D, G, bx);
        if (FUSE_NORM && G == 256) {
            pg8::RowStatX s3{(float*)(ws + WS_SSY2), (unsigned*)(ws + WS_CTL) + CW_SEAM + 4096, (unsigned*)(ws + WS_CTL) + CW_TMO, 1.f / D, EPS};
            pg8::EpiRmsResOut E{a.out, (const float*)(ws + WS_MOD) + 10240, (const float*)a.in[20], s3};
            pg8::gemm_phase<pg8::EpiRmsResOut, pg8::StaticOrder, false, PG8_SP2V>(lds, g, So, E);
        } else {
        pg8::EpiF32SS E{(bf16_t*)(ws + WS_Y2), (float*)(ws + WS_SSY2)};
        pg8::gemm_phase<pg8::EpiF32SS, pg8::StaticOrder, true, PG8_SP2V>(lds, g, So, E);
        }
        #if PROBE_DUP == 310
        {
        pg8::Gemm g{(const bf16_t*)(ws + WS_ACT), (const bf16_t*)(ws + WS_WDN), S, D, DFF}; pg8::StaticOrder So; So.init(S, D, G, bx);
        if (FUSE_NORM && G == 256) {
            pg8::RowStatX s3{(float*)(ws + WS_SSY2), (unsigned*)(ws + WS_CTL) + CW_SEAM + 4096, (unsigned*)(ws + WS_CTL) + CW_TMO, 1.f / D, EPS};
            pg8::EpiRmsResOut E{a.out, (const float*)(ws + WS_MOD) + 10240, (const float*)a.in[20], s3};
            pg8::gemm_phase<pg8::EpiRmsResOut, pg8::StaticOrder, false, PG8_SP2V>(lds, g, So, E);
        } else {
        pg8::EpiF32SS E{(bf16_t*)(ws + WS_Y2), (float*)(ws + WS_SSY2)};
        pg8::gemm_phase<pg8::EpiF32SS, pg8::StaticOrder, true, PG8_SP2V>(lds, g, So, E);
        }
                }
#endif

    }
    if (!(FUSE_NORM && G == 256)) BAR_AFTER(10);
    if (IN(11) && !(FUSE_NORM && G == 256)) p12_rows_final(a, gw, NGW, lane);
#undef IN
#undef BAR_AFTER
}
extern "C" void kernel_launch(void* const* d_in, const int* in_sizes, int n_in, void* d_out, int out_size, void* d_ws, size_t ws_size, hipStream_t stream) {
    static int grid = 0;
    if (grid == 0) {
        if (n_in != 21 || out_size != S * D || ws_size < WS_END) { fprintf(stderr, "kernel_launch: unexpected shapes (n_in %d out %d ws %zu)\n", n_in, out_size, ws_size); grid = -1; return; }
        int dev = 0, cus = 0;
        if (hipGetDevice(&dev) != hipSuccess || hipDeviceGetAttribute(&cus, hipDeviceAttributeMultiprocessorCount, dev) != hipSuccess) { grid = -1; return; }
        if (hipFuncSetAttribute((const void*)fwd, hipFuncAttributeMaxDynamicSharedMemorySize, LDS_BYTES) != hipSuccess) { fprintf(stderr, "kernel_launch: hipFuncSetAttribute failed\n"); grid = -1; return; }
        int per_cu = 0;
        if (hipOccupancyMaxActiveBlocksPerMultiprocessor(&per_cu, (const void*)fwd, NTHREADS, LDS_BYTES) != hipSuccess || per_cu < 1) { fprintf(stderr, "kernel_launch: occupancy query failed (%d)\n", per_cu); (void)hipGetLastError(); per_cu = 1; }
        grid = cus;
    }
    if (grid < 0) return;
    Args a{};
    for (int i = 0; i < 21; ++i) a.in[i] = d_in[i];
    a.out = (float*)d_out; a.ws = (unsigned char*)d_ws;
    auto run = [&](int lo, int hi) { a.ph_lo = lo; a.ph_hi = hi; hipLaunchKernelGGL(fwd, dim3(grid), dim3(NTHREADS), LDS_BYTES, stream, a); };
    if (hipMemsetAsync((char*)d_ws + WS_CTL, 0, 131072, stream) != hipSuccess) { fprintf(stderr, "kernel_launch: hipMemsetAsync failed\n"); return; }
    run(0, 12);
}
```

```cpp
#ifndef PG8_SP2V
#define PG8_SP2V true
#endif
#ifndef PROBE_DUP
#define PROBE_DUP 0
#endif
#include <hip/hip_runtime.h>
#include <hip/hip_bf16.h>
#include <hip/hip_fp16.h>
#include <cstdio>
#include <cstdint>

typedef unsigned short bf16_t;
typedef unsigned short f16_t;

constexpr int S = 8192, D = 2048, H = 16, HK = 128, HV = 128;
constexpr int QL = 512, KVL = 512, NOPE = 128, ROPE = 64, VD = 128, QKD = 192;
constexpr int DFF = 5632, NMOD = 6;
constexpr int IN_W = 13376, IN_WP = 13568;
constexpr int UQ_W = 3072, UKV_W = 4096, GU_W = 11264;
constexpr float EPS = 1e-6f;
constexpr float QSCALE = 0.07216878364870322f * 1.4426950408889634f;

constexpr size_t MiB = 1u << 20;
constexpr size_t WS_CTL = 0;
constexpr size_t WS_MOD = 1 * MiB;
constexpr size_t WS_LB = 1 * MiB + 64 * 1024;
constexpr size_t WS_DG = 1 * MiB + 128 * 1024;
constexpr size_t WS_ROPE = 2 * MiB;
constexpr size_t WS_SSQ = 4 * MiB;
constexpr size_t WS_SSKV = 5 * MiB;
constexpr size_t WS_SSY = 6 * MiB;
constexpr size_t WS_SSY2 = 7 * MiB;
constexpr size_t WS_SSX1 = 367 * MiB;
constexpr size_t WS_WIN = 8 * MiB;
constexpr size_t WS_QN = 8 * MiB;
constexpr size_t WS_QR = 40 * MiB;
constexpr size_t WS_WOHG = 61 * MiB;
constexpr size_t WS_WUQ = 69 * MiB;
constexpr size_t WS_WUKV = 72 * MiB;
constexpr size_t WS_WOMLA = 76 * MiB;
constexpr size_t WS_WOUT = 84 * MiB;
constexpr size_t WS_WGU = 92 * MiB;
constexpr size_t WS_WDN = 136 * MiB;
constexpr size_t WS_QH = 158 * MiB;
constexpr size_t WS_G16 = 190 * MiB;
constexpr size_t WS_V = 222 * MiB;
constexpr size_t WS_OG = 254 * MiB;
constexpr size_t WS_SA = 286 * MiB;
constexpr size_t WS_SB = 318 * MiB;
constexpr size_t WS_CQ = 350 * MiB;
constexpr size_t WS_CKV = 358 * MiB;
constexpr size_t WS_KR = 366 * MiB;
constexpr size_t WS_H = 368 * MiB;
constexpr size_t WS_KN = 368 * MiB;
constexpr size_t WS_U = 400 * MiB;
constexpr size_t WS_YAS = 158 * MiB;
constexpr size_t WS_MERGED = 222 * MiB;
constexpr size_t WS_Y = 254 * MiB;
constexpr size_t WS_ACT = 158 * MiB;
constexpr size_t WS_Y2 = 254 * MiB;
constexpr size_t WS_SCR2 = 318 * MiB;
constexpr size_t WS_END = 416 * MiB;

__device__ __forceinline__ float bf2f(bf16_t v) { return __uint_as_float((unsigned)v << 16); }
__device__ __forceinline__ bf16_t f2bf(float f) { unsigned u = __float_as_uint(f); return (bf16_t)((u + 0x7fffu + ((u >> 16) & 1u)) >> 16); }
__device__ __forceinline__ float h2f(f16_t v) { return __half2float(__ushort_as_half(v)); }
__device__ __forceinline__ f16_t f2h(float f) { return __half_as_ushort(__float2half_rn(f)); }
__device__ __forceinline__ float sigmoidf_(float x) { return 1.f / (1.f + __expf(-x)); }
__device__ __forceinline__ float siluf_(float x) { return x / (1.f + __expf(-x)); }

__host__ __device__ inline int src_in(int n) {
    if (n < 8192) return n;
    if (n < 10240) return n - 8192 + 9280;
    if (n < 12288) return n - 10240 + 11328;
    if (n < 12800) return n - 12288 + 8192;
    if (n < 13312) return n - 12800 + 8704;
    if (n < 13376) { const int i = n - 13312; return 9216 + 32 * (i & 1) + (i >> 1); }
    return -1;
}
__host__ __device__ inline int src_uq(int n) {
    if (n < 2048) return (n >> 7) * 192 + (n & 127);
    const int m = n - 2048, h = m >> 6, i = m & 63; return h * 192 + 128 + 32 * (i & 1) + (i >> 1);
}
__host__ __device__ inline int src_gu(int n) { const int t = n >> 8, r = n & 255; return r < 128 ? 128 * t + r : 5632 + 128 * t + (r - 128); }
__host__ __device__ inline int src_id(int n) { return n; }

namespace pg8 {
#define PG8_LAS __attribute__((address_space(3)))
typedef unsigned short bf16_t;
typedef short bf16x8 __attribute__((ext_vector_type(8)));
typedef float f32x4 __attribute__((ext_vector_type(4)));
typedef unsigned u32x4 __attribute__((ext_vector_type(4)));
constexpr int BM = 256, BK = 64, HALF = 128, HTB = HALF * BK * 2  , STAGE_BYTES = 8 * HTB, NXCD = 8, WGM = 8;

__host__ __device__ __forceinline__ int lds_byte(int r, int c) { const int st = (r >> 4) * 2 + (c >> 5), rr = r & 15, cc = c & 31, ob = rr * 64 + cc * 2; return st * 1024 + (ob ^ (((ob >> 9) & 1) << 5)); }
__host__ __device__ __forceinline__ void stage_rc(int b, int& R, int& C) { const int st = b / 1024, sb = b % 1024, swz = sb ^ (((sb >> 9) & 1) << 5); R = (st >> 1) * 16 + swz / 64; C = (st & 1) * 32 + (swz % 64) / 2; }
__host__ __device__ __forceinline__ int perm32(int rho) { const int n = rho >> 4, i = rho & 15; return 8 * (i >> 2) + 4 * n + (i & 3); }

struct Unit { int pm, pn; };
struct Gemm { const bf16_t* A; const bf16_t* Bt; int M, N, K; };

struct StaticOrder {
    int nM, nN, nwg, G, c;
    __host__ __device__ void init(int M, int N, int G_, int c_) { nM = M / BM; nN = N / BM; nwg = nM * nN; G = G_; c = c_; }
    __host__ __device__ bool next(int i, Unit& u) const {
        const long L = (long)i * G + c; if (L >= nwg) return false;
        int wgid = (int)L; { const int q = nwg / NXCD, r = nwg % NXCD, xcd = wgid % NXCD, off = wgid / NXCD; wgid = (xcd < r ? xcd * (q + 1) : r * (q + 1) + (xcd - r) * q) + off; }
        const int nig = WGM * nN, gid = wgid / nig, fm = gid * WGM, gsz = (nM - fm) < WGM ? (nM - fm) : WGM;
        u.pm = fm + ((wgid % nig) % gsz); u.pn = (wgid % nig) / gsz; return true;
    }
    __device__ __forceinline__ void a_ready(const Unit&) const {}
    __device__ __forceinline__ void done(const Unit&) const {}
};

__device__ __forceinline__ unsigned cvt_pk_bf16(float lo, float hi) { unsigned r; asm volatile("v_cvt_pk_bf16_f32 %0, %1, %2" : "=v"(r) : "v"(lo), "v"(hi)); return r; }
__device__ __forceinline__ float sigm(float x) { return __builtin_amdgcn_rcpf(1.f + __expf(-x)); }
__device__ __forceinline__ unsigned cvt_pk_f16(float lo, float hi) { typedef _Float16 h2v __attribute__((ext_vector_type(2))); h2v v = {(_Float16)lo, (_Float16)hi}; return __builtin_bit_cast(unsigned, v); }
__device__ __forceinline__ u32x4 pack_bf16x8(f32x4 a, f32x4 b) { u32x4 w; w.x = cvt_pk_bf16(a[0], a[1]); w.y = cvt_pk_bf16(a[2], a[3]); w.z = cvt_pk_bf16(b[0], b[1]); w.w = cvt_pk_bf16(b[2], b[3]); return w; }
__device__ __forceinline__ void unpack_bf16x8(u32x4 w, f32x4& a, f32x4& b) {
    a[0] = __uint_as_float(w.x << 16); a[1] = __uint_as_float(w.x & 0xffff0000u); a[2] = __uint_as_float(w.y << 16); a[3] = __uint_as_float(w.y & 0xffff0000u);
    b[0] = __uint_as_float(w.z << 16); b[1] = __uint_as_float(w.z & 0xffff0000u); b[2] = __uint_as_float(w.w << 16); b[3] = __uint_as_float(w.w & 0xffff0000u); }
__device__ __forceinline__ float sumsq8(f32x4 a, f32x4 b) { return ((a[0] * a[0] + a[1] * a[1]) + (a[2] * a[2] + a[3] * a[3])) + ((b[0] * b[0] + b[1] * b[1]) + (b[2] * b[2] + b[3] * b[3])); }

struct EpiIn {
    static constexpr bool PERM = true, AFTER_DRAIN = false;
    unsigned short *qh, *g16, *v, *og, *sa, *sb, *cq, *ckv, *kr; const float *lb, *rope; float *ssq, *sskv;
    template <int MODE> __device__ __forceinline__ void seg(const f32x4 (&acc)[2][2][4][2], unsigned short* base, int row0, int colb) const {
        f32x4 l0[2], l1[2];
        if (MODE == 3) {
#pragma unroll
            for (int bj = 0; bj < 2; ++bj) { l0[bj] = *(const f32x4*)(lb + colb + bj * HALF); l1[bj] = *(const f32x4*)(lb + colb + bj * HALF + 4); } }
#pragma unroll
        for (int ai = 0; ai < 2; ++ai)
#pragma unroll
            for (int m = 0; m < 4; ++m) { unsigned short* rowp = base + (size_t)(row0 + ai * HALF + m * 16) * 2048 + colb;
#pragma unroll
                for (int bj = 0; bj < 2; ++bj) { f32x4 a = acc[ai][bj][m][0], b = acc[ai][bj][m][1]; u32x4 w;
                    if (MODE == 1) {
#pragma unroll
                        for (int e = 0; e < 4; ++e) { a[e] = a[e] * sigm(a[e]); b[e] = b[e] * sigm(b[e]); } }
                    if (MODE == 2) {
#pragma unroll
                        for (int e = 0; e < 4; ++e) { a[e] = sigm(a[e]); b[e] = sigm(b[e]); } }
                    if (MODE == 3) {
#pragma unroll
                        for (int e = 0; e < 4; ++e) { a[e] = __logf(l0[bj][e] + (1.f - l0[bj][e]) * sigm(a[e])); b[e] = __logf(l1[bj][e] + (1.f - l1[bj][e]) * sigm(b[e])); }
                        w.x = cvt_pk_f16(a[0], a[1]); w.y = cvt_pk_f16(a[2], a[3]); w.z = cvt_pk_f16(b[0], b[1]); w.w = cvt_pk_f16(b[2], b[3]); }
                    else w = pack_bf16x8(a, b);
                    *(u32x4*)(rowp + bj * HALF) = w; } }
    }
    __device__ __forceinline__ void operator()(const f32x4 (&acc)[2][2][4][2], const Unit& u, int wr, int wc, int fr, int fq) const {
        const int row0 = u.pm * BM + wr * 64 + fr, pn = u.pn, cw = wc * 32 + 8 * fq;
        if (pn < 48) { const int sg = pn >> 3, colb = (pn & 7) * 256 + cw;
            if (sg == 0) seg<1>(acc, qh, row0, colb); else if (sg == 1) seg<3>(acc, g16, row0, colb); else if (sg == 2) seg<0>(acc, v, row0, colb);
            else if (sg == 3) seg<1>(acc, og, row0, colb); else if (sg == 4) seg<2>(acc, sa, row0, colb); else seg<2>(acc, sb, row0, colb); }
        else if (pn < 52) { unsigned short* base = pn < 50 ? cq : ckv; float* ss = pn < 50 ? ssq : sskv; const int colb = (pn & 1) * 256 + cw, slot = (pn & 1) * 4 + wc;
#pragma unroll
            for (int ai = 0; ai < 2; ++ai)
#pragma unroll
                for (int m = 0; m < 4; ++m) { const int row = row0 + ai * HALF + m * 16; unsigned short* rowp = base + (size_t)row * 512 + colb; float s = 0.f;
#pragma unroll
                    for (int bj = 0; bj < 2; ++bj) { const f32x4 a = acc[ai][bj][m][0], b = acc[ai][bj][m][1]; s += sumsq8(a, b); *(u32x4*)(rowp + bj * HALF) = pack_bf16x8(a, b); }
                    s += __shfl_xor(s, 16); s += __shfl_xor(s, 32);
                    if (fq == 0) ss[(size_t)row * 8 + slot] = s; } }
        else if (wc < 2) {
#pragma unroll
            for (int ai = 0; ai < 2; ++ai)
#pragma unroll
                for (int m = 0; m < 4; ++m) { const int row = row0 + ai * HALF + m * 16; const float* rp = rope + ((size_t)row * 32 + 16 * wc + 4 * fq) * 2;
                    const f32x4 c0 = *(const f32x4*)rp, c1 = *(const f32x4*)(rp + 4); const f32x4 a = acc[ai][0][m][0], b = acc[ai][0][m][1]; f32x4 oa, ob;
                    oa[0] = a[0] * c0[0] - a[1] * c0[1]; oa[1] = a[1] * c0[0] + a[0] * c0[1]; oa[2] = a[2] * c0[2] - a[3] * c0[3]; oa[3] = a[3] * c0[2] + a[2] * c0[3];
                    ob[0] = b[0] * c1[0] - b[1] * c1[1]; ob[1] = b[1] * c1[0] + b[0] * c1[1]; ob[2] = b[2] * c1[2] - b[3] * c1[3]; ob[3] = b[3] * c1[2] + b[2] * c1[3];
                    *(u32x4*)(kr + (size_t)row * 64 + cw) = pack_bf16x8(oa, ob); } }
    }
};
struct EpiUq {
    static constexpr bool PERM = true, AFTER_DRAIN = false;
    unsigned short *qn, *qr; const float *ssq, *rope; float qscale, eps;
    __device__ __forceinline__ void operator()(const f32x4 (&acc)[2][2][4][2], const Unit& u, int wr, int wc, int fr, int fq) const {
        const int row0 = u.pm * BM + wr * 64 + fr, pn = u.pn, cw = wc * 32 + 8 * fq;
#pragma unroll
        for (int ai = 0; ai < 2; ++ai)
#pragma unroll
            for (int m = 0; m < 4; ++m) { const int row = row0 + ai * HALF + m * 16;
                const f32x4 p0 = *(const f32x4*)(ssq + (size_t)row * 8), p1 = *(const f32x4*)(ssq + (size_t)row * 8 + 4);
                const float rs = __builtin_amdgcn_rsqf((((p0[0] + p0[1]) + (p0[2] + p0[3])) + ((p1[0] + p1[1]) + (p1[2] + p1[3]))) * (1.f / 512.f) + eps) * qscale;
                if (pn < 8) { unsigned short* rowp = qn + (size_t)row * 2048 + pn * 256 + cw;
#pragma unroll
                    for (int bj = 0; bj < 2; ++bj) *(u32x4*)(rowp + bj * HALF) = pack_bf16x8(acc[ai][bj][m][0] * rs, acc[ai][bj][m][1] * rs); }
                else { unsigned short* rowp = qr + (size_t)row * 1024 + (pn - 8) * 256 + cw; const float* rp = rope + ((size_t)row * 32 + 16 * (wc & 1) + 4 * fq) * 2;
                    const f32x4 c0 = *(const f32x4*)rp, c1 = *(const f32x4*)(rp + 4);
#pragma unroll
                    for (int bj = 0; bj < 2; ++bj) { const f32x4 a = acc[ai][bj][m][0] * rs, b = acc[ai][bj][m][1] * rs; f32x4 oa, ob;
                        oa[0] = a[0] * c0[0] - a[1] * c0[1]; oa[1] = a[1] * c0[0] + a[0] * c0[1]; oa[2] = a[2] * c0[2] - a[3] * c0[3]; oa[3] = a[3] * c0[2] + a[2] * c0[3];
                        ob[0] = b[0] * c1[0] - b[1] * c1[1]; ob[1] = b[1] * c1[0] + b[0] * c1[1]; ob[2] = b[2] * c1[2] - b[3] * c1[3]; ob[3] = b[3] * c1[2] + b[2] * c1[3];
                        *(u32x4*)(rowp + bj * HALF) = pack_bf16x8(oa, ob); } } }
    }
};
struct EpiUkv {
    static constexpr bool PERM = true, AFTER_DRAIN = false;
    unsigned short *kn, *vm; const float* sskv; float eps;
    __device__ __forceinline__ void operator()(const f32x4 (&acc)[2][2][4][2], const Unit& u, int wr, int wc, int fr, int fq) const {
        const int row0 = u.pm * BM + wr * 64 + fr, colb = u.pn * 128 + wc * 32 + 8 * fq;
#pragma unroll
        for (int ai = 0; ai < 2; ++ai)
#pragma unroll
            for (int m = 0; m < 4; ++m) { const int row = row0 + ai * HALF + m * 16;
                const f32x4 p0 = *(const f32x4*)(sskv + (size_t)row * 8), p1 = *(const f32x4*)(sskv + (size_t)row * 8 + 4);
                const float rs = __builtin_amdgcn_rsqf((((p0[0] + p0[1]) + (p0[2] + p0[3])) + ((p1[0] + p1[1]) + (p1[2] + p1[3]))) * (1.f / 512.f) + eps);
                *(u32x4*)(kn + (size_t)row * 2048 + colb) = pack_bf16x8(acc[ai][0][m][0] * rs, acc[ai][0][m][1] * rs);
                *(u32x4*)(vm + (size_t)row * 2048 + colb) = pack_bf16x8(acc[ai][1][m][0] * rs, acc[ai][1][m][1] * rs); }
    }
};
struct EpiYa {
    static constexpr bool PERM = true, AFTER_DRAIN = false;
    unsigned short* yas; const unsigned short* sa;
    __device__ __forceinline__ void operator()(const f32x4 (&acc)[2][2][4][2], const Unit& u, int wr, int wc, int fr, int fq) const {
        const int row0 = u.pm * BM + wr * 64 + fr, colb = u.pn * 256 + wc * 32 + 8 * fq;
#pragma unroll
        for (int ai = 0; ai < 2; ++ai)
#pragma unroll
            for (int m = 0; m < 4; ++m) { const size_t off = (size_t)(row0 + ai * HALF + m * 16) * 2048 + colb;
#pragma unroll
                for (int bj = 0; bj < 2; ++bj) { f32x4 ga, gb; unpack_bf16x8(*(const u32x4*)(sa + off + bj * HALF), ga, gb);
                    *(u32x4*)(yas + off + bj * HALF) = pack_bf16x8(acc[ai][bj][m][0] * ga, acc[ai][bj][m][1] * gb); } }
    }
};
struct EpiYb {
    static constexpr bool PERM = true, AFTER_DRAIN = false;
    const unsigned short* yas; const unsigned short* sb; unsigned short* merged;
    __device__ __forceinline__ void operator()(const f32x4 (&acc)[2][2][4][2], const Unit& u, int wr, int wc, int fr, int fq) const {
        const int row0 = u.pm * BM + wr * 64 + fr, colb = u.pn * 256 + wc * 32 + 8 * fq;
#pragma unroll
        for (int ai = 0; ai < 2; ++ai)
#pragma unroll
            for (int m = 0; m < 4; ++m) { const size_t off = (size_t)(row0 + ai * HALF + m * 16) * 2048 + colb;
#pragma unroll
                for (int bj = 0; bj < 2; ++bj) { f32x4 ga, gb, y0, y1; unpack_bf16x8(*(const u32x4*)(sb + off + bj * HALF), ga, gb); unpack_bf16x8(*(const u32x4*)(yas + off + bj * HALF), y0, y1);
                    *(u32x4*)(merged + off + bj * HALF) = pack_bf16x8(y0 + acc[ai][bj][m][0] * ga, y1 + acc[ai][bj][m][1] * gb); } }
    }
};
struct EpiF32SS {
    static constexpr bool PERM = true, AFTER_DRAIN = false;
    unsigned short* y; float* ss;
    __device__ __forceinline__ void operator()(const f32x4 (&acc)[2][2][4][2], const Unit& u, int wr, int wc, int fr, int fq) const {
        const int row0 = u.pm * BM + wr * 64 + fr, colb = u.pn * 256 + wc * 32 + 8 * fq, slot = u.pn * 4 + wc;
#pragma unroll
        for (int ai = 0; ai < 2; ++ai)
#pragma unroll
            for (int m = 0; m < 4; ++m) { const int row = row0 + ai * HALF + m * 16; const size_t off = (size_t)row * 2048 + colb; float s = 0.f;
#pragma unroll
                for (int bj = 0; bj < 2; ++bj) { const f32x4 a = acc[ai][bj][m][0], b = acc[ai][bj][m][1]; s += sumsq8(a, b); *(u32x4*)(y + off + bj * HALF) = pack_bf16x8(a, b); }
                s += __shfl_xor(s, 16); s += __shfl_xor(s, 32);
                if (fq == 0) ss[(size_t)row * 32 + slot] = s; }
    }
};
struct EpiGu {
    static constexpr bool PERM = true, AFTER_DRAIN = false;
    unsigned short* act; int ldc;
    __device__ __forceinline__ void operator()(const f32x4 (&acc)[2][2][4][2], const Unit& u, int wr, int wc, int fr, int fq) const {
        const int row0 = u.pm * BM + wr * 64 + fr, colb = u.pn * 128 + wc * 32 + 8 * fq;
#pragma unroll
        for (int ai = 0; ai < 2; ++ai)
#pragma unroll
            for (int m = 0; m < 4; ++m) { f32x4 a = acc[ai][0][m][0], b = acc[ai][0][m][1];
#pragma unroll
                for (int e = 0; e < 4; ++e) { a[e] = a[e] * sigm(a[e]) * acc[ai][1][m][0][e]; b[e] = b[e] * sigm(b[e]) * acc[ai][1][m][1][e]; }
                *(u32x4*)(act + (size_t)(row0 + ai * HALF + m * 16) * ldc + colb) = pack_bf16x8(a, b); }
    }
};
struct RowStatX {
    float* ss; unsigned* cnt; unsigned* tmo; float inv_n, eps;
    __device__ __forceinline__ void run(const float (&s)[2][4], float (&rstd)[2][4], const Unit& u, int wr, int wc, int fr, int fq, PG8_LAS unsigned char* lds, int wid, int lane) const {
        const int row0 = u.pm * BM + wr * 64 + fr, slot = u.pn * 4 + wc;
        if (fq == 0) {
#pragma unroll
            for (int ai = 0; ai < 2; ++ai)
#pragma unroll
                for (int m = 0; m < 4; ++m) __hip_atomic_store(ss + (size_t)(row0 + ai * HALF + m * 16) * 32 + slot, s[ai][m], __ATOMIC_RELAXED, __HIP_MEMORY_SCOPE_AGENT); }
        asm volatile("s_waitcnt vmcnt(0)" ::: "memory");
        if (lane == 0) __hip_atomic_fetch_add(cnt + 64 * u.pm, 1u, __ATOMIC_RELAXED, __HIP_MEMORY_SCOPE_AGENT);
        if (wid == 0) {
            const unsigned long long t0 = __builtin_amdgcn_s_memrealtime();
            for (;;) {
                if ((unsigned)__builtin_amdgcn_readfirstlane(__hip_atomic_load(cnt + 64 * u.pm, __ATOMIC_RELAXED, __HIP_MEMORY_SCOPE_AGENT)) >= 64u) break;
                if (__builtin_amdgcn_s_memrealtime() - t0 > 2000000ull) { if (lane == 0) __hip_atomic_store(tmo, 1u, __ATOMIC_RELAXED, __HIP_MEMORY_SCOPE_AGENT); break; }
                __builtin_amdgcn_s_sleep(2);
            }
            __builtin_amdgcn_fence(__ATOMIC_ACQUIRE, "agent");
        }
        asm volatile("s_waitcnt vmcnt(0) lgkmcnt(0)" ::: "memory"); __builtin_amdgcn_s_barrier(); asm volatile("" ::: "memory");
#pragma unroll
        for (int ai = 0; ai < 2; ++ai)
#pragma unroll
            for (int m = 0; m < 4; ++m) { const float* p = ss + (size_t)(row0 + ai * HALF + m * 16) * 32; float t = 0.f;
#pragma unroll
                for (int q = 0; q < 8; ++q) { const f32x4 x = *(const f32x4*)(p + 4 * q); t += (x[0] + x[1]) + (x[2] + x[3]); }
                rstd[ai][m] = __builtin_amdgcn_rsqf(t * inv_n + eps); }
    }
};
__device__ __forceinline__ void row_partials(const f32x4 (&acc)[2][2][4][2], float (&s)[2][4]) {
#pragma unroll
    for (int ai = 0; ai < 2; ++ai)
#pragma unroll
        for (int m = 0; m < 4; ++m) { float t = sumsq8(acc[ai][0][m][0], acc[ai][0][m][1]) + sumsq8(acc[ai][1][m][0], acc[ai][1][m][1]); t += __shfl_xor(t, 16); t += __shfl_xor(t, 32); s[ai][m] = t; }
}
struct EpiRmsResOut {
    static constexpr bool PERM = true, AFTER_DRAIN = true;
    float* out; const float* ga; const float* g; RowStatX st;
    __device__ __forceinline__ void fused(f32x4 (&acc)[2][2][4][2], const Unit& u, int wr, int wc, int fr, int fq, PG8_LAS unsigned char* lds, int wid, int lane) const {
        float s[2][4], rstd[2][4]; row_partials(acc, s);
        st.run(s, rstd, u, wr, wc, fr, fq, lds, wid, lane);
        const int row0 = u.pm * BM + wr * 64 + fr, colb = u.pn * 256 + wc * 32 + 8 * fq;
        f32x4 cv[2][2];
#pragma unroll
        for (int bj = 0; bj < 2; ++bj)
#pragma unroll
            for (int n = 0; n < 2; ++n) cv[bj][n] = *(const f32x4*)(ga + colb + bj * HALF + 4 * n) * *(const f32x4*)(g + colb + bj * HALF + 4 * n);
#pragma unroll
        for (int ai = 0; ai < 2; ++ai)
#pragma unroll
            for (int m = 0; m < 4; ++m) { float* rowp = out + (size_t)(row0 + ai * HALF + m * 16) * 2048 + colb;
#pragma unroll
                for (int bj = 0; bj < 2; ++bj)
#pragma unroll
                    for (int n = 0; n < 2; ++n) { f32x4* p = (f32x4*)(rowp + bj * HALF + 4 * n); *p = *p + cv[bj][n] * (acc[ai][bj][m][n] * rstd[ai][m]); }
                if (m & 1) asm volatile("" ::: "memory"); }
    }
};
struct EpiRmsResRms {
    static constexpr bool PERM = true, AFTER_DRAIN = true;
    const float* x; float* out; unsigned short* h2; const float *ga, *g1, *g2, *sc, *sh; RowStatX st1, st2;
    __device__ __forceinline__ void fused(f32x4 (&acc)[2][2][4][2], const Unit& u, int wr, int wc, int fr, int fq, PG8_LAS unsigned char* lds, int wid, int lane) const {
        float s[2][4], rstd[2][4]; row_partials(acc, s);
        st1.run(s, rstd, u, wr, wc, fr, fq, lds, wid, lane);
        const int row0 = u.pm * BM + wr * 64 + fr, colb = u.pn * 256 + wc * 32 + 8 * fq;
        { f32x4 cv[2][2];
#pragma unroll
          for (int bj = 0; bj < 2; ++bj)
#pragma unroll
              for (int n = 0; n < 2; ++n) cv[bj][n] = *(const f32x4*)(ga + colb + bj * HALF + 4 * n) * *(const f32x4*)(g1 + colb + bj * HALF + 4 * n);
#pragma unroll
          for (int ai = 0; ai < 2; ++ai)
#pragma unroll
              for (int m = 0; m < 4; ++m) { const size_t off = (size_t)(row0 + ai * HALF + m * 16) * 2048 + colb;
#pragma unroll
                  for (int bj = 0; bj < 2; ++bj)
#pragma unroll
                      for (int n = 0; n < 2; ++n) { const f32x4 xv = *(const f32x4*)(x + off + bj * HALF + 4 * n); const f32x4 r = xv + cv[bj][n] * (acc[ai][bj][m][n] * rstd[ai][m]);
                          acc[ai][bj][m][n] = r; *(f32x4*)(out + off + bj * HALF + 4 * n) = r; }
                  asm volatile("" : "+v"(acc[ai][0][m][0]), "+v"(acc[ai][0][m][1]), "+v"(acc[ai][1][m][0]), "+v"(acc[ai][1][m][1]));
                  if (m & 1) asm volatile("" ::: "memory"); } }
        row_partials(acc, s);
        st2.run(s, rstd, u, wr, wc, fr, fq, lds, wid, lane);
        f32x4 c2[2][2], sv[2][2];
#pragma unroll
        for (int bj = 0; bj < 2; ++bj)
#pragma unroll
            for (int n = 0; n < 2; ++n) { c2[bj][n] = *(const f32x4*)(g2 + colb + bj * HALF + 4 * n) * (*(const f32x4*)(sc + colb + bj * HALF + 4 * n) + 1.f); sv[bj][n] = *(const f32x4*)(sh + colb + bj * HALF + 4 * n); }
#pragma unroll
        for (int ai = 0; ai < 2; ++ai)
#pragma unroll
            for (int m = 0; m < 4; ++m) { unsigned short* rowp = h2 + (size_t)(row0 + ai * HALF + m * 16) * 2048 + colb;
#pragma unroll
                for (int bj = 0; bj < 2; ++bj) *(u32x4*)(rowp + bj * HALF) = pack_bf16x8(acc[ai][bj][m][0] * rstd[ai][m] * c2[bj][0] + sv[bj][0], acc[ai][bj][m][1] * rstd[ai][m] * c2[bj][1] + sv[bj][1]); }
    }
};
template <class Epi, class Sched, bool ALIGN_EPI = false, bool SP2 = false>
__device__ __forceinline__ void gemm_phase(PG8_LAS unsigned char* lds, const Gemm g, const Sched& S, const Epi& E) {
    const int tid = threadIdx.x, wid = __builtin_amdgcn_readfirstlane(tid >> 6), lane = tid & 63, wr = wid >> 2, wc = wid & 3, fr = lane & 15, fq = lane >> 4;
    const int K = g.K, nt = K / BK;
    unsigned voffA[2], voffB[2];
#pragma unroll
    for (int i = 0; i < 2; ++i) { int R, C; stage_rc(tid * 16 + i * 8192, R, C); const int Rb = Epi::PERM ? ((R & ~31) + perm32(R & 31)) : R;
        voffA[i] = (unsigned)(R * K + C) * 2u; voffB[i] = (unsigned)(Rb * K + C) * 2u; }
    const size_t kstep = (size_t)(BK * 2);
    const size_t hstep = (size_t)HALF * K * 2;
    const size_t tstep = 2 * hstep;
    const unsigned ldsw = (unsigned)wid * 1024u;
    const int aoff = lds_byte(wr * 64 + fr, fq * 8), boff = lds_byte(wc * 32 + fr, fq * 8);
#define PG8_SA(b, h) (((b) * 2 + (h)) * HTB)
#define PG8_SB(b, h) ((4 + (b) * 2 + (h)) * HTB)
#define PG8_STAGE(bufoff, gbase, voff) do { _Pragma("unroll") for (int _i = 0; _i < 2; ++_i) \
        __builtin_amdgcn_global_load_lds((const unsigned*)((const char*)(gbase) + (voff)[_i]), (PG8_LAS unsigned*)(lds + (bufoff) + ldsw + _i * 8192), 16, 0, 0); } while (0)
#define PG8_LDA(dst, b, h) do { _Pragma("unroll") for (int m = 0; m < 4; ++m) _Pragma("unroll") for (int k = 0; k < 2; ++k) dst[m][k] = *(const PG8_LAS bf16x8*)(lds + PG8_SA(b, h) + aoff + m * 2048 + k * 1024); } while (0)
#define PG8_LDB(dst, b, h) do { _Pragma("unroll") for (int n = 0; n < 2; ++n) _Pragma("unroll") for (int k = 0; k < 2; ++k) dst[n][k] = *(const PG8_LAS bf16x8*)(lds + PG8_SB(b, h) + boff + n * 2048 + k * 1024); } while (0)
#define PG8_MMA(ai, bj, At, Bt) do { __builtin_amdgcn_s_setprio(1); _Pragma("unroll") for (int m = 0; m < 4; ++m) _Pragma("unroll") for (int n = 0; n < 2; ++n) _Pragma("unroll") for (int k = 0; k < 2; ++k) \
        acc[ai][bj][m][n] = __builtin_amdgcn_mfma_f32_16x16x32_bf16(Bt[n][k], At[m][k], acc[ai][bj][m][n], 0, 0, 0); __builtin_amdgcn_s_setprio(0); } while (0)
#define PG8_WAIT_V(n) asm volatile("s_waitcnt vmcnt(" #n ")" ::: "memory")
#define PG8_WAIT_L(n) asm volatile("s_waitcnt lgkmcnt(" #n ")" ::: "memory")
#define PG8_BAR __builtin_amdgcn_s_barrier()
#define PG8_SCHED __builtin_amdgcn_sched_barrier(0)
    Unit cur, nxt; int ui = 0;
    if (!S.next(0, cur)) return;
    f32x4 acc[2][2][4][2];
#pragma unroll
    for (int a = 0; a < 2; ++a)
#pragma unroll
        for (int b = 0; b < 2; ++b)
#pragma unroll
            for (int m = 0; m < 4; ++m)
#pragma unroll
                for (int n = 0; n < 2; ++n) acc[a][b][m][n] = (f32x4){0.f, 0.f, 0.f, 0.f};
    bf16x8 At[4][2], B0[2][2], B1[2][2];
    const char* cA = (const char*)g.A + (size_t)cur.pm * tstep; const char* cB = (const char*)g.Bt + (size_t)cur.pn * tstep;
    S.a_ready(cur);
    if constexpr (SP2) {
        PG8_STAGE(PG8_SB(0, 0), cB, voffB); PG8_STAGE(PG8_SB(0, 1), cB + hstep, voffB); PG8_STAGE(PG8_SA(0, 0), cA, voffA); PG8_STAGE(PG8_SA(0, 1), cA + hstep, voffA);
        if (wr == 1) PG8_BAR;
        PG8_WAIT_V(2); PG8_BAR;
        PG8_STAGE(PG8_SB(1, 0), cB + kstep, voffB); PG8_STAGE(PG8_SA(1, 0), cA + kstep, voffA); PG8_STAGE(PG8_SB(1, 1), cB + hstep + kstep, voffB);
        PG8_WAIT_V(6); PG8_BAR;
    } else {
        PG8_STAGE(PG8_SB(0, 0), cB, voffB); PG8_STAGE(PG8_SA(0, 0), cA, voffA); PG8_STAGE(PG8_SB(0, 1), cB + hstep, voffB); PG8_STAGE(PG8_SA(0, 1), cA + hstep, voffA);
        if (wr == 1) PG8_BAR;
        PG8_WAIT_V(4); PG8_BAR;
        PG8_STAGE(PG8_SB(1, 0), cB + kstep, voffB); PG8_STAGE(PG8_SA(1, 0), cA + kstep, voffA); PG8_STAGE(PG8_SB(1, 1), cB + hstep + kstep, voffB);
        PG8_WAIT_V(6); PG8_BAR;
    }
    for (;;) {
        const bool has_next = S.next(ui + 1, nxt);
        const char* nA = has_next ? (const char*)g.A + (size_t)nxt.pm * tstep : cA; const char* nB = has_next ? (const char*)g.Bt + (size_t)nxt.pn * tstep : cB;
        for (int t = 0; t < nt; t += 2) {
            const bool last = (t == nt - 2);
            const char* a1 = cA + (size_t)(t + 1) * kstep;
            const char* a2 = last ? nA : cA + (size_t)(t + 2) * kstep; const char* b2 = last ? nB : cB + (size_t)(t + 2) * kstep;
            const char* a3 = a2 + kstep; const char* b3 = b2 + kstep;
            if (last && has_next) S.a_ready(nxt);
            if constexpr (SP2) {
            PG8_LDB(B0, 0, 0); PG8_LDB(B1, 0, 1); PG8_SCHED; PG8_LDA(At, 0, 0); PG8_STAGE(PG8_SA(1, 1), a1 + hstep, voffA);
            PG8_WAIT_V(8); PG8_WAIT_L(0); PG8_BAR; PG8_MMA(0, 0, At, B0); PG8_MMA(0, 1, At, B1); PG8_BAR; PG8_SCHED;
            PG8_LDA(At, 0, 1); PG8_STAGE(PG8_SB(0, 0), b2, voffB); PG8_STAGE(PG8_SB(0, 1), b2 + hstep, voffB); PG8_STAGE(PG8_SA(0, 0), a2, voffA);
            PG8_WAIT_V(8); PG8_WAIT_L(0); PG8_BAR; PG8_MMA(1, 0, At, B0); PG8_MMA(1, 1, At, B1); PG8_BAR; PG8_SCHED;
            PG8_LDB(B0, 1, 0); PG8_LDB(B1, 1, 1); PG8_SCHED; PG8_LDA(At, 1, 0); PG8_STAGE(PG8_SA(0, 1), a2 + hstep, voffA);
            PG8_WAIT_V(8); PG8_WAIT_L(0); PG8_BAR; PG8_MMA(0, 0, At, B0); PG8_MMA(0, 1, At, B1); PG8_BAR; PG8_SCHED;
            PG8_LDA(At, 1, 1); PG8_STAGE(PG8_SB(1, 0), b3, voffB); PG8_STAGE(PG8_SB(1, 1), b3 + hstep, voffB); PG8_STAGE(PG8_SA(1, 0), a3, voffA);
            PG8_WAIT_V(8); PG8_WAIT_L(0); PG8_BAR; PG8_MMA(1, 0, At, B0); PG8_MMA(1, 1, At, B1); PG8_BAR; PG8_SCHED;
            } else {
            PG8_LDB(B0, 0, 0); PG8_SCHED; PG8_LDA(At, 0, 0); PG8_STAGE(PG8_SA(1, 1), a1 + hstep, voffA);
            PG8_WAIT_L(8); PG8_BAR; PG8_WAIT_L(0); PG8_MMA(0, 0, At, B0); PG8_BAR; PG8_SCHED;
            PG8_LDB(B1, 0, 1); PG8_STAGE(PG8_SB(0, 0), b2, voffB);
            PG8_BAR; PG8_WAIT_L(0); PG8_MMA(0, 1, At, B1); PG8_BAR;
            PG8_LDA(At, 0, 1); PG8_STAGE(PG8_SA(0, 0), a2, voffA);
            PG8_BAR; PG8_WAIT_L(0); PG8_MMA(1, 0, At, B0); PG8_BAR; PG8_SCHED;
            PG8_STAGE(PG8_SB(0, 1), b2 + hstep, voffB);
            PG8_WAIT_V(6); PG8_BAR; PG8_MMA(1, 1, At, B1); PG8_BAR;
            PG8_LDB(B0, 1, 0); PG8_SCHED; PG8_LDA(At, 1, 0); PG8_STAGE(PG8_SA(0, 1), a2 + hstep, voffA);
            PG8_WAIT_L(8); PG8_BAR; PG8_WAIT_L(0); PG8_MMA(0, 0, At, B0); PG8_BAR; PG8_SCHED;
            PG8_LDB(B1, 1, 1); PG8_STAGE(PG8_SB(1, 0), b3, voffB);
            PG8_BAR; PG8_WAIT_L(0); PG8_MMA(0, 1, At, B1); PG8_BAR;
            PG8_LDA(At, 1, 1); PG8_STAGE(PG8_SA(1, 0), a3, voffA);
            PG8_BAR; PG8_WAIT_L(0); PG8_MMA(1, 0, At, B0); PG8_BAR; PG8_SCHED;
            PG8_STAGE(PG8_SB(1, 1), b3 + hstep, voffB);
            PG8_WAIT_V(6); PG8_BAR; PG8_MMA(1, 1, At, B1); PG8_BAR;
            }
        }
        if constexpr (ALIGN_EPI) { if (wr == 0) PG8_BAR; }
        if constexpr (!Epi::AFTER_DRAIN) { E(acc, cur, wr, wc, fr, fq); S.done(cur); }
        if (!has_next) break;
#pragma unroll
        for (int a = 0; a < 2; ++a)
#pragma unroll
            for (int b = 0; b < 2; ++b)
#pragma unroll
                for (int m = 0; m < 4; ++m)
#pragma unroll
                    for (int n = 0; n < 2; ++n) acc[a][b][m][n] = (f32x4){0.f, 0.f, 0.f, 0.f};
        cur = nxt; cA = nA; cB = nB; ++ui;
        if constexpr (ALIGN_EPI) { if (wr == 1) PG8_BAR; }
    }
    PG8_WAIT_V(0);
    if constexpr (!ALIGN_EPI) { if (wr == 0) PG8_BAR; }
    PG8_BAR;
    if constexpr (Epi::AFTER_DRAIN) { E.fused(acc, cur, wr, wc, fr, fq, lds, wid, lane); S.done(cur); }
#undef PG8_SA
#undef PG8_SB
#undef PG8_STAGE
#undef PG8_LDA
#undef PG8_LDB
#undef PG8_MMA
#undef PG8_WAIT_V
#undef PG8_WAIT_L
#undef PG8_BAR
#undef PG8_SCHED
}
}
namespace att {
typedef short bf16x8 __attribute__((ext_vector_type(8)));
typedef short s16x4 __attribute__((ext_vector_type(4)));
typedef float f32x16 __attribute__((ext_vector_type(16)));
typedef unsigned u32x4 __attribute__((ext_vector_type(4)));
constexpr int NW = 8, QBLK = 32, KVBLK = 64, QB = NW * QBLK;
constexpr int SHM_V = KVBLK * 128 * 2, SHM_K = KVBLK * 128 * 2, SHM_R = KVBLK * 64 * 2;
constexpr int OFF_V = 0, OFF_K = 2 * SHM_V, OFF_R = OFF_K + 2 * SHM_K, OFF_WS = OFF_R + 2 * SHM_R, OFF_QR = OFF_WS + NW * 64 * 4, LDS_BYTES = OFF_QR + NW * 4096;
constexpr float THR2 = 11.5f;
constexpr int LDQ = 2048, LDR = 1024, LDK = 2048, LDKR = 64;
#define LAS3 __attribute__((address_space(3)))
#define KSWZ(row, colB) ((row) * 256 + ((colB) ^ (((row) & 15) << 4)))
#define SBAR() __builtin_amdgcn_sched_barrier(0)
__device__ __forceinline__ int v_st(int k, int c) { const int kk = (k & ~0xC) | ((k & 4) << 1) | ((k & 8) >> 1); return ((kk >> 3) * 4 + (c >> 5)) * 512 + ((kk & 7) * 32 + (c & 31)) * 2; }
__device__ __forceinline__ int v_rd_base(int lane) { return ((lane & 3) << 3) | (((lane >> 2) & 3) << 6) | (((lane >> 4) & 1) << 5) | (((lane >> 5) & 1) << 8); }
constexpr int v_rd_off(int d0, int ks, int half) { return d0 * 512 + ks * 4096 + half * 2048; }
__device__ __forceinline__ int crow(int r, int hi) { return (r & 3) + 8 * (r >> 2) + 4 * hi; }
__device__ __forceinline__ unsigned cvtpk(float lo, float hi) { unsigned r; asm volatile("v_cvt_pk_bf16_f32 %0, %1, %2" : "=v"(r) : "v"(lo), "v"(hi)); return r; }
__device__ __forceinline__ bf16x8 ld8(const bf16_t* p) { return *reinterpret_cast<const bf16x8*>(p); }
__device__ __forceinline__ void mask_tile(f32x16& p0, f32x16& p1, int dq) {
    const float NEG = -__builtin_inff();
#pragma unroll
    for (int r = 0; r < 16; ++r) { const int c = (r & 3) + 8 * (r >> 2); if (dq - c < 0) p0[r] = NEG; if (dq - c - 32 < 0) p1[r] = NEG; }
}
__device__ __forceinline__ void partialSM(f32x16& p0, f32x16& p1, float& m_reg, float& mn, float& alpha) {
    float pmax = p0[0]; for (int r = 1; r < 16; ++r) pmax = fmaxf(pmax, p0[r]); for (int r = 0; r < 16; ++r) pmax = fmaxf(pmax, p1[r]);
    { auto rr = __builtin_amdgcn_permlane32_swap(__float_as_uint(pmax), __float_as_uint(pmax), false, false); pmax = fmaxf(__uint_as_float(rr[0]), __uint_as_float(rr[1])); }
    if (__builtin_expect(__all((pmax - m_reg) <= THR2), 1)) { mn = m_reg; alpha = 1.f; }
    else { mn = fmaxf(m_reg, pmax); alpha = __builtin_amdgcn_exp2f(m_reg - mn); m_reg = mn; }
    for (int r = 0; r < 16; ++r) p0[r] = p0[r] - mn; for (int r = 0; r < 16; ++r) p1[r] = p1[r] - mn;
    for (int r = 0; r < 16; ++r) p0[r] = __builtin_amdgcn_exp2f(p0[r]);
}
__device__ __forceinline__ void finishSM(f32x16& p0, f32x16& p1, float alpha, float& l_reg, bf16x8& pa0, bf16x8& pa1, bf16x8& pa2, bf16x8& pa3) {
    for (int r = 0; r < 16; ++r) p1[r] = __builtin_amdgcn_exp2f(p1[r]);
    float ps = 0; for (int r = 0; r < 16; ++r) ps += p0[r]; for (int r = 0; r < 16; ++r) ps += p1[r];
    { auto rr = __builtin_amdgcn_permlane32_swap(__float_as_uint(ps), __float_as_uint(ps), false, false); ps = __uint_as_float(rr[0]) + __uint_as_float(rr[1]); }
    l_reg = l_reg * alpha + ps;
#define PK4(P, B_, OUT) do { unsigned a0 = cvtpk(P[B_+0], P[B_+1]), a1 = cvtpk(P[B_+2], P[B_+3]); unsigned b0 = cvtpk(P[B_+4], P[B_+5]), b1 = cvtpk(P[B_+6], P[B_+7]); \
        auto r0 = __builtin_amdgcn_permlane32_swap(a0, b0, false, false); auto r1 = __builtin_amdgcn_permlane32_swap(a1, b1, false, false); \
        u32x4 w = {r0[0], r1[0], r0[1], r1[1]}; OUT = *reinterpret_cast<bf16x8*>(&w); } while (0)
    PK4(p0, 0, pa0); PK4(p0, 8, pa1); PK4(p1, 0, pa2); PK4(p1, 8, pa3);
#undef PK4
}
template <int KB> __device__ __forceinline__ void qkt(f32x16& p0, f32x16& p1, const char* lds, int r32, int hi, const bf16x8* qr, const char* qrl) {
    p0 = f32x16{}; p1 = f32x16{};
#pragma unroll
    for (int d0 = 0; d0 < 8; ++d0) { const char* a = lds + OFF_K + KB * SHM_K + KSWZ(r32, (d0 * 16 + hi * 8) * 2);
        bf16x8 b0 = *reinterpret_cast<const bf16x8*>(a); bf16x8 b1 = *reinterpret_cast<const bf16x8*>(a + 32 * 256);
        p0 = __builtin_amdgcn_mfma_f32_32x32x16_bf16(b0, qr[d0], p0, 0, 0, 0); p1 = __builtin_amdgcn_mfma_f32_32x32x16_bf16(b1, qr[d0], p1, 0, 0, 0);
        if (d0 == 3 || d0 == 7) SBAR(); }
#pragma unroll
    for (int d0 = 0; d0 < 4; ++d0) { const char* a = lds + OFF_R + KB * SHM_R + d0 * 2048 + r32 * 32 + hi * 16;
        bf16x8 b0 = *reinterpret_cast<const bf16x8*>(a); bf16x8 b1 = *reinterpret_cast<const bf16x8*>(a + 1024);
        const bf16x8 qf = *reinterpret_cast<const bf16x8*>(qrl + d0 * 1024);
        p0 = __builtin_amdgcn_mfma_f32_32x32x16_bf16(b0, qf, p0, 0, 0, 0); p1 = __builtin_amdgcn_mfma_f32_32x32x16_bf16(b1, qf, p1, 0, 0, 0); }
}
template <int VB> __device__ __forceinline__ void pv_tile(f32x16* o, int vb0, bf16x8 pa0, bf16x8 pa1, bf16x8 pa2, bf16x8 pa3) {
#define TRRD(dst, off) asm volatile("ds_read_b64_tr_b16 %0, %1 offset:%2" : "=&v"(dst) : "v"(vb0), "i"(off) : "memory")
#define PV_D0(d0) do { s16x4 l0, l1, l2, l3, h0, h1, h2, h3; constexpr int b_ = OFF_V + VB * SHM_V + v_rd_off(d0, 0, 0); \
        TRRD(l0, b_); TRRD(h0, b_ + 2048); TRRD(l1, b_ + 4096); TRRD(h1, b_ + 6144); TRRD(l2, b_ + 8192); TRRD(h2, b_ + 10240); TRRD(l3, b_ + 12288); TRRD(h3, b_ + 14336); \
        asm volatile("s_waitcnt lgkmcnt(0)" ::: "memory"); SBAR(); \
        o[d0] = __builtin_amdgcn_mfma_f32_32x32x16_bf16(pa0, (bf16x8){l0[0], l0[1], l0[2], l0[3], h0[0], h0[1], h0[2], h0[3]}, o[d0], 0, 0, 0); \
        o[d0] = __builtin_amdgcn_mfma_f32_32x32x16_bf16(pa1, (bf16x8){l1[0], l1[1], l1[2], l1[3], h1[0], h1[1], h1[2], h1[3]}, o[d0], 0, 0, 0); \
        o[d0] = __builtin_amdgcn_mfma_f32_32x32x16_bf16(pa2, (bf16x8){l2[0], l2[1], l2[2], l2[3], h2[0], h2[1], h2[2], h2[3]}, o[d0], 0, 0, 0); \
        o[d0] = __builtin_amdgcn_mfma_f32_32x32x16_bf16(pa3, (bf16x8){l3[0], l3[1], l3[2], l3[3], h3[0], h3[1], h3[2], h3[3]}, o[d0], 0, 0, 0); } while (0)
    PV_D0(0); PV_D0(1); PV_D0(2); PV_D0(3);
#undef PV_D0
#undef TRRD
}
struct BlockRef { const bf16_t* Qn; const bf16_t* Qr; const bf16_t* K; const bf16_t* V; bf16_t* O; int P0; };
#define DMA16(src, dstoff) __builtin_amdgcn_global_load_lds((const unsigned*)(src), (LAS3 unsigned*)(lds3 + (dstoff)), 16, 0, 0)
#define DMA_K(t, bf) do { const bf16_t* s_ = Kh + (size_t)(t) * (KVBLK * LDK); DMA16(s_ + koff0, OFF_K + (bf) * SHM_K + wid * 2048); DMA16(s_ + koff1, OFF_K + (bf) * SHM_K + wid * 2048 + 1024); } while (0)
#define DMA_V(t, bf) do { const bf16_t* s_ = Vh + (size_t)(t) * (KVBLK * LDK); DMA16(s_ + voff0, OFF_V + (bf) * SHM_V + wid * 2048); DMA16(s_ + voff0 + 64, OFF_V + (bf) * SHM_V + wid * 2048 + 1024); } while (0)
#define DMA_R(t, bf) DMA16(KR + (size_t)(t) * (KVBLK * LDKR) + roff, OFF_R + (bf) * SHM_R + wid * 1024)
#define WAIT_BAR() asm volatile("s_waitcnt vmcnt(0) lgkmcnt(0)\n\ts_barrier" ::: "memory")
__device__ __forceinline__ void block(const BlockRef& cur, const bf16_t* KR, char* lds, LAS3 unsigned char* lds3) {
    const int tid = threadIdx.x, wid = __builtin_amdgcn_readfirstlane(tid >> 6), lane = tid & 63, r32 = lane & 31, hi = lane >> 5;
    const int NT = (cur.P0 + QB) / KVBLK;
    const int qlo = cur.P0 + wid * QBLK, qm = qlo + r32 - 4 * hi;
    float* ws = (float*)(lds + OFF_WS) + wid * 64; float* li_l = ws, * al_l = ws + 32;
    float m_reg = -1e30f, l_reg = 0; f32x16 o[4] = {};
    const int vb0 = (int)(uintptr_t)lds + v_rd_base(lane);
    char* qrl = lds + OFF_QR + wid * 4096 + lane * 16;
    const bf16_t* Kh = cur.K; const bf16_t* Vh = cur.V;
    const int kr0 = (wid & 1) * 8 + (lane >> 4), kr1 = kr0 + 4;
    const int koff0 = (wid * 8 + (lane >> 4)) * LDK + (((lane & 15) ^ kr0) << 3), koff1 = (wid * 8 + 4 + (lane >> 4)) * LDK + (((lane & 15) ^ kr1) << 3);
    const int vkk = wid * 8 + ((lane & 31) >> 2), vk = (vkk & ~0xC) | ((vkk & 4) << 1) | ((vkk & 8) >> 1);
    const int voff0 = vk * LDK + (lane >> 5) * 32 + (lane & 3) * 8;
    const int roff = ((wid & 1) * 32 + (lane >> 1)) * LDKR + (wid >> 1) * 16 + (lane & 1) * 8;
    bf16x8 qr[8];
#define RESC(a) do { if (__any((a) < 1.f)) { if (hi == 0) al_l[r32] = (a); asm volatile("s_waitcnt lgkmcnt(0)" ::: "memory"); \
                     for (int d_ = 0; d_ < 4; ++d_) for (int r = 0; r < 16; ++r) o[d_][r] *= al_l[crow(r, hi)]; } } while (0)
#define KBASE(t) ((t) * KVBLK)
#define MASKT(P0_, P1_, t) do { const int kb_ = KBASE(t); if (kb_ + KVBLK - 1 > qlo) mask_tile(P0_, P1_, qm - kb_); } while (0)
    f32x16 pA0, pA1, pB0 = {}, pB1 = {}; float mnA, mnB, alA, alB = 1.f; bf16x8 pa0, pa1, pa2, pa3;
    DMA_K(0, 0); DMA_R(0, 0);
#pragma unroll
    for (int d0 = 0; d0 < 8; ++d0) qr[d0] = ld8(cur.Qn + (size_t)(wid * QBLK + r32) * LDQ + d0 * 16 + hi * 8);
    { bf16x8 t_[4];
#pragma unroll
      for (int d0 = 0; d0 < 4; ++d0) t_[d0] = ld8(cur.Qr + (size_t)(wid * QBLK + r32) * LDR + d0 * 16 + hi * 8);
#pragma unroll
      for (int d0 = 0; d0 < 4; ++d0) *(bf16x8*)(qrl + d0 * 1024) = t_[d0]; }
    WAIT_BAR();
    const int ldsa = (int)(uintptr_t)lds;
    const int kbase = ldsa + OFF_K + r32 * 256, hs4 = ((hi ^ (r32 & 15)) << 4), rb = ldsa + OFF_R + r32 * 32 + hi * 16, qb = ldsa + OFF_QR + wid * 4096 + lane * 16;
    bf16x8 kfa0, kfb0, qf0, kfa1, kfb1, qf1;
#define DSR128(dst, addr, off) asm volatile("ds_read_b128 %0, %1 offset:%2" : "=v"(dst) : "v"(addr), "i"(off) : "memory")
#define LGKM(n) asm volatile("s_waitcnt lgkmcnt(%0)" :: "i"(n) : "memory")
#define KREAD(S_, d0, KB) do { if ((d0) < 8) { const int ka_ = kbase + (hs4 ^ ((d0) << 5)); DSR128(kfa##S_, ka_, (KB) * SHM_K); DSR128(kfb##S_, ka_, (KB) * SHM_K + 8192); } \
        else if ((d0) < 12) { DSR128(kfa##S_, rb, (KB) * SHM_R + ((d0) - 8) * 2048); DSR128(kfb##S_, rb, (KB) * SHM_R + ((d0) - 8) * 2048 + 1024); DSR128(qf##S_, qb, ((d0) - 8) * 1024); } } while (0)
#define NRD(d0) ((d0) < 8 ? 2 : (d0) < 12 ? 3 : 0)
#define MF(S_, d0, PX0, PX1) do { const bf16x8 q_ = (d0) < 8 ? qr[(d0) < 8 ? (d0) : 0] : qf##S_; \
        PX0 = __builtin_amdgcn_mfma_f32_32x32x16_bf16(kfa##S_, q_, (d0) == 0 ? f32x16{} : PX0, 0, 0, 0); PX1 = __builtin_amdgcn_mfma_f32_32x32x16_bf16(kfb##S_, q_, (d0) == 0 ? f32x16{} : PX1, 0, 0, 0); } while (0)
#define PK4(P, B_, OUT) do { unsigned a0 = cvtpk(P[B_+0], P[B_+1]), a1 = cvtpk(P[B_+2], P[B_+3]); unsigned b0 = cvtpk(P[B_+4], P[B_+5]), b1 = cvtpk(P[B_+6], P[B_+7]); \
        auto r0 = __builtin_amdgcn_permlane32_swap(a0, b0, false, false); auto r1 = __builtin_amdgcn_permlane32_swap(a1, b1, false, false); \
        u32x4 w = {r0[0], r1[0], r0[1], r1[1]}; OUT = *reinterpret_cast<bf16x8*>(&w); } while (0)
#define FSLICE(g, PY0, PY1, alY) do { \
        if ((g) < 8) { PY1[2 * (g)] = __builtin_amdgcn_exp2f(PY1[2 * (g)]); PY1[2 * (g) + 1] = __builtin_amdgcn_exp2f(PY1[2 * (g) + 1]); } \
        if ((g) < 4) { ps_ += (PY0[4 * (g)] + PY0[4 * (g) + 1]) + (PY0[4 * (g) + 2] + PY0[4 * (g) + 3]); } \
        if ((g) >= 4) { ps_ += PY1[2 * ((g) - 4)] + PY1[2 * ((g) - 4) + 1]; } \
        if ((g) == 1) PK4(PY0, 0, pa0); if ((g) == 3) PK4(PY0, 8, pa1); if ((g) == 8) PK4(PY1, 0, pa2); if ((g) == 10) PK4(PY1, 8, pa3); \
        if ((g) == 11) { auto rr = __builtin_amdgcn_permlane32_swap(__float_as_uint(ps_), __float_as_uint(ps_), false, false); ps_ = __uint_as_float(rr[0]) + __uint_as_float(rr[1]); l_reg = l_reg * (alY) + ps_; } } while (0)
#define QSTEP(S_, S2_, d0, KB, FIN, PX0, PX1, PY0, PY1, alY) do { LGKM(NRD((d0) + 1)); SBAR(); __builtin_amdgcn_s_setprio(1); MF(S_, d0, PX0, PX1); __builtin_amdgcn_s_setprio(0); KREAD(S2_, (d0) + 2, KB); if (FIN) FSLICE(d0, PY0, PY1, alY); SBAR(); } while (0)
#define QKT_FIN(KB, FIN, PX0, PX1, PY0, PY1, alY) do { float ps_ = 0.f; SBAR(); KREAD(0, 0, KB); KREAD(1, 1, KB); \
        QSTEP(0, 0, 0, KB, FIN, PX0, PX1, PY0, PY1, alY); QSTEP(1, 1, 1, KB, FIN, PX0, PX1, PY0, PY1, alY); QSTEP(0, 0, 2, KB, FIN, PX0, PX1, PY0, PY1, alY); \
        QSTEP(1, 1, 3, KB, FIN, PX0, PX1, PY0, PY1, alY); QSTEP(0, 0, 4, KB, FIN, PX0, PX1, PY0, PY1, alY); QSTEP(1, 1, 5, KB, FIN, PX0, PX1, PY0, PY1, alY); \
        QSTEP(0, 0, 6, KB, FIN, PX0, PX1, PY0, PY1, alY); QSTEP(1, 1, 7, KB, FIN, PX0, PX1, PY0, PY1, alY); QSTEP(0, 0, 8, KB, FIN, PX0, PX1, PY0, PY1, alY); \
        QSTEP(1, 1, 9, KB, FIN, PX0, PX1, PY0, PY1, alY); QSTEP(0, 0, 10, KB, FIN, PX0, PX1, PY0, PY1, alY); QSTEP(1, 1, 11, KB, FIN, PX0, PX1, PY0, PY1, alY); } while (0)
#define TRRD(dst, off) asm volatile("ds_read_b64_tr_b16 %0, %1 offset:%2" : "=&v"(dst) : "v"(vb0), "i"(off) : "memory")
#define TRSET(X, VB, d0) do { constexpr int b_ = OFF_V + (VB) * SHM_V + v_rd_off(d0, 0, 0); TRRD(X##l0, b_); TRRD(X##h0, b_ + 2048); TRRD(X##l1, b_ + 4096); TRRD(X##h1, b_ + 6144); TRRD(X##l2, b_ + 8192); TRRD(X##h2, b_ + 10240); TRRD(X##l3, b_ + 12288); TRRD(X##h3, b_ + 14336); } while (0)
#define PVMF(X, d0) do { \
        o[d0] = __builtin_amdgcn_mfma_f32_32x32x16_bf16(pa0, (bf16x8){X##l0[0], X##l0[1], X##l0[2], X##l0[3], X##h0[0], X##h0[1], X##h0[2], X##h0[3]}, o[d0], 0, 0, 0); \
        o[d0] = __builtin_amdgcn_mfma_f32_32x32x16_bf16(pa1, (bf16x8){X##l1[0], X##l1[1], X##l1[2], X##l1[3], X##h1[0], X##h1[1], X##h1[2], X##h1[3]}, o[d0], 0, 0, 0); \
        o[d0] = __builtin_amdgcn_mfma_f32_32x32x16_bf16(pa2, (bf16x8){X##l2[0], X##l2[1], X##l2[2], X##l2[3], X##h2[0], X##h2[1], X##h2[2], X##h2[3]}, o[d0], 0, 0, 0); \
        o[d0] = __builtin_amdgcn_mfma_f32_32x32x16_bf16(pa3, (bf16x8){X##l3[0], X##l3[1], X##l3[2], X##l3[3], X##h3[0], X##h3[1], X##h3[2], X##h3[3]}, o[d0], 0, 0, 0); } while (0)
#define PV_PIPE(VB) do { s16x4 Al0, Al1, Al2, Al3, Ah0, Ah1, Ah2, Ah3, Bl0, Bl1, Bl2, Bl3, Bh0, Bh1, Bh2, Bh3; SBAR(); \
        TRSET(A, VB, 0); TRSET(B, VB, 1); LGKM(8); SBAR(); PVMF(A, 0); SBAR(); \
        TRSET(A, VB, 2); LGKM(8); SBAR(); PVMF(B, 1); SBAR(); \
        TRSET(B, VB, 3); LGKM(8); SBAR(); PVMF(A, 2); SBAR(); \
        LGKM(0); SBAR(); PVMF(B, 3); SBAR(); } while (0)
#define STEP(PX0, PX1, mnX, alX, PY0, PY1, alY, t, KB, VB) do { \
        if ((t) + 1 < NT) { DMA_K((t) + 1, VB); DMA_R((t) + 1, VB); } DMA_V((t), KB); \
        QKT_FIN(KB, true, PX0, PX1, PY0, PY1, alY); \
        PV_PIPE(VB); MASKT(PX0, PX1, (t)); partialSM(PX0, PX1, m_reg, mnX, alX); \
        RESC(alX); WAIT_BAR(); } while (0)
    DMA_K(1, 1); DMA_R(1, 1); DMA_V(0, 0);
    QKT_FIN(0, false, pA0, pA1, pB0, pB1, alB);
    MASKT(pA0, pA1, 0); partialSM(pA0, pA1, m_reg, mnA, alA);
    WAIT_BAR();
    for (int t = 1; t + 1 < NT; t += 2) {
        STEP(pB0, pB1, mnB, alB, pA0, pA1, alA, t, 1, 0);
        STEP(pA0, pA1, mnA, alA, pB0, pB1, alB, t + 1, 0, 1);
    }
    STEP(pB0, pB1, mnB, alB, pA0, pA1, alA, NT - 1, 1, 0);
    finishSM(pB0, pB1, alB, l_reg, pa0, pa1, pa2, pa3); SBAR(); PV_PIPE(1);
    if (hi == 0) li_l[r32] = l_reg; asm volatile("s_waitcnt lgkmcnt(0)" ::: "memory");
    float rli[16];
#pragma unroll
    for (int r = 0; r < 16; ++r) rli[r] = __builtin_amdgcn_rcpf(li_l[crow(r, hi)]);
    bf16_t* Ow = cur.O + (size_t)(wid * QBLK) * LDQ;
#pragma unroll
    for (int r = 0; r < 16; ++r) { const int orow = crow(r, hi);
#pragma unroll
        for (int d0 = 0; d0 < 4; ++d0) { const float v = o[d0][r] * rli[r]; const float vn = __shfl_xor(v, 1);
            if ((r32 & 1) == 0) *(unsigned*)(Ow + (size_t)orow * LDQ + d0 * 32 + r32) = cvtpk(v, vn); } }
    WAIT_BAR();
#undef RESC
#undef KBASE
#undef MASKT
#undef STEP
#undef DSR128
#undef LGKM
#undef KREAD
#undef NRD
#undef MF
#undef PK4
#undef FSLICE
#undef QSTEP
#undef QKT_FIN
#undef TRRD
#undef TRSET
#undef PVMF
#undef PV_PIPE
}
#undef DMA16
#undef DMA_K
#undef DMA_V
#undef DMA_R
#undef WAIT_BAR
__device__ __forceinline__ BlockRef make_ref(int h, int qb, const bf16_t* qn, const bf16_t* qr, const bf16_t* kn, const bf16_t* vm, bf16_t* ob) {
    BlockRef r; r.Qn = qn + (size_t)qb * QB * LDQ + h * 128; r.Qr = qr + (size_t)qb * QB * LDR + h * 64; r.K = kn + h * 128; r.V = vm + h * 128; r.O = ob + (size_t)qb * QB * LDQ + h * 128; r.P0 = qb * QB; return r;
}
__device__ __forceinline__ void phase(char* lds, LAS3 unsigned char* lds3, const bf16_t* qn, const bf16_t* qr, const bf16_t* kn, const bf16_t* kr, const bf16_t* vm, bf16_t* ob, int vcu, int G) {
    constexpr int NITEMS = H * 16;
    for (int L = vcu; L < NITEMS; L += G) {
        const int h = L >> 4, x = L & 15;
        block(make_ref(h, x, qn, qr, kn, vm, ob), kr, lds, lds3);
        block(make_ref(h, 31 - x, qn, qr, kn, vm, ob), kr, lds, lds3);
    }
}
#undef KSWZ
#undef LAS3
#undef SBAR
}
namespace hg {
typedef short bf16x8 __attribute__((ext_vector_type(8)));
typedef short s16x4 __attribute__((ext_vector_type(4)));
typedef float f32x16 __attribute__((ext_vector_type(16)));
typedef float f32x4 __attribute__((ext_vector_type(4)));
typedef unsigned u32x4 __attribute__((ext_vector_type(4)));
typedef unsigned u32x2 __attribute__((ext_vector_type(2)));
typedef _Float16 f16x8 __attribute__((ext_vector_type(8)));
#define LAS3 __attribute__((address_space(3)))
#define KSWZ(row, colB) ((row) * 256 + ((colB) ^ (((row) & 7) << 4)))
#define SBAR() __builtin_amdgcn_sched_barrier(0)
constexpr int O_QES = 0, O_KES = 16384, O_KET = 32768, O_V = 49152, O_ST = 65536, O_BL = 98304, O_SEG = 131072, O_DL = 133120, O_END = 133632;
constexpr int LD = 2048;
__device__ __forceinline__ int crow(int r, int hi) { return (r & 3) + 8 * (r >> 2) + 4 * hi; }
__device__ __forceinline__ unsigned cvtpk(float lo, float hi) { unsigned r; asm volatile("v_cvt_pk_bf16_f32 %0, %1, %2" : "=v"(r) : "v"(lo), "v"(hi)); return r; }
__device__ __forceinline__ int v_rd_base(int lane) { return ((lane & 3) << 3) | (((lane >> 2) & 3) << 6) | (((lane >> 4) & 1) << 5) | (((lane >> 5) & 1) << 8); }

struct Ptrs { const bf16_t* qh; const f16_t* g16; const bf16_t* v; const bf16_t* og; bf16_t* og_out; const float* ghg; float* U; float* Dg; };

template <bool OUT>
__device__ __forceinline__ void unit(char* lds, LAS3 unsigned char* lds3, const Ptrs& P, int h, int grp) {
    const int tid = threadIdx.x, wid = __builtin_amdgcn_readfirstlane(tid >> 6), lane = tid & 63, r32 = lane & 31, hi = lane >> 5;
    const int tb = wid & 1, vq = wid >> 1;
    const size_t colh = (size_t)h * 128;
    const int vkk = wid * 8 + ((lane & 31) >> 2), vk = (vkk & ~0xC) | ((vkk & 4) << 1) | ((vkk & 8) >> 1);
    const int voff0 = vk * LD + (lane >> 5) * 32 + (lane & 3) * 8;
    const int vb = (int)(uintptr_t)lds + O_V + v_rd_base(lane) + vq * 512;
    f32x16 Sf[2];
    float gsum[16];
#pragma unroll
    for (int j = 0; j < 16; ++j) gsum[j] = 0.f;
    if (OUT) {
        const float* Sin = P.U + ((size_t)(grp * 16 + h) * 128) * 128;
#pragma unroll
        for (int i = 0; i < 2; ++i)
#pragma unroll
            for (int r = 0; r < 16; ++r) Sf[i][r] = Sin[(size_t)(32 * (2 * tb + i) + crow(r, hi)) * 128 + 32 * vq + r32];
    } else { Sf[0] = f32x16{}; Sf[1] = f32x16{}; }
#define WRITE_ST() do { _Pragma("unroll") for (int i = 0; i < 2; ++i) _Pragma("unroll") for (int g = 0; g < 4; ++g) { const int row = 32 * vq + r32, ch = 4 * (2 * tb + i) + g; \
        u32x2 w; w.x = cvtpk(Sf[i][4 * g], Sf[i][4 * g + 1]); w.y = cvtpk(Sf[i][4 * g + 2], Sf[i][4 * g + 3]); \
        *(u32x2*)(lds + O_ST + row * 256 + ((ch * 16) ^ ((row & 7) << 4)) + 8 * hi) = w; } } while (0)
    if (OUT) WRITE_ST();
#define BAR_L() asm volatile("s_waitcnt lgkmcnt(0)\n\ts_barrier" ::: "memory")
#define BAR_VL() asm volatile("s_waitcnt vmcnt(0) lgkmcnt(0)\n\ts_barrier" ::: "memory")
#define GLDS16(src, dst) do { unsigned keep_; asm volatile("s_mov_b32 %0, m0\n\ts_mov_b32 m0, %2\n\ts_nop 0\n\tglobal_load_lds_dwordx4 %1, off\n\ts_mov_b32 m0, %0" : "=&s"(keep_) : "v"(src), "s"(dst) : "memory"); } while (0)
    const unsigned vdst = (unsigned)__builtin_amdgcn_readfirstlane((int)(uintptr_t)lds + O_V + wid * 2048);
#define DMA_V(tok) do { const bf16_t* s_ = P.v + (size_t)(tok) * LD + colh; GLDS16(s_ + voff0, vdst); GLDS16(s_ + voff0 + 64, vdst + 1024u); } while (0)
    const int t = lane, kc = wid * 16, to = tid >> 3, vc = (tid & 7) * 16;
    const size_t grow = ((size_t)grp * 512 + t) * LD + colh + kc, orow = ((size_t)grp * 512 + to) * LD + colh + vc;
    f16x8 g0 = *(const f16x8*)(P.g16 + grow), g1 = *(const f16x8*)(P.g16 + grow + 8);
    bf16x8 q0 = {}, q1 = {};
    if (OUT) { q0 = *(const bf16x8*)(P.qh + grow); q1 = *(const bf16x8*)(P.qh + grow + 8); }
    DMA_V((size_t)grp * 512);
    for (int c = 0; c < 8; ++c) {
        const size_t tok0 = (size_t)grp * 512 + c * 64;
        float gl[16], b[16];
#pragma unroll
        for (int j = 0; j < 16; ++j) { gl[j] = (float)(j < 8 ? g0[j] : g1[j - 8]); float x = gl[j];
            x += __int_as_float(__builtin_amdgcn_update_dpp(0, __float_as_int(x), 0x111, 0xF, 0xF, false));
            x += __int_as_float(__builtin_amdgcn_update_dpp(0, __float_as_int(x), 0x112, 0xF, 0xF, false));
            x += __int_as_float(__builtin_amdgcn_update_dpp(0, __float_as_int(x), 0x114, 0xF, 0xF, false));
            x += __int_as_float(__builtin_amdgcn_update_dpp(0, __float_as_int(x), 0x118, 0xF, 0xF, false));
            x += __int_as_float(__builtin_amdgcn_update_dpp(0, __float_as_int(x), 0x142, 0xA, 0xF, false));
            x += __int_as_float(__builtin_amdgcn_update_dpp(0, __float_as_int(x), 0x143, 0xC, 0xF, false));
            b[j] = x; }
        { float ke[16];
#pragma unroll
          for (int j = 0; j < 16; ++j) ke[j] = (1.f - __expf(gl[j])) * __expf(-b[j]);
          if (OUT) { float qe[16];
#pragma unroll
              for (int j = 0; j < 16; ++j) qe[j] = bf2f((bf16_t)(j < 8 ? q0[j] : q1[j - 8])) * __expf(b[j]);
              u32x4 w0 = {cvtpk(qe[0], qe[1]), cvtpk(qe[2], qe[3]), cvtpk(qe[4], qe[5]), cvtpk(qe[6], qe[7])}, w1 = {cvtpk(qe[8], qe[9]), cvtpk(qe[10], qe[11]), cvtpk(qe[12], qe[13]), cvtpk(qe[14], qe[15])};
              *(u32x4*)(lds + O_QES + KSWZ(t, kc * 2)) = w0; *(u32x4*)(lds + O_QES + KSWZ(t, kc * 2 + 16)) = w1;
              u32x4 k0 = {cvtpk(ke[0], ke[1]), cvtpk(ke[2], ke[3]), cvtpk(ke[4], ke[5]), cvtpk(ke[6], ke[7])}, k1 = {cvtpk(ke[8], ke[9]), cvtpk(ke[10], ke[11]), cvtpk(ke[12], ke[13]), cvtpk(ke[14], ke[15])};
              *(u32x4*)(lds + O_KES + KSWZ(t, kc * 2)) = k0; *(u32x4*)(lds + O_KES + KSWZ(t, kc * 2 + 16)) = k1; }
          { char* kt = lds + O_KET + (t >> 4) * 4096 + kc * 32 + ((t >> 3) & 1) * 16 + (t & 7) * 2;
#pragma unroll
            for (int j = 0; j < 16; j += 2) { const unsigned w = cvtpk(ke[j], ke[j + 1]); *(unsigned short*)(kt + j * 32) = (unsigned short)(w & 0xffffu); *(unsigned short*)(kt + (j + 1) * 32) = (unsigned short)(w >> 16); } }
          if (t == 63) {
#pragma unroll
              for (int j = 0; j < 16; ++j) { ((float*)(lds + O_DL))[kc + j] = __expf(b[j]); gsum[j] += b[j]; } } }
        BAR_VL();
        bf16x8 e0 = {}, e1 = {};
        if (OUT) { e0 = *(const bf16x8*)(P.og + orow + (size_t)c * 64 * LD); e1 = *(const bf16x8*)(P.og + orow + (size_t)c * 64 * LD + 8); }
        if (c < 7) { const size_t nx = grow + (size_t)(c + 1) * 64 * LD; g0 = *(const f16x8*)(P.g16 + nx); g1 = *(const f16x8*)(P.g16 + nx + 8);
            if (OUT) { q0 = *(const bf16x8*)(P.qh + nx); q1 = *(const bf16x8*)(P.qh + nx + 8); } }
        bf16x8 vf[4];
        { s16x4 lo[4], hh[4];
#pragma unroll
          for (int ks = 0; ks < 4; ++ks) { asm volatile("ds_read_b64_tr_b16 %0, %1 offset:%2" : "=&v"(lo[ks]) : "v"(vb), "i"(ks * 4096) : "memory"); asm volatile("ds_read_b64_tr_b16 %0, %1 offset:%2" : "=&v"(hh[ks]) : "v"(vb), "i"(ks * 4096 + 2048) : "memory"); }
          asm volatile("s_waitcnt lgkmcnt(0)" ::: "memory"); SBAR();
#pragma unroll
          for (int ks = 0; ks < 4; ++ks) vf[ks] = (bf16x8){lo[ks][0], lo[ks][1], lo[ks][2], lo[ks][3], hh[ks][0], hh[ks][1], hh[ks][2], hh[ks][3]}; }
        f32x16 o = f32x16{};
        if (OUT) {
            bf16x8 qr[8], kf[8];
#pragma unroll
            for (int ks = 0; ks < 8; ++ks) qr[ks] = *(const bf16x8*)(lds + O_QES + KSWZ(32 * tb + r32, (ks * 16 + hi * 8) * 2));
#pragma unroll
            for (int ks = 0; ks < 8; ++ks) kf[ks] = *(const bf16x8*)(lds + O_KES + KSWZ(r32, (ks * 16 + hi * 8) * 2));
            SBAR();
            f32x16 p0 = f32x16{}, p1 = f32x16{};
#pragma unroll
            for (int ks = 0; ks < 8; ++ks) p0 = __builtin_amdgcn_mfma_f32_32x32x16_bf16(kf[ks], qr[ks], p0, 0, 0, 0);
            if (tb == 1) {
#pragma unroll
                for (int ks = 0; ks < 8; ++ks) kf[ks] = *(const bf16x8*)(lds + O_KES + KSWZ(32 + r32, (ks * 16 + hi * 8) * 2));
                SBAR();
#pragma unroll
                for (int ks = 0; ks < 8; ++ks) p1 = __builtin_amdgcn_mfma_f32_32x32x16_bf16(kf[ks], qr[ks], p1, 0, 0, 0);
#pragma unroll
                for (int r = 0; r < 16; ++r) if (crow(r, hi) > r32) p1[r] = 0.f;
            } else {
#pragma unroll
                for (int r = 0; r < 16; ++r) if (crow(r, hi) > r32) p0[r] = 0.f;
            }
#pragma unroll
            for (int ks = 0; ks < 8; ++ks) kf[ks] = *(const bf16x8*)(lds + O_ST + KSWZ(32 * vq + r32, (ks * 16 + hi * 8) * 2));
            SBAR();
            bf16x8 pa0, pa1, pa2, pa3;
#define PK4(Pv, B_, OUTF) do { unsigned a0 = cvtpk(Pv[B_+0], Pv[B_+1]), a1 = cvtpk(Pv[B_+2], Pv[B_+3]); unsigned b0 = cvtpk(Pv[B_+4], Pv[B_+5]), b1 = cvtpk(Pv[B_+6], Pv[B_+7]); \
        auto r0 = __builtin_amdgcn_permlane32_swap(a0, b0, false, false); auto r1 = __builtin_amdgcn_permlane32_swap(a1, b1, false, false); \
        u32x4 w = {r0[0], r1[0], r0[1], r1[1]}; OUTF = *reinterpret_cast<bf16x8*>(&w); } while (0)
            PK4(p0, 0, pa0); PK4(p0, 8, pa1); PK4(p1, 0, pa2); PK4(p1, 8, pa3);
#undef PK4
            o = __builtin_amdgcn_mfma_f32_32x32x16_bf16(pa0, vf[0], o, 0, 0, 0); o = __builtin_amdgcn_mfma_f32_32x32x16_bf16(pa1, vf[1], o, 0, 0, 0);
            o = __builtin_amdgcn_mfma_f32_32x32x16_bf16(pa2, vf[2], o, 0, 0, 0); o = __builtin_amdgcn_mfma_f32_32x32x16_bf16(pa3, vf[3], o, 0, 0, 0);
#pragma unroll
            for (int ks = 0; ks < 8; ++ks) o = __builtin_amdgcn_mfma_f32_32x32x16_bf16(qr[ks], kf[ks], o, 0, 0, 0);
        }
        bf16x8 tf[2][4];
#pragma unroll
        for (int i = 0; i < 2; ++i)
#pragma unroll
            for (int ks = 0; ks < 4; ++ks) tf[i][ks] = *(const bf16x8*)(lds + O_KET + ks * 4096 + (32 * (2 * tb + i) + r32) * 32 + hi * 16);
        SBAR();
#pragma unroll
        for (int i = 0; i < 2; ++i) { const int kb = 2 * tb + i; f32x16 acc = f32x16{};
#pragma unroll
            for (int ks = 0; ks < 4; ++ks) acc = __builtin_amdgcn_mfma_f32_32x32x16_bf16(tf[i][ks], vf[ks], acc, 0, 0, 0);
#pragma unroll
            for (int g = 0; g < 4; ++g) { const f32x4 dv = *(const f32x4*)((const float*)(lds + O_DL) + 32 * kb + 8 * g + 4 * hi);
#pragma unroll
                for (int e = 0; e < 4; ++e) Sf[i][4 * g + e] = dv[e] * (Sf[i][4 * g + e] + acc[4 * g + e]); } }
        if (OUT) { float* ot = (float*)(lds + O_BL);
#pragma unroll
            for (int r = 0; r < 16; ++r) ot[(32 * tb + crow(r, hi)) * 128 + 32 * vq + r32] = o[r]; }
        BAR_L();
        if (c < 7) DMA_V(tok0 + 64);
        if (OUT) {
            WRITE_ST();
            { const float* ot = (const float*)(lds + O_BL) + to * 128 + vc; float x[16]; float ss = 0.f;
#pragma unroll
              for (int j4 = 0; j4 < 4; ++j4) { const f32x4 y = *(const f32x4*)(ot + 4 * j4); x[4 * j4] = y[0]; x[4 * j4 + 1] = y[1]; x[4 * j4 + 2] = y[2]; x[4 * j4 + 3] = y[3]; ss += (y[0] * y[0] + y[1] * y[1]) + (y[2] * y[2] + y[3] * y[3]); }
              ss += __shfl_xor(ss, 1); ss += __shfl_xor(ss, 2); ss += __shfl_xor(ss, 4);
              const float rstd = rsqrtf(ss * (1.f / 128.f) + EPS);
              bf16_t* op = P.og_out + (tok0 + to) * LD + colh + vc;
#pragma unroll
              for (int j4 = 0; j4 < 4; ++j4) { const f32x4 gw = *(const f32x4*)(P.ghg + vc + 4 * j4);
#pragma unroll
                  for (int e = 0; e < 4; ++e) { const int j = 4 * j4 + e; x[j] = x[j] * rstd * gw[e] * bf2f((bf16_t)(j < 8 ? e0[j] : e1[j - 8])); } }
              u32x4 w0 = {cvtpk(x[0], x[1]), cvtpk(x[2], x[3]), cvtpk(x[4], x[5]), cvtpk(x[6], x[7])}, w1 = {cvtpk(x[8], x[9]), cvtpk(x[10], x[11]), cvtpk(x[12], x[13]), cvtpk(x[14], x[15])};
              *(u32x4*)op = w0; *(u32x4*)(op + 8) = w1; }
        }
    }
    BAR_VL();
#undef BAR_L
#undef BAR_VL
#undef DMA_V
#undef GLDS16
    if (!OUT) {
        float* Uo = P.U + ((size_t)(grp * 16 + h) * 128) * 128;
#pragma unroll
        for (int i = 0; i < 2; ++i)
#pragma unroll
            for (int r = 0; r < 16; ++r) Uo[(size_t)(32 * (2 * tb + i) + crow(r, hi)) * 128 + 32 * vq + r32] = Sf[i][r];
        if (lane == 63) {
#pragma unroll
            for (int j = 0; j < 16; ++j) P.Dg[(size_t)(grp * 16 + h) * 128 + kc + j] = __expf(gsum[j]); }
    }
#undef WRITE_ST
}
template <bool OUT> __device__ __forceinline__ void phase(char* lds, LAS3 unsigned char* lds3, const Ptrs& P, int vcu, int G) {
    for (int u = vcu; u < 256; u += G) unit<OUT>(lds, lds3, P, u >> 4, u & 15);
}
__device__ __forceinline__ void scan_phase(float* U, const float* Dg, int gt, int NGT) {
    for (int e = gt; e < 16 * 128 * 128; e += NGT) { const int hk = e >> 7; float cur = 0.f;
#pragma unroll
        for (int g = 0; g < 16; ++g) { const size_t idx = (size_t)g * (16 * 128 * 128) + e; const float u = U[idx], d = Dg[(size_t)g * (16 * 128) + hk]; U[idx] = cur; cur = d * cur + u; } }
}
#undef LAS3
#undef KSWZ
#undef SBAR
}
#define GAS __attribute__((address_space(1)))
#define LAS __attribute__((address_space(3)))
typedef float f32x4 __attribute__((ext_vector_type(4)));
typedef unsigned v4u __attribute__((ext_vector_type(4)));
typedef unsigned v2u __attribute__((ext_vector_type(2)));
constexpr int NWAVES = 8, NTHREADS = 512;
constexpr int RING_BYTES = 131072, LDS_BYTES = 147456;
constexpr int MISC_OFF = LDS_BYTES - 256, CW_BAR = 4096, CW_TMO = 64, CW_SEAM = 16384;
constexpr bool FUSE_NORM = false;
#define LDS_WAIT() asm volatile("s_waitcnt lgkmcnt(0)" ::: "memory")
__device__ __forceinline__ unsigned pk2(float lo, float hi) { return (unsigned)f2bf(lo) | ((unsigned)f2bf(hi) << 16); }
__device__ __forceinline__ float wave_sum(float v) {
#pragma unroll
    for (int o = 1; o < 64; o <<= 1) v += __shfl_xor(v, o);
    return v;
}
#define XB_TMO      128
#define XB_XCNT(j)  (256  + 64 * (j))
#define XB_XSUB(j)  (1280 + 64 * (j))
#define XB_XGEN(j)  (2304 + 64 * (j))
#define XB_TOP      3328
#define XB_TOPGEN   3392
#define XCD_BAR_WORDS 3456
#define XB_SPIN_CAP (1u << 18)

__device__ __forceinline__ unsigned xb_ld(unsigned* p)              { return __hip_atomic_load(p, __ATOMIC_RELAXED, __HIP_MEMORY_SCOPE_AGENT); }
__device__ __forceinline__ unsigned xb_add(unsigned* p, unsigned v) { return __hip_atomic_fetch_add(p, v, __ATOMIC_RELAXED, __HIP_MEMORY_SCOPE_AGENT); }
__device__ __forceinline__ unsigned xb_xcc_id() { return (unsigned)__builtin_amdgcn_s_getreg((3 << 11) | 20) & 0xFu; }
#define XB_SPIN(cond, bar) do { unsigned _sp = 0; while (cond) { __builtin_amdgcn_s_sleep(1); \
    if ((++_sp & 255u) == 0u) { if (xb_ld(&(bar)[XB_TMO])) break; if (_sp > XB_SPIN_CAP) { atomicAdd(&(bar)[XB_TMO], 1u); break; } } } } while (0)

struct XcdBarrier {
    unsigned* bar; unsigned x;
    volatile LAS unsigned* st;
};

__device__ __forceinline__ XcdBarrier xcd_barrier_post(unsigned* bar, volatile LAS unsigned* st) {
    XcdBarrier b; b.bar = bar; b.x = xb_xcc_id(); b.st = st;
    if (threadIdx.x == 0) (void)xb_add(&bar[XB_XCNT(b.x)], 1u);
    return b;
}
__device__ __forceinline__ void xcd_barrier_complete(unsigned* bar, unsigned x, unsigned& nloc, unsigned& nx) {
    const unsigned G = gridDim.x * gridDim.y * gridDim.z;
    unsigned sum, cnt, mine, sp = 0u;
    for (;;) {
        sum = 0u; cnt = 0u; mine = 0u;
#pragma unroll
        for (unsigned j = 0; j < 16; ++j) { const unsigned c = xb_ld(&bar[XB_XCNT(j)]); sum += c; cnt += (c > 0u) ? 1u : 0u; mine = (j == x) ? c : mine; }
        if (sum == G) break;
        __builtin_amdgcn_s_sleep(1);
        if ((++sp & 255u) == 0u) { if (xb_ld(&bar[XB_TMO])) break; if (sp > XB_SPIN_CAP) { atomicAdd(&bar[XB_TMO], 1u); break; } }
    }
    nloc = mine > 0u ? mine : 1u; nx = cnt > 0u ? cnt : 1u;
}

__device__ __forceinline__ void xcd_barrier(const XcdBarrier& b) {
    asm volatile("s_waitcnt vmcnt(0)" ::: "memory");
    __syncthreads();
    if (threadIdx.x == 0) {
        unsigned* bar = b.bar;
        __builtin_amdgcn_s_waitcnt(0);
        unsigned nloc = b.st[0], nx = b.st[1];
        if (nloc == 0u) { xcd_barrier_complete(bar, b.x, nloc, nx); b.st[0] = nloc; b.st[1] = nx; }
        const unsigned old = xb_add(&bar[XB_XSUB(b.x)], 1u);
        const unsigned gen = old / nloc;
        if (old + 1u == (gen + 1u) * nloc) {
            __builtin_amdgcn_fence(__ATOMIC_RELEASE, "agent");
            asm volatile("s_waitcnt vmcnt(0)" ::: "memory");
            const unsigned og = xb_add(&bar[XB_TOP], 1u);
            const unsigned tg = og / nx;
            if (og + 1u == (tg + 1u) * nx) xb_add(&bar[XB_TOPGEN], 1u);
            else XB_SPIN(xb_ld(&bar[XB_TOPGEN]) == tg, bar);
            __builtin_amdgcn_fence(__ATOMIC_ACQUIRE, "agent");
            xb_add(&bar[XB_XGEN(b.x)], 1u);
            asm volatile("s_waitcnt vmcnt(0)" ::: "memory");
        } else {
            XB_SPIN(xb_ld(&bar[XB_XGEN(b.x)]) == gen, bar);
            __builtin_amdgcn_fence(__ATOMIC_ACQUIRE, "agent");
            asm volatile("s_waitcnt vmcnt(0)" ::: "memory");
        }
    }
    __syncthreads();
}

struct Args { const void* in[21]; float* out; unsigned char* ws; int ph_lo, ph_hi; };

template <int MAP> __device__ __forceinline__ int src_map(int n) { return MAP == 0 ? src_in(n) : MAP == 1 ? src_uq(n) : MAP == 2 ? src_gu(n) : n; }
template <int MAP> __device__ __forceinline__ void p0_transpose_item(const float* W, int K, int N, int NP, const float* scale, bf16_t* WT, LAS float* scr, int item, int lane) {
    const int nblk = NP / 64, kb = item / nblk, nb = item % nblk, k0 = 64 * kb, n0 = 64 * nb;
    const int nq = (lane & 15) * 4, kr = lane >> 4;
    const int s0 = src_map<MAP>(n0 + nq), s1 = src_map<MAP>(n0 + nq + 1), s2 = src_map<MAP>(n0 + nq + 2), s3 = src_map<MAP>(n0 + nq + 3);
    f32x4 v[16];
    if (__all(s0 >= 0 && s1 == s0 + 1 && s2 == s0 + 2 && s3 == s0 + 3)) {
#pragma unroll
        for (int i = 0; i < 16; ++i) v[i] = *(const f32x4*)(W + (size_t)(k0 + 4 * i + kr) * N + s0);
    } else {
#pragma unroll
        for (int i = 0; i < 16; ++i) { const float* wr = W + (size_t)(k0 + 4 * i + kr) * N; v[i][0] = s0 >= 0 ? wr[s0] : 0.f; v[i][1] = s1 >= 0 ? wr[s1] : 0.f; v[i][2] = s2 >= 0 ? wr[s2] : 0.f; v[i][3] = s3 >= 0 ? wr[s3] : 0.f; }
    }
    if (scale) {
#pragma unroll
        for (int i = 0; i < 16; ++i) v[i] *= scale[k0 + 4 * i + kr]; }
#pragma unroll
    for (int i = 0; i < 16; ++i)
#pragma unroll
        for (int q = 0; q < 4; ++q) scr[(nq + q) * 65 + 4 * i + kr] = v[i][q];
    LDS_WAIT(); asm volatile("" ::: "memory");
    const int c = lane & 7;
#pragma unroll
    for (int j = 0; j < 8; ++j) { const int n = (lane >> 3) + 8 * j; const LAS float* s = scr + n * 65 + 8 * c;
        v4u o; o.x = pk2(s[0], s[1]); o.y = pk2(s[2], s[3]); o.z = pk2(s[4], s[5]); o.w = pk2(s[6], s[7]);
        *(GAS v4u*)(WT + (size_t)(n0 + n) * K + k0 + 8 * c) = o; }
    LDS_WAIT(); asm volatile("" ::: "memory");
}
__device__ __forceinline__ void p0_convert(const Args& a, LAS unsigned char* lds, int vcu, int G, int wave, int lane) {
    unsigned char* ws = a.ws;
    { LAS float* scr = (LAS float*)(lds + wave * 16640);
      const int gw = vcu * NWAVES + wave, NGW = G * NWAVES;
      constexpr int I_IN = (D / 64) * (IN_WP / 64), I_UQ = (QL / 64) * (UQ_W / 64), I_UKV = (KVL / 64) * (UKV_W / 64);
      constexpr int NITEMS = I_IN + I_UQ + I_UKV;
      for (int it = gw; it < NITEMS; it += NGW) { int r = it;
          if (r < I_IN) { p0_transpose_item<0>((const float*)a.in[6], D, IN_W, IN_WP, nullptr, (bf16_t*)(ws + WS_WIN), scr, r, lane); continue; } r -= I_IN;
          if (r < I_UQ) { p0_transpose_item<1>((const float*)a.in[11], QL, UQ_W, UQ_W, (const float*)a.in[10], (bf16_t*)(ws + WS_WUQ), scr, r, lane); continue; } r -= I_UQ;
          p0_transpose_item<3>((const float*)a.in[13], KVL, UKV_W, UKV_W, (const float*)a.in[12], (bf16_t*)(ws + WS_WUKV), scr, r, lane);
      } }
    __syncthreads();
}
__device__ __forceinline__ void p0_prologue(const Args& a, LAS unsigned char* lds, int vcu, int G, int wave, int lane, int tid) {
    unsigned char* ws = a.ws;
    { const int gt = vcu * NTHREADS + tid, NGT = G * NTHREADS; const int* pos = (const int*)a.in[2]; float* rope = (float*)(ws + WS_ROPE);
      const int j = gt & 31; const float inv = (float)pow(10000.0, -(double)(2 * j) / 64.0);
      for (int i = gt; i < S * 32; i += NGT) { const int t = i >> 5; const float ang = (float)pos[t] * inv; double sn, cs; sincos((double)ang, &sn, &cs);
          rope[2 * i] = (float)cs; rope[2 * i + 1] = (float)sn; }
      if (gt < 2048) { const float* ll = (const float*)a.in[7]; const float x0 = ll[gt], x1 = ll[2048 + gt], m = fmaxf(x0, x1); const float e0 = expf(x0 - m), e1 = expf(x1 - m); ((float*)(ws + WS_LB))[gt] = e0 / (e0 + e1); } }
    { LAS float* sc = (LAS float*)lds; LAS float* part = (LAS float*)(lds + 8192);
      const float* c = (const float*)a.in[1]; const float* w_ada = (const float*)a.in[3]; const float* b_ada = (const float*)a.in[4];
      for (int i = tid; i < D; i += NTHREADS) { const float cv = c[i]; sc[i] = cv / (1.f + expf(-cv)); }
      __syncthreads();
      for (int cb = vcu; cb < (NMOD * D) / 48; cb += G) {
          const int rg = tid / 12, cg = tid % 12; f32x4 acc = {0.f, 0.f, 0.f, 0.f};
          if (rg < 42) { const float* wp = w_ada + (size_t)cb * 48 + cg * 4;
              for (int r0 = rg; r0 < D; r0 += 42 * 7) { f32x4 w[7];
#pragma unroll
                  for (int u = 0; u < 7; ++u) { const int r = r0 + 42 * u; w[u] = r < D ? *(const f32x4*)(wp + (size_t)r * (NMOD * D)) : (f32x4){0.f, 0.f, 0.f, 0.f}; }
#pragma unroll
                  for (int u = 0; u < 7; ++u) { const int r = r0 + 42 * u; if (r < D) acc += w[u] * sc[r]; } }
              *(LAS f32x4*)(part + rg * 48 + cg * 4) = acc; }
          __syncthreads();
          if (tid < 48) { float s = 0.f; for (int r = 0; r < 42; ++r) s += part[r * 48 + tid]; ((float*)(ws + WS_MOD))[cb * 48 + tid] = s + b_ada[cb * 48 + tid]; }
          __syncthreads();
      } }
}
template <int MAP> __device__ __forceinline__ void tail_convert(const float* W, int K, int N, int NP, bf16_t* WT, LAS unsigned char* lds, int nwg, int G, int c, int wave, int lane) {
    const int rounds = (nwg + G - 1) / G, nlast = nwg - (rounds - 1) * G;
    if (c < nlast || nlast == G) { if (nlast != G) return; }
    const int nworkers = nlast == G ? G : G - nlast, w = nlast == G ? c : c - nlast;
    LAS float* scr = (LAS float*)(lds + wave * 16640);
    const int nitems = (K / 64) * (NP / 64);
    for (int it = w * NWAVES + wave; it < nitems; it += nworkers * NWAVES) p0_transpose_item<MAP>(W, K, N, NP, nullptr, WT, scr, it, lane);
    __syncthreads();
}
__device__ __forceinline__ void p1_rows_h(const Args& a, int gw, int NGW, int lane) {
    const float* x = (const float*)a.in[0]; const float* g = (const float*)a.in[5]; const float* mod = (const float*)(a.ws + WS_MOD); bf16_t* h = (bf16_t*)(a.ws + WS_H);
    for (int row = gw; row < S; row += NGW) {
        const f32x4* xr = (const f32x4*)(x + (size_t)row * D) + lane; f32x4 v[8]; float ss = 0.f;
#pragma unroll
        for (int j = 0; j < 8; ++j) { v[j] = xr[64 * j]; ss += (v[j][0] * v[j][0] + v[j][1] * v[j][1]) + (v[j][2] * v[j][2] + v[j][3] * v[j][3]); }
        const float rstd = rsqrtf(wave_sum(ss) * (1.f / D) + EPS);
        v2u* o = (v2u*)(h + (size_t)row * D) + lane;
#pragma unroll
        for (int j = 0; j < 8; ++j) { const int cidx = 64 * j + lane; const f32x4 gg = ((const f32x4*)g)[cidx], sh = ((const f32x4*)mod)[cidx], sc = ((const f32x4*)(mod + 2048))[cidx];
            const f32x4 r = v[j] * rstd * gg * (sc + 1.f) + sh; v2u w; w.x = pk2(r[0], r[1]); w.y = pk2(r[2], r[3]); o[64 * j] = w; }
    }
}
__device__ __forceinline__ void p9_rows_mid(const Args& a, int gw, int NGW, int lane) {
    const float* x = (const float*)a.in[0]; const bf16_t* y = (const bf16_t*)(a.ws + WS_Y); const float* ssy = (const float*)(a.ws + WS_SSY); const float* mod = (const float*)(a.ws + WS_MOD);
    const float* gpost = (const float*)a.in[16]; const float* gpre = (const float*)a.in[17]; bf16_t* h2 = (bf16_t*)(a.ws + WS_H);
    int row = gw; if (row >= S) return;
    f32x4 xv[8], xn[8]; v2u yw[8], yn[8]; float sv, sn = 0.f;
#define P9_LOAD(XV, YW, SV, R) do { const f32x4* xr_ = (const f32x4*)(x + (size_t)(R) * D) + lane; const v2u* yr_ = (const v2u*)(y + (size_t)(R) * D) + lane; \
        _Pragma("unroll") for (int j = 0; j < 8; ++j) { XV[j] = xr_[64 * j]; YW[j] = yr_[64 * j]; } SV = lane < 32 ? ssy[(size_t)(R) * 32 + lane] : 0.f; } while (0)
    P9_LOAD(xv, yw, sv, row);
    for (;;) {
        const int nrow = row + NGW; const bool has = nrow < S;
        if (has) P9_LOAD(xn, yn, sn, nrow);
        const float rstd = rsqrtf(wave_sum(sv) * (1.f / D) + EPS);
        f32x4* orow = (f32x4*)(a.out + (size_t)row * D) + lane; f32x4 v[8]; float ss = 0.f;
#pragma unroll
        for (int j = 0; j < 8; ++j) { const int cidx = 64 * j + lane; const f32x4 ga = ((const f32x4*)(mod + 4096))[cidx], gp = ((const f32x4*)gpost)[cidx];
            const v2u w_ = yw[j]; const f32x4 yv = {__uint_as_float(w_.x << 16), __uint_as_float(w_.x & 0xffff0000u), __uint_as_float(w_.y << 16), __uint_as_float(w_.y & 0xffff0000u)};
            v[j] = xv[j] + ga * (yv * rstd * gp); orow[64 * j] = v[j]; ss += (v[j][0] * v[j][0] + v[j][1] * v[j][1]) + (v[j][2] * v[j][2] + v[j][3] * v[j][3]); }
        const float r2 = rsqrtf(wave_sum(ss) * (1.f / D) + EPS);
        v2u* o = (v2u*)(h2 + (size_t)row * D) + lane;
#pragma unroll
        for (int j = 0; j < 8; ++j) { const int cidx = 64 * j + lane; const f32x4 gg = ((const f32x4*)gpre)[cidx], sh = ((const f32x4*)(mod + 6144))[cidx], sc = ((const f32x4*)(mod + 8192))[cidx];
            const f32x4 r = v[j] * r2 * gg * (sc + 1.f) + sh; v2u w; w.x = pk2(r[0], r[1]); w.y = pk2(r[2], r[3]); o[64 * j] = w; }
        if (!has) break;
        row = nrow; sv = sn;
#pragma unroll
        for (int j = 0; j < 8; ++j) { xv[j] = xn[j]; yw[j] = yn[j]; }
    }
#undef P9_LOAD
}
__device__ __forceinline__ void p12_rows_final(const Args& a, int gw, int NGW, int lane) {
    const bf16_t* y2 = (const bf16_t*)(a.ws + WS_Y2); const float* ss2 = (const float*)(a.ws + WS_SSY2); const float* mod = (const float*)(a.ws + WS_MOD); const float* gpost = (const float*)a.in[20];
    for (int row = gw; row < S; row += NGW) {
        const float rstd = rsqrtf(wave_sum(lane < 32 ? ss2[(size_t)row * 32 + lane] : 0.f) * (1.f / D) + EPS);
        const v2u* yr = (const v2u*)(y2 + (size_t)row * D) + lane; f32x4* orow = (f32x4*)(a.out + (size_t)row * D) + lane;
#pragma unroll
        for (int j = 0; j < 8; ++j) { const int cidx = 64 * j + lane; const f32x4 ga = ((const f32x4*)(mod + 10240))[cidx], gp = ((const f32x4*)gpost)[cidx];
            const v2u yw = yr[64 * j]; const f32x4 yv = {__uint_as_float(yw.x << 16), __uint_as_float(yw.x & 0xffff0000u), __uint_as_float(yw.y << 16), __uint_as_float(yw.y & 0xffff0000u)};
            orow[64 * j] = orow[64 * j] + ga * (yv * rstd * gp); }
    }
}

__global__ void __launch_bounds__(NTHREADS, 2) fwd(Args a) {
    extern __shared__ __attribute__((aligned(16))) unsigned char lds_raw[];
    LAS unsigned char* lds = (LAS unsigned char*)lds_raw;
    const int tid = threadIdx.x, lane = tid & 63, wave = __builtin_amdgcn_readfirstlane(tid >> 6);
    const int G = gridDim.x, bx = blockIdx.x, vcu = (G % 8 == 0) ? (bx % 8) * (G / 8) + bx / 8 : bx;
    const int gw = vcu * NWAVES + wave, NGW = G * NWAVES;
    unsigned char* ws = a.ws;
    const int lo = a.ph_lo, hi = a.ph_hi;
    volatile LAS unsigned* MISC = (volatile LAS unsigned*)(lds + MISC_OFF);
    if (tid < 16) MISC[tid] = 0u;
    __syncthreads();
    XcdBarrier bar = xcd_barrier_post((unsigned*)(ws + WS_CTL) + CW_BAR, MISC + 8);
#define IN(k) (lo <= (k) && (k) < hi)
#if PROBE_DUP == 200
#define BAR_AFTER(k) do { if (IN(k) && IN((k) + 1)) { xcd_barrier(bar); xcd_barrier(bar); } } while (0)
#else
#define BAR_AFTER(k) do { if (IN(k) && IN((k) + 1)) xcd_barrier(bar); } while (0)
#endif
    const hg::Ptrs hp{(const bf16_t*)(ws + WS_QH), (const f16_t*)(ws + WS_G16), (const bf16_t*)(ws + WS_V), (const bf16_t*)(ws + WS_OG), (bf16_t*)(ws + WS_OG), (const float*)a.in[8], (float*)(ws + WS_U), (float*)(ws + WS_DG)};
    if (IN(0)) p0_prologue(a, lds, vcu, G, wave, lane, tid);
#if PROBE_DUP == 100
    if (IN(0)) { __syncthreads(); p0_prologue(a, lds, vcu, G, wave, lane, tid); }
#endif
    BAR_AFTER(0);
    if (IN(1)) { p0_convert(a, lds, vcu, G, wave, lane); p1_rows_h(a, gw, NGW, lane); }
#if PROBE_DUP == 301
    if (IN(1)) p1_rows_h(a, gw, NGW, lane);
#endif
    BAR_AFTER(1);
    if (IN(2)) {
        pg8::Gemm g{(const bf16_t*)(ws + WS_H), (const bf16_t*)(ws + WS_WIN), S, IN_WP, D}; pg8::StaticOrder So; So.init(S, IN_WP, G, bx);
        pg8::EpiIn E{(bf16_t*)(ws + WS_QH), (bf16_t*)(ws + WS_G16), (bf16_t*)(ws + WS_V), (bf16_t*)(ws + WS_OG), (bf16_t*)(ws + WS_SA), (bf16_t*)(ws + WS_SB), (bf16_t*)(ws + WS_CQ), (bf16_t*)(ws + WS_CKV), (bf16_t*)(ws + WS_KR),
                     (const float*)(ws + WS_LB), (const float*)(ws + WS_ROPE), (float*)(ws + WS_SSQ), (float*)(ws + WS_SSKV)};
        pg8::gemm_phase<pg8::EpiIn, pg8::StaticOrder, true, PG8_SP2V>(lds, g, So, E);
        tail_convert<2>((const float*)a.in[18], D, GU_W, GU_W, (bf16_t*)(ws + WS_WGU), lds, (S / 256) * (IN_WP / 256), G, bx, wave, lane);
#if PROBE_DUP == 102
        pg8::gemm_phase<pg8::EpiIn, pg8::StaticOrder, true, PG8_SP2V>(lds, g, So, E);
#endif
    }
    BAR_AFTER(2);
    if (IN(3)) {
        { pg8::Gemm g{(const bf16_t*)(ws + WS_CQ), (const bf16_t*)(ws + WS_WUQ), S, UQ_W, QL}; pg8::StaticOrder So; So.init(S, UQ_W, G, bx);
          pg8::EpiUq E{(bf16_t*)(ws + WS_QN), (bf16_t*)(ws + WS_QR), (const float*)(ws + WS_SSQ), (const float*)(ws + WS_ROPE), QSCALE, EPS};
          pg8::gemm_phase<pg8::EpiUq, pg8::StaticOrder, true, PG8_SP2V>(lds, g, So, E); }
        tail_convert<3>((const float*)a.in[9], D, D, D, (bf16_t*)(ws + WS_WOHG), lds, (S / 256) * (UQ_W / 256), G, bx, wave, lane);
        tail_convert<3>((const float*)a.in[14], D, D, D, (bf16_t*)(ws + WS_WOMLA), lds, (S / 256) * (UQ_W / 256), G, bx, wave, lane);
        tail_convert<3>((const float*)a.in[15], D, D, D, (bf16_t*)(ws + WS_WOUT), lds, (S / 256) * (UQ_W / 256), G, bx, wave, lane);
        { pg8::Gemm g{(const bf16_t*)(ws + WS_CKV), (const bf16_t*)(ws + WS_WUKV), S, UKV_W, KVL}; pg8::StaticOrder So; So.init(S, UKV_W, G, bx);
          pg8::EpiUkv E{(bf16_t*)(ws + WS_KN), (bf16_t*)a.out, (const float*)(ws + WS_SSKV), EPS};
          pg8::gemm_phase<pg8::EpiUkv, pg8::StaticOrder, true, PG8_SP2V>(lds, g, So, E); }
#if PROBE_DUP == 303
        { pg8::Gemm g{(const bf16_t*)(ws + WS_CQ), (const bf16_t*)(ws + WS_WUQ), S, UQ_W, QL}; pg8::StaticOrder So; So.init(S, UQ_W, G, bx);
          pg8::EpiUq E{(bf16_t*)(ws + WS_QN), (bf16_t*)(ws + WS_QR), (const float*)(ws + WS_SSQ), (const float*)(ws + WS_ROPE), QSCALE, EPS};
          pg8::gemm_phase<pg8::EpiUq, pg8::StaticOrder, true, PG8_SP2V>(lds, g, So, E); }
        { pg8::Gemm g{(const bf16_t*)(ws + WS_CKV), (const bf16_t*)(ws + WS_WUKV), S, UKV_W, KVL}; pg8::StaticOrder So; So.init(S, UKV_W, G, bx);
          pg8::EpiUkv E{(bf16_t*)(ws + WS_KN), (bf16_t*)a.out, (const float*)(ws + WS_SSKV), EPS};
          pg8::gemm_phase<pg8::EpiUkv, pg8::StaticOrder, true, PG8_SP2V>(lds, g, So, E); }
#endif
        hg::phase<false>((char*)lds_raw, lds, hp, vcu, G);
#if PROBE_DUP == 103
        hg::phase<false>((char*)lds_raw, lds, hp, vcu, G);
#endif
    }
    BAR_AFTER(3);
    if (IN(4)) hg::scan_phase((float*)(ws + WS_U), (const float*)(ws + WS_DG), vcu * NTHREADS + tid, G * NTHREADS);
    BAR_AFTER(4);
    if (IN(5)) {
#if PROBE_DUP == 105
        att::phase((char*)lds_raw, lds, (bf16_t*)(ws + WS_QN), (const bf16_t*)(ws + WS_QR), (const bf16_t*)(ws + WS_KN), (const bf16_t*)(ws + WS_KR), (const bf16_t*)a.out, (bf16_t*)((unsigned char*)a.out + 32 * MiB), vcu, G);
#endif
        att::phase((char*)lds_raw, lds, (bf16_t*)(ws + WS_QN), (const bf16_t*)(ws + WS_QR), (const bf16_t*)(ws + WS_KN), (const bf16_t*)(ws + WS_KR), (const bf16_t*)a.out, (bf16_t*)(ws + WS_QN), vcu, G);
#if PROBE_DUP == 106
        { hg::Ptrs hp2 = hp; hp2.og_out = (bf16_t*)((unsigned char*)a.out + 32 * MiB); hg::phase<true>((char*)lds_raw, lds, hp2, vcu, G); }
#endif
        hg::phase<true>((char*)lds_raw, lds, hp, vcu, G);
    }
    BAR_AFTER(5);
    if (IN(6)) {
        { pg8::Gemm g{(const bf16_t*)(ws + WS_OG), (const bf16_t*)(ws + WS_WOHG), S, D, D}; pg8::StaticOrder So; So.init(S, D, G, bx);
          pg8::EpiYa E{(bf16_t*)(ws + WS_YAS), (const bf16_t*)(ws + WS_SA)};
          pg8::gemm_phase<pg8::EpiYa, pg8::StaticOrder, true, PG8_SP2V>(lds, g, So, E); }
        { pg8::Gemm g{(const bf16_t*)(ws + WS_QN), (const bf16_t*)(ws + WS_WOMLA), S, D, D}; pg8::StaticOrder So; So.init(S, D, G, bx);
          pg8::EpiYb E{(const bf16_t*)(ws + WS_YAS), (const bf16_t*)(ws + WS_SB), (bf16_t*)(ws + WS_MERGED)};
          pg8::gemm_phase<pg8::EpiYb, pg8::StaticOrder, true, PG8_SP2V>(lds, g, So, E); }
        #if PROBE_DUP == 306
        { pg8::Gemm g{(const bf16_t*)(ws + WS_OG), (const bf16_t*)(ws + WS_WOHG), S, D, D}; pg8::StaticOrder So; So.init(S, D, G, bx);
          pg8::EpiYa E{(bf16_t*)(ws + WS_YAS), (const bf16_t*)(ws + WS_SA)};
          pg8::gemm_phase<pg8::EpiYa, pg8::StaticOrder, true, PG8_SP2V>(lds, g, So, E); }
        { pg8::Gemm g{(const bf16_t*)(ws + WS_QN), (const bf16_t*)(ws + WS_WOMLA), S, D, D}; pg8::StaticOrder So; So.init(S, D, G, bx);
          pg8::EpiYb E{(const bf16_t*)(ws + WS_YAS), (const bf16_t*)(ws + WS_SB), (bf16_t*)(ws + WS_MERGED)};
          pg8::gemm_phase<pg8::EpiYb, pg8::StaticOrder, true, PG8_SP2V>(lds, g, So, E); }
        #endif

    }
    BAR_AFTER(6);
    if (IN(7)) {
        pg8::Gemm g{(const bf16_t*)(ws + WS_MERGED), (const bf16_t*)(ws + WS_WOUT), S, D, D}; pg8::StaticOrder So; So.init(S, D, G, bx);
        if (FUSE_NORM && G == 256) {
            const float* mod = (const float*)(ws + WS_MOD);
            pg8::RowStatX s1{(float*)(ws + WS_SSY), (unsigned*)(ws + WS_CTL) + CW_SEAM, (unsigned*)(ws + WS_CTL) + CW_TMO, 1.f / D, EPS}, s2{(float*)(ws + WS_SSX1), (unsigned*)(ws + WS_CTL) + CW_SEAM + 2048, (unsigned*)(ws + WS_CTL) + CW_TMO, 1.f / D, EPS};
            pg8::EpiRmsResRms E{(const float*)a.in[0], a.out, (bf16_t*)(ws + WS_H), mod + 4096, (const float*)a.in[16], (const float*)a.in[17], mod + 8192, mod + 6144, s1, s2};
            pg8::gemm_phase<pg8::EpiRmsResRms, pg8::StaticOrder, false, PG8_SP2V>(lds, g, So, E);
        } else {
        pg8::EpiF32SS E{(bf16_t*)(ws + WS_Y), (float*)(ws + WS_SSY)};
        pg8::gemm_phase<pg8::EpiF32SS, pg8::StaticOrder, true, PG8_SP2V>(lds, g, So, E);
        }
        #if PROBE_DUP == 307
        {
        pg8::Gemm g{(const bf16_t*)(ws + WS_MERGED), (const bf16_t*)(ws + WS_WOUT), S, D, D}; pg8::StaticOrder So; So.init(S, D, G, bx);
        if (FUSE_NORM && G == 256) {
            const float* mod = (const float*)(ws + WS_MOD);
            pg8::RowStatX s1{(float*)(ws + WS_SSY), (unsigned*)(ws + WS_CTL) + CW_SEAM, (unsigned*)(ws + WS_CTL) + CW_TMO, 1.f / D, EPS}, s2{(float*)(ws + WS_SSX1), (unsigned*)(ws + WS_CTL) + CW_SEAM + 2048, (unsigned*)(ws + WS_CTL) + CW_TMO, 1.f / D, EPS};
            pg8::EpiRmsResRms E{(const float*)a.in[0], a.out, (bf16_t*)(ws + WS_H), mod + 4096, (const float*)a.in[16], (const float*)a.in[17], mod + 8192, mod + 6144, s1, s2};
            pg8::gemm_phase<pg8::EpiRmsResRms, pg8::StaticOrder, false, PG8_SP2V>(lds, g, So, E);
        } else {
        pg8::EpiF32SS E{(bf16_t*)(ws + WS_Y), (float*)(ws + WS_SSY)};
        pg8::gemm_phase<pg8::EpiF32SS, pg8::StaticOrder, true, PG8_SP2V>(lds, g, So, E);
        }
                }
#endif

    }
    if (!(FUSE_NORM && G == 256)) BAR_AFTER(7);
    if (IN(8) && !(FUSE_NORM && G == 256)) p9_rows_mid(a, gw, NGW, lane);
#if PROBE_DUP == 308
    if (IN(8)) p9_rows_mid(a, gw, NGW, lane);
#endif
    BAR_AFTER(8);
    if (IN(9)) {
        pg8::Gemm g{(const bf16_t*)(ws + WS_H), (const bf16_t*)(ws + WS_WGU), S, GU_W, D}; pg8::StaticOrder So; So.init(S, GU_W, G, bx);
        pg8::EpiGu E{(bf16_t*)(ws + WS_ACT), DFF};
        pg8::gemm_phase<pg8::EpiGu, pg8::StaticOrder, true, PG8_SP2V>(lds, g, So, E);
        tail_convert<3>((const float*)a.in[19], DFF, D, D, (bf16_t*)(ws + WS_WDN), lds, (S / 256) * (GU_W / 256), G, bx, wave, lane);
#if PROBE_DUP == 109
        pg8::gemm_phase<pg8::EpiGu, pg8::StaticOrder, true, PG8_SP2V>(lds, g, So, E);
#endif
    }
    BAR_AFTER(9);
    if (IN(10)) {
        pg8::Gemm g{(const bf16_t*)(ws + WS_ACT), (const bf16_t*)(ws + WS_WDN), S, D, DFF}; pg8::StaticOrder So; So.init(S, D, G, bx);
        if (FUSE_NORM && G == 256) {
            pg8::RowStatX s3{(float*)(ws + WS_SSY2), (unsigned*)(ws + WS_CTL) + CW_SEAM + 4096, (unsigned*)(ws + WS_CTL) + CW_TMO, 1.f / D, EPS};
            pg8::EpiRmsResOut E{a.out, (const float*)(ws + WS_MOD) + 10240, (const float*)a.in[20], s3};
            pg8::gemm_phase<pg8::EpiRmsResOut, pg8::StaticOrder, false, PG8_SP2V>(lds, g, So, E);
        } else {
        pg8::EpiF32SS E{(bf16_t*)(ws + WS_Y2), (float*)(ws + WS_SSY2)};
        pg8::gemm_phase<pg8::EpiF32SS, pg8::StaticOrder, true, PG8_SP2V>(lds, g, So, E);
        }
        #if PROBE_DUP == 310
        {
        pg8::Gemm g{(const bf16_t*)(ws + WS_ACT), (const bf16_t*)(ws + WS_WDN), S, D, DFF}; pg8::StaticOrder So; So.init(S, D, G, bx);
        if (FUSE_NORM && G == 256) {
            pg8::RowStatX s3{(float*)(ws + WS_SSY2), (unsigned*)(ws + WS_CTL) + CW_SEAM + 4096, (unsigned*)(ws + WS_CTL) + CW_TMO, 1.f / D, EPS};
            pg8::EpiRmsResOut E{a.out, (const float*)(ws + WS_MOD) + 10240, (const float*)a.in[20], s3};
            pg8::gemm_phase<pg8::EpiRmsResOut, pg8::StaticOrder, false, PG8_SP2V>(lds, g, So, E);
        } else {
        pg8::EpiF32SS E{(bf16_t*)(ws + WS_Y2), (float*)(ws + WS_SSY2)};
        pg8::gemm_phase<pg8::EpiF32SS, pg8::StaticOrder, true, PG8_SP2V>(lds, g, So, E);
        }
                }
#endif

    }
    if (!(FUSE_NORM && G == 256)) BAR_AFTER(10);
    if (IN(11) && !(FUSE_NORM && G == 256)) p12_rows_final(a, gw, NGW, lane);
#undef IN
#undef BAR_AFTER
}
extern "C" void kernel_launch(void* const* d_in, const int* in_sizes, int n_in, void* d_out, int out_size, void* d_ws, size_t ws_size, hipStream_t stream) {
    static int grid = 0;
    if (grid == 0) {
        if (n_in != 21 || out_size != S * D || ws_size < WS_END) { fprintf(stderr, "kernel_launch: unexpected shapes (n_in %d out %d ws %zu)\n", n_in, out_size, ws_size); grid = -1; return; }
        int dev = 0, cus = 0;
        if (hipGetDevice(&dev) != hipSuccess || hipDeviceGetAttribute(&cus, hipDeviceAttributeMultiprocessorCount, dev) != hipSuccess) { grid = -1; return; }
        if (hipFuncSetAttribute((const void*)fwd, hipFuncAttributeMaxDynamicSharedMemorySize, LDS_BYTES) != hipSuccess) { fprintf(stderr, "kernel_launch: hipFuncSetAttribute failed\n"); grid = -1; return; }
        int per_cu = 0;
        if (hipOccupancyMaxActiveBlocksPerMultiprocessor(&per_cu, (const void*)fwd, NTHREADS, LDS_BYTES) != hipSuccess || per_cu < 1) { fprintf(stderr, "kernel_launch: occupancy query failed (%d)\n", per_cu); (void)hipGetLastError(); per_cu = 1; }
        grid = cus;
    }
    if (grid < 0) return;
    Args a{};
    for (int i = 0; i < 21; ++i) a.in[i] = d_in[i];
    a.out = (float*)d_out; a.ws = (unsigned char*)d_ws;
    auto run = [&](int lo, int hi) { a.ph_lo = lo; a.ph_hi = hi; hipLaunchKernelGGL(fwd, dim3(grid), dim3(NTHREADS), LDS_BYTES, stream, a); };
    if (hipMemsetAsync((char*)d_ws + WS_CTL, 0, 131072, stream) != hipSuccess) { fprintf(stderr, "kernel_launch: hipMemsetAsync failed\n"); return; }
    run(0, 12);
}
```
